# Optimizing an MI355X kernel written in HIP

```python
import math
import jax, jax.numpy as jnp
from jax import lax
import numpy as np

D_MODEL = 1024
BATCH = 1
SEQ = 16384
DEPTH = 1
DEC_BATCH = 16
DEC_SEQ = 16
PAST_LEN = 2048

CHUNK = 64
N_HEADS_A = 8
HEAD_DIM = 64
V_DIM = 2 * HEAD_DIM
D_A = N_HEADS_A * V_DIM
QK_WIDTH = N_HEADS_A * 2 * HEAD_DIM
ROPE_DIM = HEAD_DIM // 4
ROPE_THETA = 500000.0
Q_BLOCK = 128
GMLP_CHUNK = 128
N_GROUPS_B = 4
D_B = 1024
GROUP_DIM = D_B // N_GROUPS_B
D_FF = 2816
IN_COLS = 3 * QK_WIDTH + 2 * D_B + 2 * D_MODEL
EPS = 1e-6
SCALE = HEAD_DIM ** -0.5
NEG_INF = -1e30

kernel_name = "hybrid_diffattn_gmlp_streaming_step"


def rmsnorm(x, g):
    x32 = x.astype(jnp.float32)
    y = x32 * lax.rsqrt(jnp.mean(x32 * x32, axis=-1, keepdims=True) + EPS)
    return (y * g.astype(jnp.float32)).astype(x.dtype)


def swiglu(x, w_in, w_out):
    a, b = jnp.split(x @ w_in, 2, axis=-1)
    return (jax.nn.silu(a) * b) @ w_out


def partial_rope(x, pos):
    inv_freq = ROPE_THETA ** (-jnp.arange(0, ROPE_DIM, 2, dtype=jnp.float32) / ROPE_DIM)
    ang = pos.astype(jnp.float32)[:, None] * inv_freq[None, :]
    cos = jnp.cos(ang)[None, :, None, None, :].astype(x.dtype)
    sin = jnp.sin(ang)[None, :, None, None, :].astype(x.dtype)
    half = ROPE_DIM // 2
    x1, x2, xp = x[..., :half], x[..., half:ROPE_DIM], x[..., ROPE_DIM:]
    return jnp.concatenate([x1 * cos - x2 * sin, x2 * cos + x1 * sin, xp], axis=-1)


def diff_attn_core(q, k, v, lam, mask):
    s = jnp.einsum('bqhid,bkhid->bihqk', q, k).astype(jnp.float32) * SCALE
    if mask is not None:
        s = jnp.where(mask, s, NEG_INF)
    a = jax.nn.softmax(s, axis=-1)
    a = a[:, 0] - lam * a[:, 1]
    return jnp.einsum('bhqk,bkhv->bqhv', a.astype(v.dtype), v)


def prompt_diff_attn(q, k, v, lam):
    B, S = q.shape[0], q.shape[1]
    nb = S // Q_BLOCK
    qb = jnp.moveaxis(q.reshape(B, nb, Q_BLOCK, N_HEADS_A, 2, HEAD_DIM), 1, 0)
    k_chunk = jnp.arange(S) // CHUNK

    def one_block(args):
        i, qi = args
        q_chunk = (i * Q_BLOCK + jnp.arange(Q_BLOCK)) // CHUNK
        mask = k_chunk[None, :] <= q_chunk[:, None]
        return diff_attn_core(qi, k, v, lam, mask)

    o = lax.map(one_block, (jnp.arange(nb), qb))
    return jnp.moveaxis(o, 0, 1).reshape(B, S, N_HEADS_A, V_DIM)


def spatial_mix(vn, w_s, b_s):
    B, S, _ = vn.shape
    L = min(S, GMLP_CHUNK)
    nc = S // L
    w = (w_s * jnp.tril(jnp.ones((GMLP_CHUNK, GMLP_CHUNK), w_s.dtype)))[:, :L, :L]
    vr = vn.reshape(B, nc, L, N_GROUPS_B, GROUP_DIM)
    out = jnp.einsum('gij,bnjgc->bnigc', w, vr) + b_s[:, :L].T[None, None, :, :, None]
    return out.reshape(B, S, D_B)


def layer(x, pos, cache_k, cache_v, p, lam_init):
    B, S, _ = x.shape
    h = x + 0.5 * rmsnorm(swiglu(rmsnorm(x, p['ln_ffn1_pre']), p['w_ffn1_in'], p['w_ffn1_out']), p['ln_ffn1_post'])
    n = rmsnorm(h, p['ln_mix_pre'])
    proj = n @ p['w_in']
    splits = np.cumsum([QK_WIDTH, QK_WIDTH, D_A, D_B, D_B, D_MODEL]).tolist()
    q, k, v, u, vg, ga, gb = jnp.split(proj, splits, axis=-1)
    q = partial_rope(q.reshape(B, S, N_HEADS_A, 2, HEAD_DIM), pos)
    k = partial_rope(k.reshape(B, S, N_HEADS_A, 2, HEAD_DIM), pos)
    v = v.reshape(B, S, N_HEADS_A, V_DIM)
    k_rows = k.reshape(B, S, N_HEADS_A, 2 * HEAD_DIM)
    lam = (jnp.exp(jnp.sum(p['lambda_q1'].astype(jnp.float32) * p['lambda_k1'].astype(jnp.float32)))
           - jnp.exp(jnp.sum(p['lambda_q2'].astype(jnp.float32) * p['lambda_k2'].astype(jnp.float32)))
           + lam_init)
    if cache_k is None:
        attn = prompt_diff_attn(q, k, v, lam)
    else:
        P = cache_k.shape[1]
        k_all = jnp.concatenate([cache_k.reshape(B, P, N_HEADS_A, 2, HEAD_DIM), k], axis=1)
        v_all = jnp.concatenate([cache_v, v], axis=1)
        attn = diff_attn_core(q, k_all, v_all, lam, None)
    attn = (rmsnorm(attn, p['ln_subln']) * (1.0 - lam_init)).reshape(B, S, D_A)
    u = jax.nn.gelu(u)
    vn = rmsnorm(jax.nn.gelu(vg), p['ln_sgu'])
    sgu = u * spatial_mix(vn, p['w_spatial'], p['b_spatial'])
    merged = jax.nn.sigmoid(ga) * (attn @ p['w_proj_a']) + jax.nn.sigmoid(gb) * (sgu @ p['w_proj_b'])
    h = h + rmsnorm(merged @ p['w_out'], p['ln_mix_post'])
    y = h + 0.5 * rmsnorm(swiglu(rmsnorm(h, p['ln_ffn2_pre']), p['w_ffn2_in'], p['w_ffn2_out']), p['ln_ffn2_post'])
    return y, k_rows, v, vn


def setup_inputs(seed: int = 0) -> dict:
    key = jax.random.key(seed)
    ks = jax.random.split(key, 32)

    def nrm(k, shape, scale):
        return jax.random.normal(k, shape, jnp.float32) * scale

    def gain(k, dim):
        return 1.0 + 0.05 * jax.random.normal(k, (DEPTH, dim), jnp.float32)

    return {
        'x_prompt': nrm(ks[0], (BATCH, SEQ, D_MODEL), 1.0),
        'x_sample': nrm(ks[1], (DEC_BATCH, DEC_SEQ, D_MODEL), 1.0),
        'cache_k': nrm(ks[2], (DEPTH, DEC_BATCH, PAST_LEN, N_HEADS_A, 2 * HEAD_DIM), 1.0),
        'cache_v': nrm(ks[3], (DEPTH, DEC_BATCH, PAST_LEN, N_HEADS_A, V_DIM), 1.0),
        'ln_ffn1_pre': gain(ks[4], D_MODEL),
        'w_ffn1_in': nrm(ks[5], (DEPTH, D_MODEL, 2 * D_FF), D_MODEL ** -0.5),
        'w_ffn1_out': nrm(ks[6], (DEPTH, D_FF, D_MODEL), D_FF ** -0.5),
        'ln_ffn1_post': gain(ks[7], D_MODEL),
        'ln_mix_pre': gain(ks[8], D_MODEL),
        'w_in': nrm(ks[9], (DEPTH, D_MODEL, IN_COLS), D_MODEL ** -0.5),
        'lambda_q1': nrm(ks[10], (DEPTH, HEAD_DIM), 0.1),
        'lambda_k1': nrm(ks[11], (DEPTH, HEAD_DIM), 0.1),
        'lambda_q2': nrm(ks[12], (DEPTH, HEAD_DIM), 0.1),
        'lambda_k2': nrm(ks[13], (DEPTH, HEAD_DIM), 0.1),
        'ln_subln': gain(ks[14], V_DIM),
        'ln_sgu': gain(ks[15], D_B),
        'w_spatial': nrm(ks[16], (DEPTH, N_GROUPS_B, GMLP_CHUNK, GMLP_CHUNK), GMLP_CHUNK ** -0.5),
        'b_spatial': 1.0 + 0.1 * jax.random.normal(ks[17], (DEPTH, N_GROUPS_B, GMLP_CHUNK), jnp.float32),
        'w_proj_a': nrm(ks[18], (DEPTH, D_A, D_MODEL), D_A ** -0.5),
        'w_proj_b': nrm(ks[19], (DEPTH, D_B, D_MODEL), D_B ** -0.5),
        'w_out': nrm(ks[20], (DEPTH, D_MODEL, D_MODEL), D_MODEL ** -0.5),
        'ln_mix_post': gain(ks[21], D_MODEL),
        'ln_ffn2_pre': gain(ks[22], D_MODEL),
        'w_ffn2_in': nrm(ks[23], (DEPTH, D_MODEL, 2 * D_FF), D_MODEL ** -0.5),
        'w_ffn2_out': nrm(ks[24], (DEPTH, D_FF, D_MODEL), D_FF ** -0.5),
        'ln_ffn2_post': gain(ks[25], D_MODEL),
    }


def reference(x_prompt, x_sample, cache_k, cache_v,
              ln_ffn1_pre, w_ffn1_in, w_ffn1_out, ln_ffn1_post,
              ln_mix_pre, w_in, lambda_q1, lambda_k1, lambda_q2, lambda_k2,
              ln_subln, ln_sgu, w_spatial, b_spatial, w_proj_a, w_proj_b, w_out, ln_mix_post,
              ln_ffn2_pre, w_ffn2_in, w_ffn2_out, ln_ffn2_post):
    S = x_prompt.shape[1]
    P = cache_k.shape[2]
    L = x_sample.shape[1]
    pos_prompt = jnp.arange(S)
    pos_sample = P + jnp.arange(L)
    hp, hs = x_prompt, x_sample
    kp_l, vp_l, ks_l, vs_l, gs_l = [], [], [], [], []
    for l in range(DEPTH):
        p = {
            'ln_ffn1_pre': ln_ffn1_pre[l], 'w_ffn1_in': w_ffn1_in[l], 'w_ffn1_out': w_ffn1_out[l],
            'ln_ffn1_post': ln_ffn1_post[l], 'ln_mix_pre': ln_mix_pre[l], 'w_in': w_in[l],
            'lambda_q1': lambda_q1[l], 'lambda_k1': lambda_k1[l],
            'lambda_q2': lambda_q2[l], 'lambda_k2': lambda_k2[l],
            'ln_subln': ln_subln[l], 'ln_sgu': ln_sgu[l], 'w_spatial': w_spatial[l], 'b_spatial': b_spatial[l],
            'w_proj_a': w_proj_a[l], 'w_proj_b': w_proj_b[l], 'w_out': w_out[l], 'ln_mix_post': ln_mix_post[l],
            'ln_ffn2_pre': ln_ffn2_pre[l], 'w_ffn2_in': w_ffn2_in[l], 'w_ffn2_out': w_ffn2_out[l],
            'ln_ffn2_post': ln_ffn2_post[l],
        }
        lam_init = 0.8 - 0.6 * math.exp(-0.3 * l)
        hp, kp, vp, _ = layer(hp, pos_prompt, None, None, p, lam_init)
        hs, ksm, vsm, gsm = layer(hs, pos_sample, cache_k[l], cache_v[l], p, lam_init)
        kp_l.append(kp); vp_l.append(vp); ks_l.append(ksm); vs_l.append(vsm); gs_l.append(gsm)
    new_k_prompt = jnp.stack(kp_l)
    new_v_prompt = jnp.stack(vp_l)
    new_k_sample = jnp.stack(ks_l)
    new_v_sample = jnp.stack(vs_l)
    new_sgu_v_sample = jnp.stack(gs_l)
    return (hp, hs, new_k_prompt, new_v_prompt, new_k_sample, new_v_sample, new_sgu_v_sample)
```

```cpp
#include <hip/hip_runtime.h>
#include <hip/hip_cooperative_groups.h>
#include <cstdio>
#include <cstdint>
namespace cg = cooperative_groups;
#ifndef P5M
#define P5M 7
#endif
#ifndef PHM
#define PHM 0xFFF
#endif

namespace pg8 {
#define PG8_LAS __attribute__((address_space(3)))
typedef unsigned short bf16_t;
typedef short bf16x8 __attribute__((ext_vector_type(8)));
typedef float f32x4 __attribute__((ext_vector_type(4)));
typedef float f32x2 __attribute__((ext_vector_type(2)));
typedef unsigned u32x4 __attribute__((ext_vector_type(4)));
typedef unsigned u32x2 __attribute__((ext_vector_type(2)));
constexpr int BM = 256, BK = 64, HALF = 128, HTB = HALF * BK * 2, STAGE_BYTES = 8 * HTB, NXCD = 8, WGM = 8;

__host__ __device__ __forceinline__ int lds_byte(int r, int c) { const int st = (r >> 4) * 2 + (c >> 5), rr = r & 15, cc = c & 31, ob = rr * 64 + cc * 2; return st * 1024 + (ob ^ (((ob >> 9) & 1) << 5)); }
__host__ __device__ __forceinline__ void stage_rc(int b, int& R, int& C) { const int st = b / 1024, sb = b % 1024, swz = sb ^ (((sb >> 9) & 1) << 5); R = (st >> 1) * 16 + swz / 64; C = (st & 1) * 32 + (swz % 64) / 2; }
__host__ __device__ __forceinline__ int perm32(int rho) { const int n = rho >> 4, i = rho & 15; return 8 * (i >> 2) + 4 * n + (i & 3); }

struct Unit { int pm, pn, w; };
struct Gemm { const bf16_t* A; const bf16_t* Bt; int M, N, K; const bf16_t* A2 = nullptr; const bf16_t* Bt2 = nullptr; int ld = 0; };

struct StaticOrder {
    int nM, nN, nwg, G, c;
    __host__ __device__ void init(int M, int N, int G_, int c_) { nM = M / BM; nN = N / BM; nwg = nM * nN; G = G_; c = c_; }
    __host__ __device__ bool next(int i, Unit& u) const {
        const long L = (long)i * G + c; if (L >= nwg) return false;
        int wgid = (int)L; { const int q = nwg / NXCD, r = nwg % NXCD, xcd = wgid % NXCD, off = wgid / NXCD; wgid = (xcd < r ? xcd * (q + 1) : r * (q + 1) + (xcd - r) * q) + off; }
        const int nig = WGM * nN, gid = wgid / nig, fm = gid * WGM, gsz = (nM - fm) < WGM ? (nM - fm) : WGM;
        u.pm = fm + ((wgid % nig) % gsz); u.pn = (wgid % nig) / gsz; u.w = 0; return true;
    }
    __device__ __forceinline__ void a_ready(const Unit&) const {}
    __device__ __forceinline__ void done(const Unit&) const {}
};
struct DualOrder {
    StaticOrder so;
    __host__ __device__ void init(int M, int N, int G_, int c_) { so.init(M, N, G_, c_); }
    __host__ __device__ bool next(int i, Unit& u) const { if (!so.next(i >> 1, u)) return false; u.w = i & 1; return true; }
    __device__ __forceinline__ void a_ready(const Unit&) const {}
    __device__ __forceinline__ void done(const Unit&) const {}
};

typedef float f32x2_cv __attribute__((ext_vector_type(2))); typedef __bf16 bf16x2_cv __attribute__((ext_vector_type(2)));
struct OneUnit {
    int pm, pn;
    __device__ __forceinline__ bool next(int i, Unit& u) const { if (i > 0) return false; u.pm = pm; u.pn = pn; u.w = 0; return true; }
    __device__ __forceinline__ void a_ready(const Unit&) const {}
    __device__ __forceinline__ void done(const Unit&) const {}
};
__device__ __forceinline__ unsigned cvt_pk_bf16(float lo, float hi) { f32x2_cv v = {lo, hi}; bf16x2_cv b = __builtin_convertvector(v, bf16x2_cv); return __builtin_bit_cast(unsigned, b); }

template <class Epi, class Sched, bool ALIGN_EPI = false, bool SP2 = false>
__device__ __forceinline__ void gemm_phase(PG8_LAS unsigned char* lds, const Gemm g, const Sched& S, const Epi& E) {
    int tid = threadIdx.x; asm volatile("" : "+v"(tid));
    const int wid = __builtin_amdgcn_readfirstlane(tid >> 6), lane = tid & 63, wr = wid >> 2, wc = wid & 3, fr = lane & 15, fq = lane >> 4;
    const int K = g.K, nt = K / BK, LD = g.ld ? g.ld : g.K;
    unsigned voffA[2], voffB[2];
#pragma unroll
    for (int i = 0; i < 2; ++i) { int R, C; stage_rc(tid * 16 + i * 8192, R, C); const int Rb = Epi::PERM ? ((R & ~31) + perm32(R & 31)) : R;
        voffA[i] = (unsigned)(R * LD + C) * 2u; voffB[i] = (unsigned)(Rb * LD + C) * 2u; }
    const size_t kstep = (size_t)(BK * 2);
    const size_t hstep = (size_t)HALF * LD * 2;
    const size_t tstep = 2 * hstep;
    const unsigned ldsw = (unsigned)wid * 1024u;
    const int aoff = lds_byte(wr * 64 + fr, fq * 8), boff = lds_byte(wc * 32 + fr, fq * 8);
#define PG8_SA(b, h) (((b) * 2 + (h)) * HTB)
#define PG8_SB(b, h) ((4 + (b) * 2 + (h)) * HTB)
#define PG8_STAGE(bufoff, gbase, voff) do { _Pragma("unroll") for (int _i = 0; _i < 2; ++_i) \
        __builtin_amdgcn_global_load_lds((const unsigned*)((const char*)(gbase) + (voff)[_i]), (PG8_LAS unsigned*)(lds + (bufoff) + ldsw + _i * 8192), 16, 0, 0); } while (0)
#define PG8_LDA(dst, b, h) do { _Pragma("unroll") for (int m = 0; m < 4; ++m) _Pragma("unroll") for (int k = 0; k < 2; ++k) dst[m][k] = *(const PG8_LAS bf16x8*)(lds + PG8_SA(b, h) + aoff + m * 2048 + k * 1024); } while (0)
#define PG8_LDB(dst, b, h) do { _Pragma("unroll") for (int n = 0; n < 2; ++n) _Pragma("unroll") for (int k = 0; k < 2; ++k) dst[n][k] = *(const PG8_LAS bf16x8*)(lds + PG8_SB(b, h) + boff + n * 2048 + k * 1024); } while (0)
#define PG8_MMA(ai, bj, At, Bt) do { __builtin_amdgcn_s_setprio(1); _Pragma("unroll") for (int m = 0; m < 4; ++m) _Pragma("unroll") for (int n = 0; n < 2; ++n) _Pragma("unroll") for (int k = 0; k < 2; ++k) \
        acc[ai][bj][m][n] = __builtin_amdgcn_mfma_f32_16x16x32_bf16(Bt[n][k], At[m][k], acc[ai][bj][m][n], 0, 0, 0); __builtin_amdgcn_s_setprio(0); } while (0)
#define PG8_WAIT_V(n) asm volatile("s_waitcnt vmcnt(" #n ")" ::: "memory")
#define PG8_WAIT_L(n) asm volatile("s_waitcnt lgkmcnt(" #n ")" ::: "memory")
#define PG8_BAR __builtin_amdgcn_s_barrier()
#define PG8_SCHED __builtin_amdgcn_sched_barrier(0)
    Unit cur, nxt; int ui = 0;
    if (!S.next(0, cur)) return;
    f32x4 acc[2][2][4][2];
#pragma unroll
    for (int a = 0; a < 2; ++a)
#pragma unroll
        for (int b = 0; b < 2; ++b)
#pragma unroll
            for (int m = 0; m < 4; ++m)
#pragma unroll
                for (int n = 0; n < 2; ++n) acc[a][b][m][n] = (f32x4){0.f, 0.f, 0.f, 0.f};
    bf16x8 At[4][2], B0[2][2], B1[2][2];
    const char* cA = (const char*)(cur.w ? g.A2 : g.A) + (size_t)cur.pm * tstep; const char* cB = (const char*)(cur.w ? g.Bt2 : g.Bt) + (size_t)cur.pn * tstep;
    S.a_ready(cur);
    if constexpr (SP2) {
        PG8_STAGE(PG8_SB(0, 0), cB, voffB); PG8_STAGE(PG8_SB(0, 1), cB + hstep, voffB); PG8_STAGE(PG8_SA(0, 0), cA, voffA); PG8_STAGE(PG8_SA(0, 1), cA + hstep, voffA);
        if (wr == 1) PG8_BAR;
        PG8_WAIT_V(2); PG8_BAR;
        PG8_STAGE(PG8_SB(1, 0), cB + kstep, voffB); PG8_STAGE(PG8_SA(1, 0), cA + kstep, voffA); PG8_STAGE(PG8_SB(1, 1), cB + hstep + kstep, voffB);
        PG8_WAIT_V(6); PG8_BAR;
    } else {
        PG8_STAGE(PG8_SB(0, 0), cB, voffB); PG8_STAGE(PG8_SA(0, 0), cA, voffA); PG8_STAGE(PG8_SB(0, 1), cB + hstep, voffB); PG8_STAGE(PG8_SA(0, 1), cA + hstep, voffA);
        if (wr == 1) PG8_BAR;
        PG8_WAIT_V(4); PG8_BAR;
        PG8_STAGE(PG8_SB(1, 0), cB + kstep, voffB); PG8_STAGE(PG8_SA(1, 0), cA + kstep, voffA); PG8_STAGE(PG8_SB(1, 1), cB + hstep + kstep, voffB);
        PG8_WAIT_V(6); PG8_BAR;
    }
    for (;;) {
        const bool has_next = S.next(ui + 1, nxt);
        const char* nA = has_next ? (const char*)(nxt.w ? g.A2 : g.A) + (size_t)nxt.pm * tstep : cA; const char* nB = has_next ? (const char*)(nxt.w ? g.Bt2 : g.Bt) + (size_t)nxt.pn * tstep : cB;
        for (int t = 0; t < nt; t += 2) {
            const bool last = (t == nt - 2);
            const char* a1 = cA + (size_t)(t + 1) * kstep;
            const char* a2 = last ? nA : cA + (size_t)(t + 2) * kstep; const char* b2 = last ? nB : cB + (size_t)(t + 2) * kstep;
            const char* a3 = a2 + kstep; const char* b3 = b2 + kstep;
            if (last && has_next) S.a_ready(nxt);
            if constexpr (SP2) {
            PG8_LDB(B0, 0, 0); PG8_LDB(B1, 0, 1); PG8_SCHED; PG8_LDA(At, 0, 0); PG8_STAGE(PG8_SA(1, 1), a1 + hstep, voffA);
            PG8_WAIT_V(8); PG8_WAIT_L(0); PG8_BAR; PG8_MMA(0, 0, At, B0); PG8_MMA(0, 1, At, B1); PG8_BAR; PG8_SCHED;
            PG8_LDA(At, 0, 1); PG8_STAGE(PG8_SB(0, 0), b2, voffB); PG8_STAGE(PG8_SB(0, 1), b2 + hstep, voffB); PG8_STAGE(PG8_SA(0, 0), a2, voffA);
            PG8_WAIT_V(8); PG8_WAIT_L(0); PG8_BAR; PG8_MMA(1, 0, At, B0); PG8_MMA(1, 1, At, B1); PG8_BAR; PG8_SCHED;
            PG8_LDB(B0, 1, 0); PG8_LDB(B1, 1, 1); PG8_SCHED; PG8_LDA(At, 1, 0); PG8_STAGE(PG8_SA(0, 1), a2 + hstep, voffA);
            PG8_WAIT_V(8); PG8_WAIT_L(0); PG8_BAR; PG8_MMA(0, 0, At, B0); PG8_MMA(0, 1, At, B1); PG8_BAR; PG8_SCHED;
            PG8_LDA(At, 1, 1); PG8_STAGE(PG8_SB(1, 0), b3, voffB); PG8_STAGE(PG8_SB(1, 1), b3 + hstep, voffB); PG8_STAGE(PG8_SA(1, 0), a3, voffA);
            PG8_WAIT_V(8); PG8_WAIT_L(0); PG8_BAR; PG8_MMA(1, 0, At, B0); PG8_MMA(1, 1, At, B1); PG8_BAR; PG8_SCHED;
            } else {
            PG8_LDB(B0, 0, 0); PG8_SCHED; PG8_LDA(At, 0, 0); PG8_STAGE(PG8_SA(1, 1), a1 + hstep, voffA);
            PG8_WAIT_L(8); PG8_BAR; PG8_WAIT_L(0); PG8_MMA(0, 0, At, B0); PG8_BAR; PG8_SCHED;
            PG8_LDB(B1, 0, 1); PG8_STAGE(PG8_SB(0, 0), b2, voffB);
            PG8_BAR; PG8_WAIT_L(0); PG8_MMA(0, 1, At, B1); PG8_BAR;
            PG8_LDA(At, 0, 1); PG8_STAGE(PG8_SA(0, 0), a2, voffA);
            PG8_BAR; PG8_WAIT_L(0); PG8_MMA(1, 0, At, B0); PG8_BAR; PG8_SCHED;
            PG8_STAGE(PG8_SB(0, 1), b2 + hstep, voffB);
            PG8_WAIT_V(6); PG8_BAR; PG8_MMA(1, 1, At, B1); PG8_BAR;
            PG8_LDB(B0, 1, 0); PG8_SCHED; PG8_LDA(At, 1, 0); PG8_STAGE(PG8_SA(0, 1), a2 + hstep, voffA);
            PG8_WAIT_L(8); PG8_BAR; PG8_WAIT_L(0); PG8_MMA(0, 0, At, B0); PG8_BAR; PG8_SCHED;
            PG8_LDB(B1, 1, 1); PG8_STAGE(PG8_SB(1, 0), b3, voffB);
            PG8_BAR; PG8_WAIT_L(0); PG8_MMA(0, 1, At, B1); PG8_BAR;
            PG8_LDA(At, 1, 1); PG8_STAGE(PG8_SA(1, 0), a3, voffA);
            PG8_BAR; PG8_WAIT_L(0); PG8_MMA(1, 0, At, B0); PG8_BAR; PG8_SCHED;
            PG8_STAGE(PG8_SB(1, 1), b3 + hstep, voffB);
            PG8_WAIT_V(6); PG8_BAR; PG8_MMA(1, 1, At, B1); PG8_BAR;
            }
        }
        if constexpr (ALIGN_EPI) { if (wr == 0) PG8_BAR; }
        E(acc, cur, wr, wc, fr, fq); S.done(cur);
        if (!has_next) break;
        if (!(Epi::DUAL && cur.w == 0)) {
#pragma unroll
        for (int a = 0; a < 2; ++a)
#pragma unroll
            for (int b = 0; b < 2; ++b)
#pragma unroll
                for (int m = 0; m < 4; ++m)
#pragma unroll
                    for (int n = 0; n < 2; ++n) acc[a][b][m][n] = (f32x4){0.f, 0.f, 0.f, 0.f};
        }
        cur = nxt; cA = nA; cB = nB; ++ui;
        if constexpr (ALIGN_EPI) { if (wr == 1) PG8_BAR; }
    }
    PG8_WAIT_V(0);
    if constexpr (!ALIGN_EPI) { if (wr == 0) PG8_BAR; }
    PG8_BAR;
#undef PG8_SA
#undef PG8_SB
#undef PG8_STAGE
#undef PG8_LDA
#undef PG8_LDB
#undef PG8_MMA
#undef PG8_WAIT_V
#undef PG8_WAIT_L
#undef PG8_BAR
#undef PG8_SCHED
}
}

constexpr int DM = 1024, SEQ = 16384, DECB = 16, DECS = 16, PAST = 2048, NH = 8, DFF = 2816, INC = 7168;
constexpr int MT = SEQ + DECB * DECS;
constexpr int LDF = 2880;
constexpr float EPS = 1e-6f;
constexpr float C2 = 0.18033688011112042f;
constexpr float LAM_INIT = 0.2f;

constexpr size_t OFF_Y = 0, OFF_KP = (size_t)MT * DM, OFF_VP = OFF_KP + (size_t)SEQ * DM, OFF_KS = OFF_VP + (size_t)SEQ * DM,
                 OFF_VS = OFF_KS + (size_t)256 * DM, OFF_GS = OFF_VS + (size_t)256 * DM;

constexpr size_t MiB = 1u << 20;
constexpr size_t WS_CTL = 0, CTL_ZERO_BYTES = 64 * 1024;
constexpr size_t WS_ROPE = 1 * MiB;
constexpr size_t WS_SS = 2 * MiB;
constexpr size_t WS_W1IN = 4 * MiB;
constexpr size_t WS_W1OUT = 15 * MiB;
constexpr size_t WS_WIN = 21 * MiB;
constexpr size_t WS_WA = 35 * MiB, WS_WB = 37 * MiB, WS_WO = 39 * MiB;
constexpr size_t WS_W2IN = 41 * MiB, WS_W2OUT = 52 * MiB;
constexpr size_t WS_XN = 58 * MiB;
constexpr size_t WS_ACT = 91 * MiB;
constexpr size_t WS_UB = WS_ACT, WS_GVB = WS_ACT + 33 * MiB;
constexpr size_t WS_F = 184 * MiB;
constexpr size_t WS_ATT = WS_F, WS_SGU = WS_F + 33 * MiB;
constexpr size_t WS_H = 250 * MiB;
constexpr size_t WS_QB = 316 * MiB, WS_KPB = 349 * MiB, WS_VPB = 382 * MiB;
constexpr size_t WS_T1 = WS_QB;
constexpr size_t WS_SGA = 415 * MiB, WS_SGB = 448 * MiB;
constexpr size_t WS_SA = 481 * MiB;
constexpr size_t SA_XN = WS_SA, SA_ACT = WS_SA + 1 * MiB, SA_F = WS_SA + 3 * MiB, SA_H = WS_SA + 4 * MiB, SA_T1 = WS_SA + 5 * MiB, SA_Q = WS_SA + 6 * MiB,
                 SA_U = SA_Q + 512 * 1024, SA_GV = SA_U + 512 * 1024, SA_SGA = SA_GV + 512 * 1024, SA_SGB = SA_SGA + 512 * 1024, SA_ATT = SA_SGB + 512 * 1024,
                 SA_SGU = SA_ATT + 512 * 1024, SA_SS = SA_SGU + 512 * 1024;
constexpr size_t WS_END = 493 * MiB;
static_assert(WS_SS + (size_t)MT * 16 * 4 <= WS_W1IN && WS_XN + (size_t)MT * DM * 2 <= WS_ACT && WS_ACT + (size_t)MT * LDF * 2 <= WS_F &&
              WS_F + (size_t)MT * DM * 4 <= WS_H && WS_H + (size_t)MT * DM * 4 <= WS_QB &&
              WS_GVB + (size_t)MT * DM * 2 <= WS_F && WS_SGU + (size_t)MT * DM * 2 <= WS_H && true &&
              WS_W2OUT + (size_t)DM * LDF * 2 <= WS_XN && WS_W1IN + (size_t)2 * DFF * DM * 2 <= WS_W1OUT && WS_W1OUT + (size_t)DM * LDF * 2 <= WS_WIN &&
              WS_WIN + (size_t)INC * DM * 2 <= WS_WA && WS_W2IN + (size_t)2 * DFF * DM * 2 <= WS_W2OUT, "d_ws map");
constexpr int CW_BAR = 4096;
constexpr int CW_CH = 2048;
constexpr int CW_Q = 1024;

constexpr int RING_BYTES = 131072, MISC_OFF = RING_BYTES + 320, LDS_BYTES = 147456;
constexpr int NWAVES = 8;

#define GAS __attribute__((address_space(1)))
#define LAS __attribute__((address_space(3)))
typedef unsigned short bf16;
typedef unsigned v4u __attribute__((ext_vector_type(4)));
typedef unsigned v2u __attribute__((ext_vector_type(2)));
typedef float f32x4 __attribute__((ext_vector_type(4)));
#define LDS_WAIT() asm volatile("s_waitcnt lgkmcnt(0)" ::: "memory")
__device__ __forceinline__ unsigned f2bf(float f) { unsigned u = __builtin_bit_cast(unsigned, f); return (u + 0x7fffu + ((u >> 16) & 1u)) >> 16; }
__device__ __forceinline__ unsigned pk2(float lo, float hi) { return f2bf(lo) | (f2bf(hi) << 16); }
__device__ __forceinline__ float bf2f(unsigned short b) { return __builtin_bit_cast(float, (unsigned)b << 16); }
__device__ __forceinline__ float bflo(unsigned w) { return __builtin_bit_cast(float, w << 16); }
__device__ __forceinline__ float bfhi(unsigned w) { return __builtin_bit_cast(float, w & 0xffff0000u); }
__device__ __forceinline__ float wave_sum(float v) {
#pragma unroll
    for (int o = 1; o < 64; o <<= 1) v += __shfl_xor(v, o);
    return v;
}
__device__ __forceinline__ float fast_rcp(float x) { return __builtin_amdgcn_rcpf(x); }
__device__ __forceinline__ float sigmoidf_(float x) { return fast_rcp(1.0f + __builtin_amdgcn_exp2f(-1.4426950408889634f * x)); }
__device__ __forceinline__ float siluf_(float x) { return x * sigmoidf_(x); }
__device__ __forceinline__ float geluf_(float x) { const float z = 1.5957691216057308f * (x + 0.044715f * x * x * x); return x * sigmoidf_(z); }

namespace pg8 {
struct EpiSwiglu {
    static constexpr bool PERM = true, DUAL = false;
    bf16_t* O;
    __device__ __forceinline__ void operator()(const f32x4 (&acc)[2][2][4][2], const Unit& u, int wr, int wc, int fr, int fq) const {
        const int row0 = u.pm * BM + wr * 64 + fr, col0 = u.pn * 128 + wc * 32 + 8 * fq;
#pragma unroll
        for (int ai = 0; ai < 2; ++ai)
#pragma unroll
            for (int m = 0; m < 4; ++m) {
                const f32x4 a0 = acc[ai][0][m][0], a1 = acc[ai][0][m][1], b0 = acc[ai][1][m][0], b1 = acc[ai][1][m][1];
                u32x4 w;
                w.x = cvt_pk_bf16(siluf_(a0[0]) * b0[0], siluf_(a0[1]) * b0[1]); w.y = cvt_pk_bf16(siluf_(a0[2]) * b0[2], siluf_(a0[3]) * b0[3]);
                w.z = cvt_pk_bf16(siluf_(a1[0]) * b1[0], siluf_(a1[1]) * b1[1]); w.w = cvt_pk_bf16(siluf_(a1[2]) * b1[2], siluf_(a1[3]) * b1[3]);
                *(u32x4*)(O + (size_t)(row0 + ai * HALF + m * 16) * LDF + col0) = w;
            }
    }
};
struct EpiF32Stats {
    static constexpr bool PERM = true, DUAL = false;
    bf16_t* O; float* SS;
    __device__ __forceinline__ void operator()(const f32x4 (&acc)[2][2][4][2], const Unit& u, int wr, int wc, int fr, int fq) const {
        const int row0 = u.pm * BM + wr * 64 + fr, col0 = u.pn * BM + wc * 32 + 8 * fq;
#pragma unroll
        for (int ai = 0; ai < 2; ++ai)
#pragma unroll
            for (int m = 0; m < 4; ++m) {
                const int row = row0 + ai * HALF + m * 16; float s = 0.f;
#pragma unroll
                for (int bj = 0; bj < 2; ++bj) { const f32x4 v0 = acc[ai][bj][m][0], v1 = acc[ai][bj][m][1];
                    u32x4 w; w.x = cvt_pk_bf16(v0[0], v0[1]); w.y = cvt_pk_bf16(v0[2], v0[3]); w.z = cvt_pk_bf16(v1[0], v1[1]); w.w = cvt_pk_bf16(v1[2], v1[3]);
                    *(u32x4*)(O + (size_t)row * DM + col0 + bj * HALF) = w;
                    s += (v0[0] * v0[0] + v0[1] * v0[1]) + (v0[2] * v0[2] + v0[3] * v0[3]) + (v1[0] * v1[0] + v1[1] * v1[1]) + (v1[2] * v1[2] + v1[3] * v1[3]); }
                s += __shfl_xor(s, 16); s += __shfl_xor(s, 32);
                if (fq == 0) SS[(size_t)row * 16 + u.pn * 4 + wc] = s;
            }
    }
};
struct EpiProj {
    static constexpr bool PERM = true, DUAL = false;
    bf16_t *Qb, *Kp, *Vp, *Ub, *GVb, *SGA, *SGB; float* kout; float* vout; float* SS; const float* rope; bool samp;
    __device__ __forceinline__ void operator()(const f32x4 (&acc)[2][2][4][2], const Unit& u, int wr, int wc, int fr, int fq) const {
        const int type = u.pn >> 2, cb = (u.pn & 3) * 256;
        const int row0 = u.pm * BM + wr * 64 + fr, col0 = cb + wc * 32 + 8 * fq;
        if (type <= 1) {
            const bool ropew = ((wc & 1) == 0);
#pragma unroll
            for (int ai = 0; ai < 2; ++ai)
#pragma unroll
                for (int m = 0; m < 4; ++m) {
                    const int row = row0 + ai * HALF + m * 16;
                    f32x4 v[2][2];
#pragma unroll
                    for (int bj = 0; bj < 2; ++bj)
#pragma unroll
                        for (int n = 0; n < 2; ++n) v[bj][n] = acc[ai][bj][m][n];
                    if (ropew) {
                        const int pos = samp ? (PAST + (row & 15)) : row;
                        const f32x4* cp = (const f32x4*)(rope + (size_t)pos * 16);
                        const f32x4 cs[2] = {cp[0], cp[1]}, sn[2] = {cp[2], cp[3]};
#pragma unroll
                        for (int bj = 0; bj < 2; ++bj)
#pragma unroll
                            for (int n = 0; n < 2; ++n)
#pragma unroll
                                for (int e = 0; e < 4; ++e) {
                                    const float x = v[bj][n][e], p = __shfl_xor(x, 16);
                                    const float sgn = (fq == 0) ? -sn[n][e] : sn[n][e];
                                    const float rot = x * cs[n][e] + p * sgn;
                                    v[bj][n][e] = (fq < 2) ? rot : x;
                                }
                    }
                    if (type == 0) {
#pragma unroll
                        for (int bj = 0; bj < 2; ++bj) {
                            u32x4 w; w.x = cvt_pk_bf16(v[bj][0][0] * C2, v[bj][0][1] * C2); w.y = cvt_pk_bf16(v[bj][0][2] * C2, v[bj][0][3] * C2);
                            w.z = cvt_pk_bf16(v[bj][1][0] * C2, v[bj][1][1] * C2); w.w = cvt_pk_bf16(v[bj][1][2] * C2, v[bj][1][3] * C2);
                            *(u32x4*)(Qb + (size_t)row * DM + col0 + bj * HALF) = w;
                        }
                    } else {
                        float* kp = kout + (size_t)row * DM;
#pragma unroll
                        for (int bj = 0; bj < 2; ++bj) {
                            if (samp) { *(f32x4*)(kp + col0 + bj * HALF) = v[bj][0]; *(f32x4*)(kp + col0 + bj * HALF + 4) = v[bj][1]; }
                            if (!samp) {
                                u32x4 w; w.x = cvt_pk_bf16(v[bj][0][0], v[bj][0][1]); w.y = cvt_pk_bf16(v[bj][0][2], v[bj][0][3]);
                                w.z = cvt_pk_bf16(v[bj][1][0], v[bj][1][1]); w.w = cvt_pk_bf16(v[bj][1][2], v[bj][1][3]);
                                *(u32x4*)(Kp + (size_t)row * DM + col0 + bj * HALF) = w;
                            }
                        }
                    }
                }
        } else if (type == 2) {
#pragma unroll
            for (int ai = 0; ai < 2; ++ai)
#pragma unroll
                for (int m = 0; m < 4; ++m) {
                    const int row = row0 + ai * HALF + m * 16;
                    float* vp = vout + (size_t)row * DM;
#pragma unroll
                    for (int bj = 0; bj < 2; ++bj) {
                        const f32x4 v0 = acc[ai][bj][m][0], v1 = acc[ai][bj][m][1];
                        if (samp) { *(f32x4*)(vp + col0 + bj * HALF) = v0; *(f32x4*)(vp + col0 + bj * HALF + 4) = v1; }
                        if (!samp) {
                            const int c8 = col0 + bj * HALF, hh = c8 >> 7, cc = c8 & 127;
                            bf16_t* vt = Vp + (((size_t)(hh * (SEQ / 64) + (row >> 6)) * 128 + cc) << 6) + (row & 63);
                            vt[0 * 64] = (bf16_t)(cvt_pk_bf16(v0[0], 0.f) & 0xffffu); vt[1 * 64] = (bf16_t)(cvt_pk_bf16(v0[1], 0.f) & 0xffffu);
                            vt[2 * 64] = (bf16_t)(cvt_pk_bf16(v0[2], 0.f) & 0xffffu); vt[3 * 64] = (bf16_t)(cvt_pk_bf16(v0[3], 0.f) & 0xffffu);
                            vt[4 * 64] = (bf16_t)(cvt_pk_bf16(v1[0], 0.f) & 0xffffu); vt[5 * 64] = (bf16_t)(cvt_pk_bf16(v1[1], 0.f) & 0xffffu);
                            vt[6 * 64] = (bf16_t)(cvt_pk_bf16(v1[2], 0.f) & 0xffffu); vt[7 * 64] = (bf16_t)(cvt_pk_bf16(v1[3], 0.f) & 0xffffu);
                        }
                    }
                }
        } else if (type <= 4) {
            bf16_t* O = (type == 3) ? Ub : GVb;
#pragma unroll
            for (int ai = 0; ai < 2; ++ai)
#pragma unroll
                for (int m = 0; m < 4; ++m) {
                    const int row = row0 + ai * HALF + m * 16; float s = 0.f;
#pragma unroll
                    for (int bj = 0; bj < 2; ++bj) {
                        f32x4 v0 = acc[ai][bj][m][0], v1 = acc[ai][bj][m][1];
#pragma unroll
                        for (int e = 0; e < 4; ++e) { v0[e] = geluf_(v0[e]); v1[e] = geluf_(v1[e]); }
                        s += (v0[0] * v0[0] + v0[1] * v0[1]) + (v0[2] * v0[2] + v0[3] * v0[3]) + (v1[0] * v1[0] + v1[1] * v1[1]) + (v1[2] * v1[2] + v1[3] * v1[3]);
                        u32x4 w; w.x = cvt_pk_bf16(v0[0], v0[1]); w.y = cvt_pk_bf16(v0[2], v0[3]); w.z = cvt_pk_bf16(v1[0], v1[1]); w.w = cvt_pk_bf16(v1[2], v1[3]);
                        *(u32x4*)(O + (size_t)row * DM + col0 + bj * HALF) = w;
                    }
                    if (type == 4) { s += __shfl_xor(s, 16); s += __shfl_xor(s, 32); if (fq == 0) SS[(size_t)row * 16 + (u.pn & 3) * 4 + wc] = s; }
                }
        } else {
            bf16_t* O = (type == 5) ? SGA : SGB;
#pragma unroll
            for (int ai = 0; ai < 2; ++ai)
#pragma unroll
                for (int m = 0; m < 4; ++m) {
                    const int row = row0 + ai * HALF + m * 16;
#pragma unroll
                    for (int bj = 0; bj < 2; ++bj) {
                        const f32x4 v0 = acc[ai][bj][m][0], v1 = acc[ai][bj][m][1];
#ifdef EXP_CONST
                        u32x4 w; w.x = 0x3f803f80u; w.y = 0x3f803f80u; w.z = 0x3f803f80u; w.w = 0x3f803f80u; (void)v0; (void)v1;
#else
                        u32x4 w; w.x = cvt_pk_bf16(sigmoidf_(v0[0]), sigmoidf_(v0[1])); w.y = cvt_pk_bf16(sigmoidf_(v0[2]), sigmoidf_(v0[3]));
                        w.z = cvt_pk_bf16(sigmoidf_(v1[0]), sigmoidf_(v1[1])); w.w = cvt_pk_bf16(sigmoidf_(v1[2]), sigmoidf_(v1[3]));
#endif
                        *(u32x4*)(O + (size_t)row * DM + col0 + bj * HALF) = w;
                    }
                }
        }
    }
};
struct EpiGateA {
    static constexpr bool PERM = false, DUAL = false;
    float* T1; const bf16_t* SG;
    __device__ __forceinline__ void operator()(const f32x4 (&acc)[2][2][4][2], const Unit& u, int wr, int wc, int fr, int fq) const {
        const int row0 = u.pm * BM + wr * 64 + fr, col0 = u.pn * BM + wc * 32 + 4 * fq;
#pragma unroll
        for (int ai = 0; ai < 2; ++ai)
#pragma unroll
            for (int m = 0; m < 4; ++m) {
                const size_t ro = (size_t)(row0 + ai * HALF + m * 16) * DM + col0;
#pragma unroll
                for (int bj = 0; bj < 2; ++bj)
#pragma unroll
                    for (int n = 0; n < 2; ++n) {
                        const u32x2 g = *(const u32x2*)(SG + ro + bj * HALF + n * 16); const f32x4 v = acc[ai][bj][m][n];
                        f32x4 o; o[0] = v[0] * bflo(g.x); o[1] = v[1] * bfhi(g.x); o[2] = v[2] * bflo(g.y); o[3] = v[3] * bfhi(g.y);
                        *(f32x4*)(T1 + ro + bj * HALF + n * 16) = o;
                    }
            }
    }
};
struct EpiGateB {
    static constexpr bool PERM = true, DUAL = false;
    const float* T1; const bf16_t* SG; bf16_t* O;
    __device__ __forceinline__ void operator()(const f32x4 (&acc)[2][2][4][2], const Unit& u, int wr, int wc, int fr, int fq) const {
        const int row0 = u.pm * BM + wr * 64 + fr, col0 = u.pn * BM + wc * 32 + 8 * fq;
#pragma unroll
        for (int ai = 0; ai < 2; ++ai)
#pragma unroll
            for (int m = 0; m < 4; ++m) {
                const size_t ro = (size_t)(row0 + ai * HALF + m * 16) * DM + col0;
#pragma unroll
                for (int bj = 0; bj < 2; ++bj) {
                    const u32x4 g = *(const u32x4*)(SG + ro + bj * HALF);
                    const f32x4 t0 = *(const f32x4*)(T1 + ro + bj * HALF), t1 = *(const f32x4*)(T1 + ro + bj * HALF + 4);
                    const f32x4 v0 = acc[ai][bj][m][0], v1 = acc[ai][bj][m][1];
                    u32x4 w;
#ifndef GATEB_MODE
#define GATEB_MODE 0
#endif
                    const float ka = (GATEB_MODE == 2) ? 0.f : 1.f, kb = (GATEB_MODE == 1) ? 0.f : 1.f;
                    w.x = cvt_pk_bf16(ka * t0[0] + kb * v0[0] * bflo(g.x), ka * t0[1] + kb * v0[1] * bfhi(g.x)); w.y = cvt_pk_bf16(ka * t0[2] + kb * v0[2] * bflo(g.y), ka * t0[3] + kb * v0[3] * bfhi(g.y));
                    w.z = cvt_pk_bf16(ka * t1[0] + kb * v1[0] * bflo(g.z), ka * t1[1] + kb * v1[1] * bfhi(g.z)); w.w = cvt_pk_bf16(ka * t1[2] + kb * v1[2] * bflo(g.w), ka * t1[3] + kb * v1[3] * bfhi(g.w));
                    *(u32x4*)(O + ro + bj * HALF) = w;
                }
            }
    }
};
struct EpiGateAB {
    static constexpr bool PERM = true, DUAL = true;
    const bf16_t* SGa; const bf16_t* SGb; bf16_t* O;
    __device__ __forceinline__ void operator()(f32x4 (&acc)[2][2][4][2], const Unit& u, int wr, int wc, int fr, int fq) const {
        const int row0 = u.pm * BM + wr * 64 + fr, col0 = u.pn * BM + wc * 32 + 8 * fq;
#pragma unroll
        for (int ai = 0; ai < 2; ++ai)
#pragma unroll
            for (int m = 0; m < 4; ++m) {
                const size_t ro = (size_t)(row0 + ai * HALF + m * 16) * DM + col0;
#pragma unroll
                for (int bj = 0; bj < 2; ++bj) {
                    const u32x4 gb = *(const u32x4*)(SGb + ro + bj * HALF);
                    f32x4& v0 = acc[ai][bj][m][0]; f32x4& v1 = acc[ai][bj][m][1];
                    if (u.w == 0) {
                        const u32x4 ga = *(const u32x4*)(SGa + ro + bj * HALF);
                        v0[0] *= bflo(ga.x) * __builtin_amdgcn_rcpf(bflo(gb.x)); v0[1] *= bfhi(ga.x) * __builtin_amdgcn_rcpf(bfhi(gb.x));
                        v0[2] *= bflo(ga.y) * __builtin_amdgcn_rcpf(bflo(gb.y)); v0[3] *= bfhi(ga.y) * __builtin_amdgcn_rcpf(bfhi(gb.y));
                        v1[0] *= bflo(ga.z) * __builtin_amdgcn_rcpf(bflo(gb.z)); v1[1] *= bfhi(ga.z) * __builtin_amdgcn_rcpf(bfhi(gb.z));
                        v1[2] *= bflo(ga.w) * __builtin_amdgcn_rcpf(bflo(gb.w)); v1[3] *= bfhi(ga.w) * __builtin_amdgcn_rcpf(bfhi(gb.w));
                    } else {
                        u32x4 w;
                        w.x = cvt_pk_bf16(v0[0] * bflo(gb.x), v0[1] * bfhi(gb.x)); w.y = cvt_pk_bf16(v0[2] * bflo(gb.y), v0[3] * bfhi(gb.y));
                        w.z = cvt_pk_bf16(v1[0] * bflo(gb.z), v1[1] * bfhi(gb.z)); w.w = cvt_pk_bf16(v1[2] * bflo(gb.w), v1[3] * bfhi(gb.w));
                        *(u32x4*)(O + ro + bj * HALF) = w;
                    }
                }
            }
    }
};
}

namespace att {
using bf16x8 = __attribute__((ext_vector_type(8))) short;
using s16x4 = __attribute__((ext_vector_type(4))) short;
using f32x16 = __attribute__((ext_vector_type(16))) float;
using f32x8 = __attribute__((ext_vector_type(8))) float;
using u32x4 = __attribute__((ext_vector_type(4))) unsigned;
constexpr int KVBLK = 64, LDR = 1024;
constexpr int SHM_V = KVBLK * 128 * 2, SHM_K = KVBLK * 128 * 2, SHM_ATTN = 3 * SHM_V + 3 * SHM_K + 8 * 64 * 4;
constexpr float THRL = 8.f;
#define KSWZ(row, colB) ((row) * 256 + ((colB) ^ (((row) & 15) << 4)))
#define SBAR() __builtin_amdgcn_sched_barrier(0)
__device__ __forceinline__ int crow(int r, int hi) { return (r & 3) + 8 * (r >> 2) + 4 * hi; }
__device__ __forceinline__ unsigned cvtpk(float lo, float hi) { return pg8::cvt_pk_bf16(lo, hi); }
__device__ __forceinline__ bf16x8 tobf(f32x8 x) { u32x4 w = {cvtpk(x[0], x[1]), cvtpk(x[2], x[3]), cvtpk(x[4], x[5]), cvtpk(x[6], x[7])}; return *reinterpret_cast<bf16x8*>(&w); }

__device__ __forceinline__ void partialSM(f32x16& p0, f32x16& p1, float& m_reg, float& alpha) {
    float m0 = fmaxf(fmaxf(p0[0], p0[1]), p0[2]), m1 = fmaxf(fmaxf(p0[3], p0[4]), p0[5]), m2 = fmaxf(fmaxf(p1[0], p1[1]), p1[2]), m3 = fmaxf(fmaxf(p1[3], p1[4]), p1[5]);
    m0 = fmaxf(fmaxf(m0, p0[6]), p0[7]); m1 = fmaxf(fmaxf(m1, p0[8]), p0[9]); m2 = fmaxf(fmaxf(m2, p1[6]), p1[7]); m3 = fmaxf(fmaxf(m3, p1[8]), p1[9]);
    m0 = fmaxf(fmaxf(m0, p0[10]), p0[11]); m1 = fmaxf(fmaxf(m1, p0[12]), p0[13]); m2 = fmaxf(fmaxf(m2, p1[10]), p1[11]); m3 = fmaxf(fmaxf(m3, p1[12]), p1[13]);
    m0 = fmaxf(fmaxf(m0, p0[14]), p0[15]); m2 = fmaxf(fmaxf(m2, p1[14]), p1[15]);
    float pmax = fmaxf(fmaxf(m0, m1), fmaxf(m2, m3));
    { auto rr = __builtin_amdgcn_permlane32_swap(__float_as_uint(pmax), __float_as_uint(pmax), false, false);
      pmax = fmaxf(__uint_as_float(rr[0]), __uint_as_float(rr[1])); }
    float mn;
    if (__builtin_expect(__all(pmax - m_reg <= THRL), 1)) { mn = m_reg; alpha = 1.f; }
    else { mn = fmaxf(m_reg, pmax); alpha = __builtin_amdgcn_exp2f(m_reg - mn); m_reg = mn; }
#pragma unroll
    for (int r = 0; r < 16; ++r) p0[r] = p0[r] - mn;
#pragma unroll
    for (int r = 0; r < 16; ++r) p1[r] = p1[r] - mn;
#pragma unroll
    for (int r = 0; r < 16; ++r) p0[r] = __builtin_amdgcn_exp2f(p0[r]);
}
__device__ __forceinline__ void finishSM(f32x16& p0, f32x16& p1, float alpha, float& l_reg, bf16x8& pa0, bf16x8& pa1, bf16x8& pa2, bf16x8& pa3) {
#pragma unroll
    for (int r = 0; r < 16; ++r) p1[r] = __builtin_amdgcn_exp2f(p1[r]);
    float s0 = p0[0] + p0[1], s1 = p0[2] + p0[3], s2 = p1[0] + p1[1], s3 = p1[2] + p1[3];
#pragma unroll
    for (int r = 4; r < 16; r += 2) { if (r & 2) { s1 += p0[r] + p0[r + 1]; s3 += p1[r] + p1[r + 1]; } else { s0 += p0[r] + p0[r + 1]; s2 += p1[r] + p1[r + 1]; } }
    float ps = (s0 + s1) + (s2 + s3);
    { auto rr = __builtin_amdgcn_permlane32_swap(__float_as_uint(ps), __float_as_uint(ps), false, false);
      ps = __uint_as_float(rr[0]) + __uint_as_float(rr[1]); }
    l_reg = l_reg * alpha + ps;
#define PK4(P, BASE, OUT) do { unsigned a0 = cvtpk(P[BASE + 0], P[BASE + 1]), a1 = cvtpk(P[BASE + 2], P[BASE + 3]);   \
    unsigned b0 = cvtpk(P[BASE + 4], P[BASE + 5]), b1 = cvtpk(P[BASE + 6], P[BASE + 7]);                              \
    auto r0 = __builtin_amdgcn_permlane32_swap(a0, b0, false, false); auto r1 = __builtin_amdgcn_permlane32_swap(a1, b1, false, false); \
    u32x4 w = {r0[0], r1[0], r0[1], r1[1]}; OUT = *reinterpret_cast<bf16x8*>(&w); } while (0)
    PK4(p0, 0, pa0); PK4(p0, 8, pa1); PK4(p1, 0, pa2); PK4(p1, 8, pa3);
#undef PK4
}
__device__ __forceinline__ void qkt(f32x16& p0, f32x16& p1, const char* Ks, const bf16x8* qr, int r32, int hi, int sub) {
    p0 = f32x16{}; p1 = f32x16{};
#pragma unroll
    for (int d0 = 0; d0 < 4; ++d0) { const int cb = (sub * 64 + d0 * 16 + hi * 8) * 2;
        const bf16x8 b0 = *reinterpret_cast<const bf16x8*>(Ks + KSWZ(r32, cb));
        const bf16x8 b1 = *reinterpret_cast<const bf16x8*>(Ks + KSWZ(32 + r32, cb));
        p0 = __builtin_amdgcn_mfma_f32_32x32x16_bf16(b0, qr[d0], p0, 0, 0, 0);
        p1 = __builtin_amdgcn_mfma_f32_32x32x16_bf16(b1, qr[d0], p1, 0, 0, 0); }
}
__device__ __forceinline__ int v_st(int k, int c) { const int kk = (k & ~0xC) | ((k & 4) << 1) | ((k & 8) >> 1); return ((kk >> 3) * 4 + (c >> 5)) * 512 + ((kk & 7) * 32 + (c & 31)) * 2; }
__device__ __forceinline__ int v_rd_base(int lane) { return ((lane & 3) << 3) | (((lane >> 2) & 3) << 6) | (((lane >> 4) & 1) << 5) | (((lane >> 5) & 1) << 8); }
constexpr int v_rd_off(int d0, int ks, int half) { return d0 * 512 + ks * 4096 + half * 2048; }
typedef short v4i16_t __attribute__((ext_vector_type(4)));
typedef __attribute__((address_space(3))) const char* lds_cptr;
template <int OFF> __device__ __forceinline__ s16x4 tr_read(lds_cptr vp) {
    return __builtin_bit_cast(s16x4, __builtin_amdgcn_ds_read_tr16_b64_v4i16((__attribute__((address_space(3))) v4i16_t*)(vp + OFF)));
}
template <int D0> __device__ __forceinline__ void pv_one(f32x16& od, lds_cptr vb, bf16x8 pa0, bf16x8 pa1, bf16x8 pa2, bf16x8 pa3) {
    const s16x4 l0 = tr_read<v_rd_off(D0, 0, 0)>(vb), h0 = tr_read<v_rd_off(D0, 0, 1)>(vb), l1 = tr_read<v_rd_off(D0, 1, 0)>(vb), h1 = tr_read<v_rd_off(D0, 1, 1)>(vb);
    const s16x4 l2 = tr_read<v_rd_off(D0, 2, 0)>(vb), h2 = tr_read<v_rd_off(D0, 2, 1)>(vb), l3 = tr_read<v_rd_off(D0, 3, 0)>(vb), h3 = tr_read<v_rd_off(D0, 3, 1)>(vb);
#define PK(L, H) (bf16x8){L[0], L[1], L[2], L[3], H[0], H[1], H[2], H[3]}
    od = __builtin_amdgcn_mfma_f32_32x32x16_bf16(pa0, PK(l0, h0), od, 0, 0, 0);
    od = __builtin_amdgcn_mfma_f32_32x32x16_bf16(pa1, PK(l1, h1), od, 0, 0, 0);
    od = __builtin_amdgcn_mfma_f32_32x32x16_bf16(pa2, PK(l2, h2), od, 0, 0, 0);
    od = __builtin_amdgcn_mfma_f32_32x32x16_bf16(pa3, PK(l3, h3), od, 0, 0, 0);
#undef PK
}
__device__ __forceinline__ void pv_t(f32x16* o, const char* vt, const int* ko, bf16x8 pa0, bf16x8 pa1, bf16x8 pa2, bf16x8 pa3) {
#pragma unroll
    for (int d0 = 0; d0 < 4; ++d0) {
        const bf16x8 b0 = *reinterpret_cast<const bf16x8*>(vt + d0 * 4096 + ko[0]), b1 = *reinterpret_cast<const bf16x8*>(vt + d0 * 4096 + ko[1]);
        const bf16x8 b2 = *reinterpret_cast<const bf16x8*>(vt + d0 * 4096 + ko[2]), b3 = *reinterpret_cast<const bf16x8*>(vt + d0 * 4096 + ko[3]);
        o[d0] = __builtin_amdgcn_mfma_f32_32x32x16_bf16(pa0, b0, o[d0], 0, 0, 0);
        o[d0] = __builtin_amdgcn_mfma_f32_32x32x16_bf16(pa1, b1, o[d0], 0, 0, 0);
        o[d0] = __builtin_amdgcn_mfma_f32_32x32x16_bf16(pa2, b2, o[d0], 0, 0, 0);
        o[d0] = __builtin_amdgcn_mfma_f32_32x32x16_bf16(pa3, b3, o[d0], 0, 0, 0);
    }
}
__device__ __forceinline__ void pv_d0(f32x16* o, lds_cptr vb, bf16x8 pa0, bf16x8 pa1, bf16x8 pa2, bf16x8 pa3) {
    pv_one<0>(o[0], vb, pa0, pa1, pa2, pa3); pv_one<1>(o[1], vb, pa0, pa1, pa2, pa3); pv_one<2>(o[2], vb, pa0, pa1, pa2, pa3); pv_one<3>(o[3], vb, pa0, pa1, pa2, pa3);
}

struct Args {
    const unsigned short* Qb; const unsigned short* Kp; const unsigned short* Vp;
    const float* cK; const float* cV;
    const float* nK; const float* nV;
    unsigned short* ATT; const float* gsub;
    const unsigned short* Qs; unsigned short* ATTs;
    float* kpo; float* vpo;
};

template <bool SAMPLE>
__device__ __forceinline__ void attn_unit(const Args& A, int h, int qi, char* lds, float lam) {
    asm volatile("" : "+s"(h), "+s"(qi));
    int tid = threadIdx.x; asm volatile("" : "+v"(tid));
    const int lane = tid & 63, r32 = lane & 31, hi = lane >> 5;
    const int wid = __builtin_amdgcn_readfirstlane(tid >> 6), sub = wid >> 2, rg = wid & 3;
    char* V_lds = lds; char* K_lds = lds + 2 * SHM_V;
    float* ws = (float*)(lds + 3 * SHM_V + 3 * SHM_K) + wid * 64; float* li_l = ws; float* al_l = ws + 32;
    const int NT = SAMPLE ? 33 : 2 * qi + 2;
    float m_reg = -1e30f, l_reg = 0; f32x16 o[4] = {}; bf16x8 qr[4];
    {
        const int qrow = SAMPLE ? (qi * 16 + (r32 & 15)) : (qi * 128 + rg * 32 + r32);
        const unsigned short* Qw = (SAMPLE ? A.Qs : A.Qb) + (size_t)qrow * LDR + h * 128 + sub * 64 + hi * 8;
#pragma unroll
        for (int d0 = 0; d0 < 4; ++d0) qr[d0] = *reinterpret_cast<const bf16x8*>(Qw + d0 * 16);
    }
    const int sr = tid >> 4, sc = (tid & 15) * 8;
    const int vcol0 = tid >> 3, vcol1 = 64 + (tid >> 3), vch = tid & 7;
    const int vst0 = SAMPLE ? v_st(sr, sc) : vcol0 * 128 + ((vch ^ ((vcol0 >> 1) & 7)) << 4), vst1 = SAMPLE ? v_st(32 + sr, sc) : vcol1 * 128 + ((vch ^ ((vcol1 >> 1) & 7)) << 4);
    const lds_cptr vb0 = (lds_cptr)V_lds + v_rd_base(lane);
    const char* vtb = V_lds + r32 * 128; int vko[4];
#pragma unroll
    for (int ks = 0; ks < 4; ++ks) vko[ks] = ((2 * ks + hi) ^ ((r32 >> 1) & 7)) << 4;
    constexpr int SDEPTH = SAMPLE ? 2 : 1;
    using ST = typename std::conditional<SAMPLE, f32x8, bf16x8>::type;
    struct { ST vs0, vs1, ks0, ks1; } sr_[SDEPTH];
    constexpr unsigned ESZ = SAMPLE ? 4u : 2u;
    const unsigned lo0 = (unsigned)(sr * LDR + sc) * ESZ, lo1 = lo0 + 32u * LDR * ESZ, lon = (unsigned)((sr & 15) * LDR + sc) * 4u;
    const __amdgpu_buffer_rsrc_t rK = __builtin_amdgcn_make_buffer_rsrc((void*)(SAMPLE ? (const void*)A.cK : (const void*)A.Kp), 0, SAMPLE ? 16 * PAST * LDR * 4 : SEQ * LDR * 2, 0x00020000);
    const __amdgpu_buffer_rsrc_t rV = __builtin_amdgcn_make_buffer_rsrc((void*)(SAMPLE ? (const void*)A.cV : (const void*)A.Vp), 0, SAMPLE ? 16 * PAST * LDR * 4 : SEQ * LDR * 2, 0x00020000);
    const __amdgpu_buffer_rsrc_t rKn = __builtin_amdgcn_make_buffer_rsrc((void*)A.nK, 0, 256 * LDR * 4, 0x00020000);
    const __amdgpu_buffer_rsrc_t rVn = __builtin_amdgcn_make_buffer_rsrc((void*)A.nV, 0, 256 * LDR * 4, 0x00020000);
    const unsigned sbase = SAMPLE ? (unsigned)((qi * PAST * LDR + h * 128) * 4) : (unsigned)(h * 256), sbn = (unsigned)((qi * 16 * LDR + h * 128) * 4);
    const unsigned vl0 = (unsigned)tid * 16u, vl1 = vl0 + 8192u, vsb = (unsigned)h * (unsigned)(SEQ / 64) * 16384u;
    auto cv = [](ST x) -> bf16x8 { if constexpr (SAMPLE) return tobf(x); else return x; };
    auto bld = [](__amdgpu_buffer_rsrc_t r, unsigned vo, unsigned so) -> ST {
        if constexpr (SAMPLE) { const u32x4 a = __builtin_amdgcn_raw_buffer_load_b128(r, vo, so, 0), b = __builtin_amdgcn_raw_buffer_load_b128(r, vo + 16u, so, 0);
            f32x8 o; o[0] = __uint_as_float(a[0]); o[1] = __uint_as_float(a[1]); o[2] = __uint_as_float(a[2]); o[3] = __uint_as_float(a[3]);
            o[4] = __uint_as_float(b[0]); o[5] = __uint_as_float(b[1]); o[6] = __uint_as_float(b[2]); o[7] = __uint_as_float(b[3]); return o; }
        else { const u32x4 a = __builtin_amdgcn_raw_buffer_load_b128(r, vo, so, 0); return __builtin_bit_cast(bf16x8, a); }
    };
#define SLOAD(i, t) do { if (SAMPLE && (t) >= 32) { \
        sr_[i].vs0 = bld(rVn, lon, sbn); sr_[i].vs1 = sr_[i].vs0; sr_[i].ks0 = bld(rKn, lon, sbn); sr_[i].ks1 = sr_[i].ks0; \
    } else { const unsigned so_ = sbase + (unsigned)(t) * (64u * LDR * ESZ); \
        if constexpr (SAMPLE) { sr_[i].vs0 = bld(rV, lo0, so_); sr_[i].vs1 = bld(rV, lo1, so_); } else { const unsigned sv_ = vsb + (unsigned)(t) * 16384u; sr_[i].vs0 = bld(rV, vl0, sv_); sr_[i].vs1 = bld(rV, vl1, sv_); } \
        sr_[i].ks0 = bld(rK, lo0, so_); sr_[i].ks1 = bld(rK, lo1, so_); } } while (0)
#define SWRITE(b, i) do { *(bf16x8*)(V_lds + (b) * SHM_V + vst0) = cv(sr_[i].vs0);          \
    *(bf16x8*)(V_lds + (b) * SHM_V + vst1) = cv(sr_[i].vs1); const int kc = sc * 2;               \
    *(bf16x8*)(K_lds + (b) * SHM_K + KSWZ(sr, kc)) = cv(sr_[i].ks0);                       \
    *(bf16x8*)(K_lds + (b) * SHM_K + KSWZ(32 + sr, kc)) = cv(sr_[i].ks1); } while (0)
#define SWAIT() do { if constexpr (SDEPTH == 2) asm volatile("s_waitcnt vmcnt(4)" ::: "memory"); else asm volatile("s_waitcnt vmcnt(0)" ::: "memory"); } while (0)
#define RESC(a) do { if (__any((a) < 1.f)) { if (hi == 0) al_l[r32] = (a); asm volatile("s_waitcnt lgkmcnt(0)" ::: "memory"); \
    _Pragma("unroll") for (int d = 0; d < 4; ++d) _Pragma("unroll") for (int r = 0; r < 16; ++r) o[d][r] *= al_l[crow(r, hi)]; } } while (0)
#define MASK(P0, P1, t) do { if constexpr (SAMPLE) { if ((t) >= 32) { _Pragma("unroll") for (int r = 0; r < 16; ++r) { if (crow(r, hi) >= 16) P0[r] = -INFINITY; P1[r] = -INFINITY; } } } \
    else { if ((t) == NT - 1 && rg < 2) { _Pragma("unroll") for (int r = 0; r < 16; ++r) { P0[r] = -INFINITY; P1[r] = -INFINITY; } } } } while (0)
    bf16x8 pa0, pa1, pa2, pa3;
    if constexpr (SAMPLE) {
        f32x16 pA0, pA1; float alA = 1.f;
        SLOAD(0, 0); SLOAD(1, 1);
#define STILE(t, SL) do { SWRITE(SL, SL); if ((t) + 2 < NT) SLOAD(SL, (t) + 2); __syncthreads(); \
            if (rg == 0) { SBAR(); qkt(pA0, pA1, K_lds + (SL) * SHM_K, qr, r32, hi, sub); MASK(pA0, pA1, t); partialSM(pA0, pA1, m_reg, alA); RESC(alA); \
                finishSM(pA0, pA1, alA, l_reg, pa0, pa1, pa2, pa3); SBAR(); pv_d0(o, vb0 + (SL) * SHM_V, pa0, pa1, pa2, pa3); } } while (0)
        for (int t = 0; t + 1 < NT; t += 2) { STILE(t, 0); STILE(t + 1, 1); }
        STILE(NT - 1, 0);
#undef STILE
        __syncthreads();
    } else {
    const int n16 = lane & 15, g4 = lane >> 4;
    f32x4 O[2][8], S0[2][2], S1[2][2], negm[2]; float mq[2] = {0.f, 0.f}, lq[2] = {0.f, 0.f}, pmx[2] = {0.f, 0.f};
    bf16x8 Q[2][2], kf[2][2], vf[8], PA[2], PB[2];
#pragma unroll
    for (int qb = 0; qb < 2; ++qb) {
#pragma unroll
        for (int cb = 0; cb < 8; ++cb) O[qb][cb] = (f32x4){0.f, 0.f, 0.f, 0.f};
        negm[qb] = (f32x4){0.f, 0.f, 0.f, 0.f};
#pragma unroll
        for (int ks = 0; ks < 2; ++ks) Q[qb][ks] = *reinterpret_cast<const bf16x8*>(A.Qb + (size_t)(qi * 128 + rg * 32 + 16 * qb + n16) * LDR + h * 128 + sub * 64 + 32 * ks + 8 * g4);
    }
    const int grp = sub;
#define FSW_(r) ((((r) & 8)) | (((r) & 3) << 1) | (((r) >> 2) & 1))
    const int key0 = 8 * (n16 >> 2) + (n16 & 3), key1 = key0 + 4;
    const int kof0 = key0 * 256, kof1 = key1 * 256, kfx0 = FSW_(key0 & 15), kfx1 = FSW_(key1 & 15);
    const int vof = n16 * 128, vsw = (n16 >> 1) & 7;
    typedef __attribute__((address_space(3))) unsigned lds_u;
    char* Kr = lds + 3 * SHM_V;
    int so_p = 2 * SHM_K, so_c = 0, so_n = SHM_K;
    const int krow0 = 8 * wid + (lane >> 4), krow1 = krow0 + 4, vcl0 = 16 * wid + (lane >> 3), vcl1 = vcl0 + 8;
    const unsigned kdo0 = (unsigned)krow0 * (LDR * 2u) + (unsigned)(((lane & 15) ^ FSW_(krow0 & 15)) << 4), kdo1 = (unsigned)krow1 * (LDR * 2u) + (unsigned)(((lane & 15) ^ FSW_(krow1 & 15)) << 4);
    const unsigned vdo0 = (unsigned)vcl0 * 128u + (unsigned)(((lane & 7) ^ ((vcl0 >> 1) & 7)) << 4), vdo1 = (unsigned)vcl1 * 128u + (unsigned)(((lane & 7) ^ ((vcl1 >> 1) & 7)) << 4);
#define KDMA_(t, so) do { const unsigned s_ = sbase + (unsigned)(t) * (64u * LDR * 2u); \
        __builtin_amdgcn_raw_ptr_buffer_load_lds(rK, (lds_u*)(Kr + (so) + wid * 2048), 16, kdo0, s_, 0, 0); \
        __builtin_amdgcn_raw_ptr_buffer_load_lds(rK, (lds_u*)(Kr + (so) + wid * 2048 + 1024), 16, kdo1, s_, 0, 0); } while (0)
#define VDMA_(t, so) do { const unsigned s_ = vsb + (unsigned)(t) * 16384u; \
        __builtin_amdgcn_raw_ptr_buffer_load_lds(rV, (lds_u*)(V_lds + (so) + wid * 2048), 16, vdo0, s_, 0, 0); \
        __builtin_amdgcn_raw_ptr_buffer_load_lds(rV, (lds_u*)(V_lds + (so) + wid * 2048 + 1024), 16, vdo1, s_, 0, 0); } while (0)
#define DST_(t) do { if ((t) + 3 < NT) KDMA_((t) + 3, so_c); if ((t) + 2 < NT) VDMA_((t) + 2, so_p); } while (0)
#define WAITV_(t) do { if ((t) + 2 < NT) asm volatile("s_waitcnt vmcnt(4)" ::: "memory"); else asm volatile("s_waitcnt vmcnt(0)" ::: "memory"); } while (0)
#define ROT_() do { const int t_ = so_p; so_p = so_c; so_c = so_n; so_n = t_; } while (0)
#define MEET_() do { asm volatile("s_waitcnt lgkmcnt(0)" ::: "memory"); __builtin_amdgcn_s_barrier(); asm volatile("" ::: "memory"); } while (0)
#define LSEG(HAVE_K, KSO, KH, HAVE_V, VSO, VH, STG, WT) do { \
        if (HAVE_K) { const char* kb_ = Kr + (KSO) + 32 * (KH) * 256; \
            _Pragma("unroll") for (int ks = 0; ks < 2; ++ks) { kf[0][ks] = *reinterpret_cast<const bf16x8*>(kb_ + kof0 + (((sub * 8 + 4 * ks + g4) ^ kfx0) << 4)); \
                                                                 kf[1][ks] = *reinterpret_cast<const bf16x8*>(kb_ + kof1 + (((sub * 8 + 4 * ks + g4) ^ kfx1) << 4)); } } \
        if (HAVE_V) { const char* vb_ = V_lds + (VSO) + vof + (((4 * (VH) + g4) ^ vsw) << 4); \
            _Pragma("unroll") for (int cb = 0; cb < 8; ++cb) vf[cb] = *reinterpret_cast<const bf16x8*>(vb_ + cb * 2048); } \
        STG; \
        if ((WT) >= 0 && grp == 1) WAITV_(WT); \
        MEET_(); } while (0)
#define HEAD_(FIRST, SC) do { ok_ = (FIRST) ? false : (bool)__all(fmaxf(pmx[0], pmx[1]) <= THRL); \
        if (__builtin_expect(!ok_, 0)) { _Pragma("unroll") for (int qb = 0; qb < 2; ++qb) { float v_ = pmx[qb]; v_ = fmaxf(v_, __shfl_xor(v_, 16)); v_ = fmaxf(v_, __shfl_xor(v_, 32)); \
                dl[qb] = (FIRST) ? v_ : fmaxf(v_, 0.f); mq[qb] += dl[qb]; al[qb] = (FIRST) ? 1.f : __builtin_amdgcn_exp2f(-dl[qb]); lq[qb] *= al[qb]; \
                _Pragma("unroll") for (int kb = 0; kb < 2; ++kb) _Pragma("unroll") for (int j = 0; j < 4; ++j) SC[qb][kb][j] -= dl[qb]; } } } while (0)
#define GQ_(HAVE, X) do { SBAR(); if (HAVE) { X; } SBAR(); } while (0)
#define CSEG(HAVE_QK, HAVE_PV, HAVE_SM, FIRST, SC, SN, PR, PW, WT) do { \
        bool ok_ = true; unsigned cw_[2][4] = {{0, 0, 0, 0}, {0, 0, 0, 0}}; float dl[2] = {0.f, 0.f}, al[2] = {1.f, 1.f}; \
        __builtin_amdgcn_s_setprio(2); \
        GQ_(HAVE_QK, SN[0][0] = __builtin_amdgcn_mfma_f32_16x16x32_bf16(kf[0][0], Q[0][0], negm[0], 0, 0, 0)); if (HAVE_SM) { HEAD_(FIRST, SC); SC[0][0][0] = __builtin_amdgcn_exp2f(SC[0][0][0]); } \
        GQ_(HAVE_QK, SN[0][1] = __builtin_amdgcn_mfma_f32_16x16x32_bf16(kf[1][0], Q[0][0], negm[0], 0, 0, 0)); if (HAVE_SM) { SC[0][0][1] = __builtin_amdgcn_exp2f(SC[0][0][1]); } \
        GQ_(HAVE_QK, SN[1][0] = __builtin_amdgcn_mfma_f32_16x16x32_bf16(kf[0][0], Q[1][0], negm[1], 0, 0, 0)); if (HAVE_SM) { SC[0][0][2] = __builtin_amdgcn_exp2f(SC[0][0][2]); } \
        GQ_(HAVE_QK, SN[1][1] = __builtin_amdgcn_mfma_f32_16x16x32_bf16(kf[1][0], Q[1][0], negm[1], 0, 0, 0)); if (HAVE_SM) { SC[0][0][3] = __builtin_amdgcn_exp2f(SC[0][0][3]); } \
        GQ_(HAVE_QK, SN[0][0] = __builtin_amdgcn_mfma_f32_16x16x32_bf16(kf[0][1], Q[0][1], SN[0][0], 0, 0, 0)); if (HAVE_SM) { SC[0][1][0] = __builtin_amdgcn_exp2f(SC[0][1][0]); } \
        GQ_(HAVE_QK, SN[0][1] = __builtin_amdgcn_mfma_f32_16x16x32_bf16(kf[1][1], Q[0][1], SN[0][1], 0, 0, 0)); if (HAVE_SM) { SC[0][1][1] = __builtin_amdgcn_exp2f(SC[0][1][1]); } \
        GQ_(HAVE_QK, SN[1][0] = __builtin_amdgcn_mfma_f32_16x16x32_bf16(kf[0][1], Q[1][1], SN[1][0], 0, 0, 0)); if (HAVE_SM) { SC[0][1][2] = __builtin_amdgcn_exp2f(SC[0][1][2]); } \
        GQ_(HAVE_QK, SN[1][1] = __builtin_amdgcn_mfma_f32_16x16x32_bf16(kf[1][1], Q[1][1], SN[1][1], 0, 0, 0)); if (HAVE_SM) { SC[0][1][3] = __builtin_amdgcn_exp2f(SC[0][1][3]); } \
        GQ_(HAVE_PV, O[0][0] = __builtin_amdgcn_mfma_f32_16x16x32_bf16(PR[0], vf[0], O[0][0], 0, 0, 0)); if (HAVE_SM) { SC[1][0][0] = __builtin_amdgcn_exp2f(SC[1][0][0]); } \
        GQ_(HAVE_PV, O[0][1] = __builtin_amdgcn_mfma_f32_16x16x32_bf16(PR[0], vf[1], O[0][1], 0, 0, 0)); if (HAVE_SM) { SC[1][0][1] = __builtin_amdgcn_exp2f(SC[1][0][1]); } \
        GQ_(HAVE_PV, O[0][2] = __builtin_amdgcn_mfma_f32_16x16x32_bf16(PR[0], vf[2], O[0][2], 0, 0, 0)); if (HAVE_SM) { SC[1][0][2] = __builtin_amdgcn_exp2f(SC[1][0][2]); } \
        GQ_(HAVE_PV, O[0][3] = __builtin_amdgcn_mfma_f32_16x16x32_bf16(PR[0], vf[3], O[0][3], 0, 0, 0)); if (HAVE_SM) { SC[1][0][3] = __builtin_amdgcn_exp2f(SC[1][0][3]); } \
        GQ_(HAVE_PV, O[0][4] = __builtin_amdgcn_mfma_f32_16x16x32_bf16(PR[0], vf[4], O[0][4], 0, 0, 0)); if (HAVE_SM) { SC[1][1][0] = __builtin_amdgcn_exp2f(SC[1][1][0]); } \
        GQ_(HAVE_PV, O[0][5] = __builtin_amdgcn_mfma_f32_16x16x32_bf16(PR[0], vf[5], O[0][5], 0, 0, 0)); if (HAVE_SM) { SC[1][1][1] = __builtin_amdgcn_exp2f(SC[1][1][1]); } \
        GQ_(HAVE_PV, O[0][6] = __builtin_amdgcn_mfma_f32_16x16x32_bf16(PR[0], vf[6], O[0][6], 0, 0, 0)); if (HAVE_SM) { SC[1][1][2] = __builtin_amdgcn_exp2f(SC[1][1][2]); } \
        GQ_(HAVE_PV, O[0][7] = __builtin_amdgcn_mfma_f32_16x16x32_bf16(PR[0], vf[7], O[0][7], 0, 0, 0)); if (HAVE_SM) { SC[1][1][3] = __builtin_amdgcn_exp2f(SC[1][1][3]); } \
        GQ_(HAVE_PV, O[1][0] = __builtin_amdgcn_mfma_f32_16x16x32_bf16(PR[1], vf[0], O[1][0], 0, 0, 0)); if (HAVE_SM) { cw_[0][0] = cvtpk(SC[0][0][0], SC[0][0][1]); cw_[0][1] = cvtpk(SC[0][0][2], SC[0][0][3]); } \
        GQ_(HAVE_PV, O[1][1] = __builtin_amdgcn_mfma_f32_16x16x32_bf16(PR[1], vf[1], O[1][1], 0, 0, 0)); if (HAVE_SM) { cw_[0][2] = cvtpk(SC[0][1][0], SC[0][1][1]); cw_[0][3] = cvtpk(SC[0][1][2], SC[0][1][3]); } \
        GQ_(HAVE_PV, O[1][2] = __builtin_amdgcn_mfma_f32_16x16x32_bf16(PR[1], vf[2], O[1][2], 0, 0, 0)); if (HAVE_SM) { cw_[1][0] = cvtpk(SC[1][0][0], SC[1][0][1]); cw_[1][1] = cvtpk(SC[1][0][2], SC[1][0][3]); } \
        GQ_(HAVE_PV, O[1][3] = __builtin_amdgcn_mfma_f32_16x16x32_bf16(PR[1], vf[3], O[1][3], 0, 0, 0)); if (HAVE_SM) { cw_[1][2] = cvtpk(SC[1][1][0], SC[1][1][1]); cw_[1][3] = cvtpk(SC[1][1][2], SC[1][1][3]); } \
        GQ_(HAVE_PV, O[1][4] = __builtin_amdgcn_mfma_f32_16x16x32_bf16(PR[1], vf[4], O[1][4], 0, 0, 0)); if (HAVE_SM) { u32x4 w0_ = {cw_[0][0], cw_[0][1], cw_[0][2], cw_[0][3]}; u32x4 w1_ = {cw_[1][0], cw_[1][1], cw_[1][2], cw_[1][3]}; asm volatile("" : "+v"(w0_), "+v"(w1_)); PW[0] = *reinterpret_cast<bf16x8*>(&w0_); PW[1] = *reinterpret_cast<bf16x8*>(&w1_); }     \
        GQ_(HAVE_PV, O[1][5] = __builtin_amdgcn_mfma_f32_16x16x32_bf16(PR[1], vf[5], O[1][5], 0, 0, 0)); if (HAVE_QK) { pmx[0] = fmaxf(fmaxf(fmaxf(fmaxf(SN[0][0][0], SN[0][0][1]), SN[0][0][2]), fmaxf(fmaxf(SN[0][0][3], SN[0][1][0]), SN[0][1][1])), fmaxf(SN[0][1][2], SN[0][1][3])); } \
        GQ_(HAVE_PV, O[1][6] = __builtin_amdgcn_mfma_f32_16x16x32_bf16(PR[1], vf[6], O[1][6], 0, 0, 0)); if (HAVE_QK) { pmx[1] = fmaxf(fmaxf(fmaxf(fmaxf(SN[1][0][0], SN[1][0][1]), SN[1][0][2]), fmaxf(fmaxf(SN[1][0][3], SN[1][1][0]), SN[1][1][1])), fmaxf(SN[1][1][2], SN[1][1][3])); } \
        GQ_(HAVE_PV, O[1][7] = __builtin_amdgcn_mfma_f32_16x16x32_bf16(PR[1], vf[7], O[1][7], 0, 0, 0)); if (HAVE_SM) { lq[0] += ((SC[0][0][0] + SC[0][0][1]) + (SC[0][0][2] + SC[0][0][3])) + ((SC[0][1][0] + SC[0][1][1]) + (SC[0][1][2] + SC[0][1][3])); lq[1] += ((SC[1][0][0] + SC[1][0][1]) + (SC[1][0][2] + SC[1][0][3])) + ((SC[1][1][0] + SC[1][1][1]) + (SC[1][1][2] + SC[1][1][3])); } \
        SBAR(); \
        if (HAVE_SM) { if (__builtin_expect(!ok_, 0)) { \
            if (!(FIRST)) { if (g4 == 0) { al_l[n16] = al[0]; al_l[16 + n16] = al[1]; } asm volatile("s_waitcnt lgkmcnt(0)" ::: "memory"); \
                _Pragma("unroll") for (int qb = 0; qb < 2; ++qb) { const f32x4 a4_ = *reinterpret_cast<const f32x4*>(al_l + 16 * qb + 4 * g4); \
                    _Pragma("unroll") for (int cb = 0; cb < 8; ++cb) O[qb][cb] *= a4_; } } \
            _Pragma("unroll") for (int qb = 0; qb < 2; ++qb) { \
                if (HAVE_QK) { SN[qb][0] -= dl[qb]; SN[qb][1] -= dl[qb]; pmx[qb] -= dl[qb]; } \
                negm[qb] = (f32x4){-mq[qb], -mq[qb], -mq[qb], -mq[qb]}; } } } \
        __builtin_amdgcn_s_setprio(0); if ((WT) >= 0 && grp == 0) WAITV_(WT); MEET_(); } while (0)
    KDMA_(0, 0); VDMA_(0, 0); KDMA_(1, SHM_K); VDMA_(1, SHM_V); if (2 < NT) KDMA_(2, 2 * SHM_K);
    asm volatile("s_waitcnt vmcnt(0)" ::: "memory");
    MEET_();
    if (grp == 1) MEET_();
    LSEG(true, 0, 0, false, 0, 0, (void)0, -1);             CSEG(true, false, false, false, S1, S0, PB, PA, -1);
    LSEG(true, so_c, 1, false, 0, 0, (void)0, 0);           CSEG(true, false, true, true, S0, S1, PB, PA, 0);
    LSEG(true, so_n, 0, true, so_c, 0, DST_(0), -1);        CSEG(true, true, true, false, S1, S0, PA, PB, -1);
    ROT_();
#pragma clang loop unroll(disable)
    for (int t = 1; t < NT - 1; ++t) {
        LSEG(true, so_c, 1, true, so_p, 1, (void)0, t);     CSEG(true, true, true, false, S0, S1, PB, PA, t);
        LSEG(true, so_n, 0, true, so_c, 0, DST_(t), -1);    CSEG(true, true, true, false, S1, S0, PA, PB, -1);
        ROT_();
    }
    if (rg < 2) {
        LSEG(false, 0, 0, true, so_p, 1, (void)0, NT - 1);  CSEG(false, true, false, false, S0, S1, PB, PA, NT - 1);
        LSEG(false, 0, 0, false, 0, 0, (void)0, -1);        CSEG(false, false, false, false, S0, S1, PB, PA, -1);
        LSEG(false, 0, 0, false, 0, 0, (void)0, -1);        CSEG(false, false, false, false, S0, S1, PB, PA, -1);
    } else {
        LSEG(true, so_c, 1, true, so_p, 1, (void)0, NT - 1); CSEG(true, true, true, false, S0, S1, PB, PA, NT - 1);
        LSEG(false, 0, 0, true, so_c, 0, (void)0, -1);       CSEG(false, true, true, false, S1, S0, PA, PB, -1);
        LSEG(false, 0, 0, true, so_c, 1, (void)0, -1);       CSEG(false, true, false, false, S0, S1, PB, PA, -1);
    }
    if (grp == 0) MEET_();
#pragma unroll
    for (int qb = 0; qb < 2; ++qb) { lq[qb] += __shfl_xor(lq[qb], 16); lq[qb] += __shfl_xor(lq[qb], 32); }
    if (g4 == 0) { li_l[n16] = lq[0]; li_l[16 + n16] = lq[1]; }
    asm volatile("s_waitcnt lgkmcnt(0)" ::: "memory");
    __syncthreads();
    {
        float* X = (float*)lds;
        f32x4 rl4[2];
#pragma unroll
        for (int qb = 0; qb < 2; ++qb) { const f32x4 l4 = *reinterpret_cast<const f32x4*>(li_l + 16 * qb + 4 * g4);
            rl4[qb] = (f32x4){__builtin_amdgcn_rcpf(l4[0]), __builtin_amdgcn_rcpf(l4[1]), __builtin_amdgcn_rcpf(l4[2]), __builtin_amdgcn_rcpf(l4[3])}; }
        if (sub == 1) {
#pragma unroll
            for (int qb = 0; qb < 2; ++qb)
#pragma unroll
                for (int cb = 0; cb < 8; ++cb)
#pragma unroll
                    for (int j = 0; j < 4; ++j) X[((((rg * 2 + qb) * 8 + cb) * 4 + j) << 6) + lane] = O[qb][cb][j] * rl4[qb][j];
        }
        __syncthreads();
        if (sub == 0) {
            float gs[8];
#pragma unroll
            for (int cb = 0; cb < 8; ++cb) gs[cb] = A.gsub[16 * cb + n16];
#pragma unroll
            for (int qb = 0; qb < 2; ++qb)
#pragma unroll
                for (int j = 0; j < 4; ++j) {
                    float d[8]; float v = 0.f;
#pragma unroll
                    for (int cb = 0; cb < 8; ++cb) { d[cb] = O[qb][cb][j] * rl4[qb][j] - lam * X[((((rg * 2 + qb) * 8 + cb) * 4 + j) << 6) + lane]; v += d[cb] * d[cb]; }
                    v += __shfl_xor(v, 1); v += __shfl_xor(v, 2); v += __shfl_xor(v, 4); v += __shfl_xor(v, 8);
                    const float sc_ = (1.0f - LAM_INIT) / sqrtf(v * (1.0f / 128.0f) + EPS);
                    unsigned short* op = A.ATT + (size_t)(qi * 128 + rg * 32 + 16 * qb + 4 * g4 + j) * LDR + h * 128 + n16;
#pragma unroll
                    for (int cb = 0; cb < 8; ++cb) op[16 * cb] = (unsigned short)f2bf(d[cb] * sc_ * gs[cb]);
                }
        }
    }
#undef FSW_
#undef HEAD_
#undef KDMA_
#undef VDMA_
#undef DST_
#undef WAITV_
#undef ROT_
#undef MEET_
#undef GQ_
#undef LSEG
#undef CSEG
    }
#undef SLOAD
#undef SWRITE
#undef SWAIT
#undef RESC
#undef MASK
    if constexpr (SAMPLE) {
    if (hi == 0) li_l[r32] = l_reg;
    asm volatile("s_waitcnt lgkmcnt(0)" ::: "memory");
    __syncthreads();
    float* X = (float*)lds;
    if (sub == 1 && (!SAMPLE || rg == 0)) {
#pragma unroll
        for (int r = 0; r < 16; ++r) { const float rl = __builtin_amdgcn_rcpf(li_l[crow(r, hi)]);
#pragma unroll
            for (int d0 = 0; d0 < 4; ++d0) X[((rg * 4 + d0) * 16 + r) * 64 + lane] = o[d0][r] * rl; }
    }
    __syncthreads();
    if (sub == 0 && (!SAMPLE || rg == 0)) {
        float gs[4];
#pragma unroll
        for (int d0 = 0; d0 < 4; ++d0) gs[d0] = A.gsub[d0 * 32 + r32];
#pragma unroll
        for (int r = 0; r < 16; ++r) {
            const int cr = crow(r, hi);
            const float rl = __builtin_amdgcn_rcpf(li_l[cr]);
            float d[4]; float v = 0.f;
#pragma unroll
            for (int d0 = 0; d0 < 4; ++d0) { d[d0] = o[d0][r] * rl - lam * X[((rg * 4 + d0) * 16 + r) * 64 + lane]; v += d[d0] * d[d0]; }
            v += __shfl_xor(v, 1); v += __shfl_xor(v, 2); v += __shfl_xor(v, 4); v += __shfl_xor(v, 8); v += __shfl_xor(v, 16);
            const float sc_ = (1.0f - LAM_INIT) / sqrtf(v * (1.0f / 128.0f) + EPS);
            const bool ok = SAMPLE ? (cr < 16) : true;
            const int orow = SAMPLE ? (qi * 16 + cr) : (qi * 128 + rg * 32 + cr);
            if (ok) {
                unsigned short* op = (SAMPLE ? A.ATTs : A.ATT) + (size_t)orow * LDR + h * 128 + r32;
#pragma unroll
                for (int d0 = 0; d0 < 4; ++d0) op[d0 * 32] = (unsigned short)f2bf(d[d0] * sc_ * gs[d0]);
            }
        }
    }
    }
    if constexpr (!SAMPLE) {
    {
        const int kr_ = tid >> 2, kc_ = (tid & 3) * 32;
        const unsigned short* ks_ = A.Kp + (size_t)(qi * 128 + kr_) * LDR + h * 128 + kc_;
        float* kd_ = A.kpo + (size_t)(qi * 128 + kr_) * LDR + h * 128 + kc_;
#pragma unroll
        for (int i = 0; i < 4; ++i) { const u32x4 w = *(const u32x4*)(ks_ + 8 * i);
            f32x4 a, b; a[0] = __uint_as_float(w[0] << 16); a[1] = __uint_as_float(w[0] & 0xffff0000u); a[2] = __uint_as_float(w[1] << 16); a[3] = __uint_as_float(w[1] & 0xffff0000u);
            b[0] = __uint_as_float(w[2] << 16); b[1] = __uint_as_float(w[2] & 0xffff0000u); b[2] = __uint_as_float(w[3] << 16); b[3] = __uint_as_float(w[3] & 0xffff0000u);
            *(f32x4*)(kd_ + 8 * i) = a; *(f32x4*)(kd_ + 8 * i + 4) = b; }
        const int vt_ = 2 * qi + (wid >> 2);
        const unsigned short* vs_ = A.Vp + ((size_t)(h * (SEQ / 64) + vt_) * 128) * 64;
        float* vd_ = A.vpo + (size_t)(vt_ * 64) * LDR + h * 128;
#pragma unroll
        for (int cc = 0; cc < 2; ++cc) {
            const int col = lane + 64 * cc;
#pragma unroll
            for (int ch = 0; ch < 2; ++ch) { const int k0 = (2 * (wid & 3) + ch) * 8;
                const u32x4 w = *(const u32x4*)(vs_ + (size_t)col * 64 + k0);
#pragma unroll
                for (int e = 0; e < 4; ++e) { vd_[(size_t)(k0 + 2 * e) * LDR + col] = __uint_as_float(w[e] << 16); vd_[(size_t)(k0 + 2 * e + 1) * LDR + col] = __uint_as_float(w[e] & 0xffff0000u); } }
        }
    }
    }
    __syncthreads();
}
#undef KSWZ

struct SpArgs { const unsigned short* Ub; const unsigned short* GVb; const float* SS; const float* gsgu; const float* wsp; const float* bsp; unsigned short* SGU; float* gsout;
                const unsigned short* Us; const unsigned short* GVs; const float* SSs; unsigned short* SGUs; };
__device__ __forceinline__ void spatial_unit(const SpArgs& A, bool sample, int c, int g, char* lds) {
    asm volatile("" : "+s"(c), "+s"(g));
    int tid = threadIdx.x; asm volatile("" : "+v"(tid));
    const int lane = tid & 63, r32 = lane & 31, hi = lane >> 5;
    const int wid = __builtin_amdgcn_readfirstlane(tid >> 6);
    const int R0 = sample ? (16 * c) : (128 * c), nrows = sample ? 16 : 128;
    const unsigned short* Ubp = sample ? A.Us : A.Ub; const unsigned short* GVp = sample ? A.GVs : A.GVb; const float* SSp = sample ? A.SSs : A.SS; unsigned short* SGUp = sample ? A.SGUs : A.SGU;
    float* rs_l = (float*)lds;
    if (tid < nrows) {
        const f32x4* sp = (const f32x4*)(SSp + (size_t)(R0 + tid) * 16);
        const f32x4 a = sp[0], b = sp[1], cc = sp[2], d = sp[3];
        const float s = ((a[0] + a[1]) + (a[2] + a[3])) + ((b[0] + b[1]) + (b[2] + b[3])) + ((cc[0] + cc[1]) + (cc[2] + cc[3])) + ((d[0] + d[1]) + (d[2] + d[3]));
        rs_l[tid] = 1.0f / sqrtf(s * (1.0f / 1024.0f) + EPS);
    }
    __syncthreads();
    const int ch = g * 256 + wid * 32 + r32;
    const float gch = A.gsgu[ch];
    const int nks = sample ? 1 : 8, nrb = sample ? 1 : 4;
    bf16x8 bfr[8];
#pragma unroll
    for (int ks = 0; ks < 8; ++ks) {
        if (ks < nks) {
            float vv[8];
#pragma unroll
            for (int jj = 0; jj < 8; ++jj) {
                const int j = 16 * ks + 8 * hi + jj;
                vv[jj] = bf2f(GVp[(size_t)(R0 + j) * LDR + ch]) * rs_l[j] * gch;
                if (sample) A.gsout[(size_t)(16 * c + j) * LDR + ch] = vv[jj];
            }
            u32x4 w = {cvtpk(vv[0], vv[1]), cvtpk(vv[2], vv[3]), cvtpk(vv[4], vv[5]), cvtpk(vv[6], vv[7])};
            bfr[ks] = *reinterpret_cast<bf16x8*>(&w);
        } else bfr[ks] = bf16x8{};
    }
    const float* Wg = A.wsp + (size_t)g * 128 * 128;
#pragma unroll 1
    for (int rb = 0; rb < nrb; ++rb) {
        {
            f32x16 acc = {};
            const int i = 32 * rb + r32;
#pragma unroll
            for (int ks = 0; ks < 8; ++ks) {
                if (ks < nks && 16 * ks <= 32 * rb + 31) {
                    const int j0 = 16 * ks + 8 * hi;
                    const f32x4 w0 = *(const f32x4*)(Wg + (size_t)i * 128 + j0), w1 = *(const f32x4*)(Wg + (size_t)i * 128 + j0 + 4);
                    float wv[8] = {w0[0], w0[1], w0[2], w0[3], w1[0], w1[1], w1[2], w1[3]};
#pragma unroll
                    for (int jj = 0; jj < 8; ++jj) if (j0 + jj > i) wv[jj] = 0.f;
                    u32x4 w = {cvtpk(wv[0], wv[1]), cvtpk(wv[2], wv[3]), cvtpk(wv[4], wv[5]), cvtpk(wv[6], wv[7])};
                    acc = __builtin_amdgcn_mfma_f32_32x32x16_bf16(*reinterpret_cast<bf16x8*>(&w), bfr[ks], acc, 0, 0, 0);
                }
            }
#pragma unroll
            for (int r = 0; r < 16; ++r) {
                const int io = 32 * rb + crow(r, hi);
                if (io < nrows) {
                    const float uv = bf2f(Ubp[(size_t)(R0 + io) * LDR + ch]);
                    SGUp[(size_t)(R0 + io) * LDR + ch] = (unsigned short)f2bf(uv * (acc[r] + A.bsp[g * 128 + io]));
                }
            }
        }
    }
    __syncthreads();
}
__device__ __forceinline__ void spatial_unit_prompt(const SpArgs& A, int c, int g, char* lds) {
    asm volatile("" : "+s"(c), "+s"(g));
    int tid = threadIdx.x; asm volatile("" : "+v"(tid));
    const int lane = tid & 63, r32 = lane & 31, hi = lane >> 5;
    const int wid = __builtin_amdgcn_readfirstlane(tid >> 6);
    constexpr int GST = 528, WST = 272;
    char* Gt = lds; char* Wt = lds + 128 * GST; float* rs_l = (float*)(lds + 128 * GST + 128 * WST);
    const int R0 = 128 * c;
    u32x4 gv[8];
#pragma unroll
    for (int i = 0; i < 8; ++i) { const int q = tid + 512 * i, row = q >> 5, cc = q & 31;
        gv[i] = *(const u32x4*)(A.GVb + (size_t)(R0 + row) * LDR + g * 256 + cc * 8); }
    const int wi = tid >> 2, wj = (tid & 3) * 32;
    f32x4 wv[8];
#pragma unroll
    for (int i = 0; i < 8; ++i) wv[i] = *(const f32x4*)(A.wsp + (size_t)g * 128 * 128 + (size_t)wi * 128 + wj + 4 * i);
    if (tid < 128) {
        const f32x4* sp = (const f32x4*)(A.SS + (size_t)(R0 + tid) * 16);
        const f32x4 a = sp[0], b = sp[1], cc = sp[2], d = sp[3];
        const float s = ((a[0] + a[1]) + (a[2] + a[3])) + ((b[0] + b[1]) + (b[2] + b[3])) + ((cc[0] + cc[1]) + (cc[2] + cc[3])) + ((d[0] + d[1]) + (d[2] + d[3]));
        rs_l[tid] = 1.0f / sqrtf(s * (1.0f / 1024.0f) + EPS);
    }
#pragma unroll
    for (int i = 0; i < 8; ++i) { const int q = tid + 512 * i, row = q >> 5, cc = q & 31; *(u32x4*)(Gt + row * GST + cc * 16) = gv[i]; }
    __syncthreads();
#pragma unroll
    for (int i = 0; i < 4; ++i) {
        const f32x4 r0 = *(const f32x4*)(rs_l + wj + 8 * i), r1 = *(const f32x4*)(rs_l + wj + 8 * i + 4);
        float t[8];
#pragma unroll
        for (int e = 0; e < 4; ++e) { t[e] = (wj + 8 * i + e <= wi) ? wv[2 * i][e] * r0[e] : 0.f; t[4 + e] = (wj + 8 * i + 4 + e <= wi) ? wv[2 * i + 1][e] * r1[e] : 0.f; }
        u32x4 w = {cvtpk(t[0], t[1]), cvtpk(t[2], t[3]), cvtpk(t[4], t[5]), cvtpk(t[6], t[7])};
        *(u32x4*)(Wt + wi * WST + (wj + 8 * i) * 2) = w;
    }
    __syncthreads();
    u32x4 uu[8];
#pragma unroll
    for (int i = 0; i < 8; ++i) { const int q = tid + 512 * i, row = q >> 5, cc = q & 31;
        uu[i] = *(const u32x4*)(A.Ub + (size_t)(R0 + row) * LDR + g * 256 + cc * 8); }
    const int ccol = wid * 32 + r32, ch = g * 256 + ccol;
    const float gch = A.gsgu[ch];
    bf16x8 bfr[8];
#pragma unroll
    for (int ks = 0; ks < 8; ++ks) {
        unsigned p[4];
#pragma unroll
        for (int e = 0; e < 4; ++e) { const int j = 16 * ks + 8 * hi + 2 * e;
            const unsigned lo = *(const unsigned short*)(Gt + j * GST + ccol * 2), hi16 = *(const unsigned short*)(Gt + (j + 1) * GST + ccol * 2);
            p[e] = lo | (hi16 << 16); }
        u32x4 w = {p[0], p[1], p[2], p[3]};
        bfr[ks] = *reinterpret_cast<bf16x8*>(&w);
    }
    asm volatile("s_waitcnt lgkmcnt(0)" ::: "memory");
#pragma unroll
    for (int rb = 0; rb < 4; ++rb) {
        f32x16 acc = {};
#pragma unroll
        for (int ks = 0; ks < 8; ++ks) {
            if (ks <= 2 * rb + 1) {
                const bf16x8 af = *(const bf16x8*)(Wt + (32 * rb + r32) * WST + (16 * ks + 8 * hi) * 2);
                acc = __builtin_amdgcn_mfma_f32_32x32x16_bf16(af, bfr[ks], acc, 0, 0, 0);
            }
        }
#pragma unroll
        for (int r = 0; r < 16; ++r) { const int io = 32 * rb + crow(r, hi);
            *(unsigned short*)(Gt + io * GST + ccol * 2) = (unsigned short)f2bf(acc[r] * gch + A.bsp[g * 128 + io]); }
    }
    __syncthreads();
#pragma unroll
    for (int i = 0; i < 8; ++i) { const int q = tid + 512 * i, row = q >> 5, cc = q & 31;
        const u32x4 rv = *(const u32x4*)(Gt + row * GST + cc * 16);
        u32x4 ov;
#pragma unroll
        for (int e = 0; e < 4; ++e) { const float a0 = __builtin_bit_cast(float, rv[e] << 16) * __builtin_bit_cast(float, uu[i][e] << 16), a1 = __builtin_bit_cast(float, rv[e] & 0xffff0000u) * __builtin_bit_cast(float, uu[i][e] & 0xffff0000u);
            ov[e] = cvtpk(a0, a1); }
        *(u32x4*)(A.SGU + (size_t)(R0 + row) * LDR + g * 256 + cc * 8) = ov; }
    __syncthreads();
}
#undef SBAR
}

struct KArgs {
    const float* in[26]; float* out; unsigned char* ws;
};

struct Frame {
    LAS unsigned char* lds; int tid, lane, wave, G, gw, NGW;
};

__device__ __forceinline__ void p0_transpose_item(const float* W, int K, int N, bf16* WT, int mode, LAS float* scr, int item, int lane, int ldw = 0) {
    if (ldw == 0) ldw = K;
    const int nblk = N / 32, kb = item / nblk, nb = item % nblk, k0 = 64 * kb, n0 = 32 * nb;
    int d0 = n0;
    if (mode == 1) { const int half = N / 2; const int nn = (n0 < half) ? n0 : n0 - half; d0 = (nn >> 7) * 256 + (nn & 127) + ((n0 < half) ? 0 : 128); }
#pragma unroll
    for (int i = 0; i < 32; ++i) { const int kk = 2 * i + (lane >> 5); scr[kk * 33 + (lane & 31)] = W[(size_t)(k0 + kk) * N + n0 + (lane & 31)]; }
    LDS_WAIT(); asm volatile("" ::: "memory");
    const int c = lane & 7;
#pragma unroll
    for (int j = 0; j < 4; ++j) { const int n = (lane >> 3) + 8 * j; const LAS float* s = scr + (8 * c) * 33 + n;
        v4u o; o.x = pk2(s[0 * 33], s[1 * 33]); o.y = pk2(s[2 * 33], s[3 * 33]); o.z = pk2(s[4 * 33], s[5 * 33]); o.w = pk2(s[6 * 33], s[7 * 33]);
        *(v4u*)(WT + (size_t)(d0 + n) * ldw + k0 + 8 * c) = o; }
    LDS_WAIT(); asm volatile("" ::: "memory");
}

__device__ __forceinline__ const float* xrow_ptr(const float* xp, const float* xs, int m) { return (m < SEQ) ? xp + (size_t)m * DM : xs + (size_t)(m - SEQ) * DM; }

template <bool BIN, bool BOUT>
__device__ __forceinline__ void row_phase(const Frame& F, int m0, int mstep, int mend, const bf16* Fb, const float* SS, const void* base0, float scale,
                                          const float* gpost, void* Hout, const float* gnext, bf16* XN) {
    for (int m = m0; m < mend; m += 2 * mstep) {
        const bool two = (m + mstep < mend); const int mb = two ? m + mstep : m;
        const v2u* fa_ = (const v2u*)(Fb + (size_t)m * DM) + F.lane; const v2u* fb_ = (const v2u*)(Fb + (size_t)mb * DM) + F.lane;
        const f32x4* gp = (const f32x4*)gpost + F.lane;
        v2u fwa[4], fwb[4]; f32x4 bva[4], bvb[4], g[4];
        float ssa = SS[(size_t)m * 16 + (F.lane & 15)], ssb = SS[(size_t)mb * 16 + (F.lane & 15)];
#pragma unroll
        for (int j = 0; j < 4; ++j) { fwa[j] = fa_[64 * j]; fwb[j] = fb_[64 * j]; g[j] = gp[64 * j];
            if constexpr (BIN) { const v2u wa = ((const v2u*)((const bf16*)base0 + (size_t)m * DM) + F.lane)[64 * j], wb = ((const v2u*)((const bf16*)base0 + (size_t)mb * DM) + F.lane)[64 * j];
                bva[j] = (f32x4){bflo(wa.x), bfhi(wa.x), bflo(wa.y), bfhi(wa.y)}; bvb[j] = (f32x4){bflo(wb.x), bfhi(wb.x), bflo(wb.y), bfhi(wb.y)}; }
            else { bva[j] = ((const f32x4*)((const float*)base0 + (size_t)m * DM) + F.lane)[64 * j]; bvb[j] = ((const f32x4*)((const float*)base0 + (size_t)mb * DM) + F.lane)[64 * j]; } }
#pragma unroll
        for (int half = 0; half < 2; ++half) {
            if (half == 1 && !two) break;
            const int mm = half ? mb : m;
            float ss = half ? ssb : ssa;
            ss += __shfl_xor(ss, 1); ss += __shfl_xor(ss, 2); ss += __shfl_xor(ss, 4); ss += __shfl_xor(ss, 8);
            const float rs = 1.0f / sqrtf(ss * (1.0f / DM) + EPS);
            f32x4 hv[4]; float s2 = 0.f;
#pragma unroll
            for (int j = 0; j < 4; ++j) { const v2u fw = half ? fwb[j] : fwa[j]; const f32x4 f = {bflo(fw.x), bfhi(fw.x), bflo(fw.y), bfhi(fw.y)}; const f32x4 b = half ? bvb[j] : bva[j];
                hv[j] = b + (f * g[j]) * (rs * scale);
                s2 += (hv[j][0] * hv[j][0] + hv[j][1] * hv[j][1]) + (hv[j][2] * hv[j][2] + hv[j][3] * hv[j][3]); }
            if (Hout) {
                if constexpr (BOUT) { v2u* ho = (v2u*)((bf16*)Hout + (size_t)mm * DM) + F.lane;
#pragma unroll
                    for (int j = 0; j < 4; ++j) ho[64 * j] = (v2u){pk2(hv[j][0], hv[j][1]), pk2(hv[j][2], hv[j][3])}; }
                else { f32x4* ho = (f32x4*)((float*)Hout + (size_t)mm * DM) + F.lane;
#pragma unroll
                    for (int j = 0; j < 4; ++j) ho[64 * j] = hv[j]; }
            }
            if (gnext) {
                const float rs2 = 1.0f / sqrtf(wave_sum(s2) * (1.0f / DM) + EPS);
                const f32x4* gn = (const f32x4*)gnext + F.lane;
                unsigned long long* o8 = (unsigned long long*)(XN + (size_t)mm * DM) + F.lane;
#pragma unroll
                for (int j = 0; j < 4; ++j) { const f32x4 gq = gn[64 * j]; const f32x4 v = hv[j] * gq * rs2;
                    o8[64 * j] = (unsigned long long)pk2(v[0], v[1]) | ((unsigned long long)pk2(v[2], v[3]) << 32); }
            }
        }
    }
}


#define XB_TMO      128
#define XB_XCNT(j)  (256  + 64 * (j))
#define XB_XSUB(j)  (1280 + 64 * (j))
#define XB_XGEN(j)  (2304 + 64 * (j))
#define XB_TOP      3328
#define XB_TOPGEN   3392
#define XCD_BAR_WORDS 3456
#define XB_SPIN_CAP (1u << 20)
__device__ __forceinline__ unsigned xb_ld(unsigned* p)              { return __hip_atomic_load(p, __ATOMIC_RELAXED, __HIP_MEMORY_SCOPE_AGENT); }
__device__ __forceinline__ unsigned xb_add(unsigned* p, unsigned v) { return __hip_atomic_fetch_add(p, v, __ATOMIC_RELAXED, __HIP_MEMORY_SCOPE_AGENT); }
__device__ __forceinline__ unsigned xb_xcc_id() { return (unsigned)__builtin_amdgcn_s_getreg((3 << 11) | 20) & 0xFu; }
#define XB_SPIN(cond, bar) do { unsigned _sp = 0; while (cond) { __builtin_amdgcn_s_sleep(1); \
    if ((++_sp & 255u) == 0u) { if (xb_ld(&(bar)[XB_TMO])) break; if (_sp > XB_SPIN_CAP) { atomicAdd(&(bar)[XB_TMO], 1u); break; } } } } while (0)
struct XcdBarrier { unsigned* bar; unsigned x; volatile LAS unsigned* st; };
__device__ __forceinline__ XcdBarrier xcd_barrier_post(unsigned* bar, volatile LAS unsigned* st) {
    XcdBarrier b; b.bar = bar; b.x = xb_xcc_id(); b.st = st;
    if (threadIdx.x == 0) (void)xb_add(&bar[XB_XCNT(b.x)], 1u);
    return b;
}
__device__ __forceinline__ void xcd_barrier_complete(unsigned* bar, unsigned x, unsigned& nloc, unsigned& nx) {
    const unsigned G = gridDim.x * gridDim.y * gridDim.z;
    unsigned sum, cnt, mine, sp = 0u;
    for (;;) {
        sum = 0u; cnt = 0u; mine = 0u;
#pragma unroll
        for (unsigned j = 0; j < 16; ++j) { const unsigned c = xb_ld(&bar[XB_XCNT(j)]); sum += c; cnt += (c > 0u) ? 1u : 0u; mine = (j == x) ? c : mine; }
        if (sum == G) break;
        __builtin_amdgcn_s_sleep(1);
        if ((++sp & 255u) == 0u) { if (xb_ld(&bar[XB_TMO])) break; if (sp > XB_SPIN_CAP) { atomicAdd(&bar[XB_TMO], 1u); break; } }
    }
    nloc = mine > 0u ? mine : 1u; nx = cnt > 0u ? cnt : 1u;
}
__device__ __forceinline__ void xcd_barrier(const XcdBarrier& b) {
    asm volatile("s_waitcnt vmcnt(0)" ::: "memory");
    __syncthreads();
    if (threadIdx.x == 0) {
        unsigned* bar = b.bar;
        __builtin_amdgcn_s_waitcnt(0);
        unsigned nloc = b.st[0], nx = b.st[1];
        if (nloc == 0u) { xcd_barrier_complete(bar, b.x, nloc, nx); b.st[0] = nloc; b.st[1] = nx; }
        const unsigned old = xb_add(&bar[XB_XSUB(b.x)], 1u);
        const unsigned gen = old / nloc;
        if (old + 1u == (gen + 1u) * nloc) {
            __builtin_amdgcn_fence(__ATOMIC_RELEASE, "agent");
            asm volatile("s_waitcnt vmcnt(0)" ::: "memory");
            const unsigned og = xb_add(&bar[XB_TOP], 1u);
            const unsigned tg = og / nx;
            if (og + 1u == (tg + 1u) * nx) xb_add(&bar[XB_TOPGEN], 1u);
            else XB_SPIN(xb_ld(&bar[XB_TOPGEN]) == tg, bar);
            __builtin_amdgcn_fence(__ATOMIC_ACQUIRE, "agent");
            xb_add(&bar[XB_XGEN(b.x)], 1u);
            asm volatile("s_waitcnt vmcnt(0)" ::: "memory");
        } else {
            XB_SPIN(xb_ld(&bar[XB_XGEN(b.x)]) == gen, bar);
            __builtin_amdgcn_fence(__ATOMIC_ACQUIRE, "agent");
            asm volatile("s_waitcnt vmcnt(0)" ::: "memory");
        }
    }
    __syncthreads();
}

__device__ __forceinline__ int queue_pop(unsigned* ctr, volatile LAS unsigned* slot) {
    if (threadIdx.x == 0) *slot = __hip_atomic_fetch_add(ctr, 1u, __ATOMIC_RELAXED, __HIP_MEMORY_SCOPE_AGENT);
    __syncthreads();
    const int v = __builtin_amdgcn_readfirstlane((int)*slot);
    __syncthreads();
    return v;
}

__global__ void __launch_bounds__(NWAVES * 64, 2) mk_fwd(KArgs args) {
    extern __shared__ __attribute__((aligned(16))) unsigned char lds[];
    cg::grid_group grid = cg::this_grid();
    Frame F;
    F.lds = (LAS unsigned char*)lds;
    F.tid = threadIdx.x; F.lane = F.tid & 63; F.wave = __builtin_amdgcn_readfirstlane(F.tid >> 6);
    F.G = gridDim.x; F.gw = blockIdx.x * NWAVES + F.wave; F.NGW = F.G * NWAVES;
    unsigned char* ws = args.ws;
    unsigned* ctl = (unsigned*)(ws + WS_CTL);
    const float* xp = args.in[0]; const float* xs = args.in[1];
    float* rope = (float*)(ws + WS_ROPE); float* SS = (float*)(ws + WS_SS);
    bf16 *W1IN = (bf16*)(ws + WS_W1IN), *W1OUT = (bf16*)(ws + WS_W1OUT), *WIN = (bf16*)(ws + WS_WIN), *WA = (bf16*)(ws + WS_WA), *WB = (bf16*)(ws + WS_WB), *WO = (bf16*)(ws + WS_WO),
         *W2IN = (bf16*)(ws + WS_W2IN), *W2OUT = (bf16*)(ws + WS_W2OUT);
    bf16 *XN = (bf16*)(ws + WS_XN), *ACT = (bf16*)(ws + WS_ACT), *UB = (bf16*)(ws + WS_UB), *GVB = (bf16*)(ws + WS_GVB), *ATT = (bf16*)(ws + WS_ATT), *SGU = (bf16*)(ws + WS_SGU),
         *QB = (bf16*)(ws + WS_QB), *KPB = (bf16*)(ws + WS_KPB), *VPB = (bf16*)(ws + WS_VPB), *SGA = (bf16*)(ws + WS_SGA), *SGB = (bf16*)(ws + WS_SGB);
    bf16* FB = (bf16*)(ws + WS_F); bf16* HB = (bf16*)(ws + WS_H); float* T1 = (float*)(ws + WS_T1);
    bf16 *XNs = (bf16*)(ws + SA_XN), *ACTs = (bf16*)(ws + SA_ACT), *Qs = (bf16*)(ws + SA_Q), *Us = (bf16*)(ws + SA_U), *GVs = (bf16*)(ws + SA_GV), *SGAs = (bf16*)(ws + SA_SGA),
         *SGBs = (bf16*)(ws + SA_SGB), *ATTs = (bf16*)(ws + SA_ATT), *SGUs = (bf16*)(ws + SA_SGU);
    bf16* Fs = (bf16*)(ws + SA_F); float *Hs = (float*)(ws + SA_H), *T1s = (float*)(ws + SA_T1), *SSs = (float*)(ws + SA_SS);
    float* out = args.out;
    volatile LAS unsigned* MISC = (volatile LAS unsigned*)(F.lds + MISC_OFF);
    if (F.tid < 32) MISC[F.tid] = 0u;
    __syncthreads();
    XcdBarrier bar = xcd_barrier_post(ctl + CW_BAR, MISC + 8);
#define GRID_BAR() xcd_barrier(bar)

#if (PHM >> 0) & 1
    {
        LAS float* scr = (LAS float*)(F.lds + F.wave * 16384);
        constexpr int I_FIN = (DM / 64) * (2 * DFF / 32), I_FOUT = (DFF / 64) * (DM / 32), I_IN = (DM / 64) * (INC / 32), I_SQ = (DM / 64) * (DM / 32);
        constexpr int NITEMS = 2 * I_FIN + 2 * I_FOUT + I_IN + 3 * I_SQ;
        for (int it = F.gw; it < NITEMS; it += F.NGW) {
            int r = it;
            if (r < I_FIN) { p0_transpose_item(args.in[5], DM, 2 * DFF, W1IN, 1, scr, r, F.lane); continue; } r -= I_FIN;
            if (r < I_FOUT) { p0_transpose_item(args.in[6], DFF, DM, W1OUT, 0, scr, r, F.lane, LDF); continue; } r -= I_FOUT;
            if (r < I_IN) { p0_transpose_item(args.in[9], DM, INC, WIN, 0, scr, r, F.lane); continue; } r -= I_IN;
            if (r < I_SQ) { p0_transpose_item(args.in[18], DM, DM, WA, 0, scr, r, F.lane); continue; } r -= I_SQ;
            if (r < I_SQ) { p0_transpose_item(args.in[19], DM, DM, WB, 0, scr, r, F.lane); continue; } r -= I_SQ;
            if (r < I_SQ) { p0_transpose_item(args.in[20], DM, DM, WO, 0, scr, r, F.lane); continue; } r -= I_SQ;
            if (r < I_FIN) { p0_transpose_item(args.in[23], DM, 2 * DFF, W2IN, 1, scr, r, F.lane); continue; } r -= I_FIN;
            p0_transpose_item(args.in[24], DFF, DM, W2OUT, 0, scr, r, F.lane, LDF);
        }
        for (int i = blockIdx.x * (NWAVES * 64) + F.tid; i < SEQ * 8; i += F.G * NWAVES * 64) {
            const int pos = i >> 3, d = i & 7;
            const double cf = (d == 0) ? 0.15915494309189535 : (d == 1) ? 0.03086376340470123 : (d == 2) ? 0.005985185712713705 : (d == 3) ? 0.001160663641240061 :
                              (d == 4) ? 0.00022507907903927653 : (d == 5) ? 4.364795279280289e-05 : (d == 6) ? 8.464330808241401e-06 : 1.6414262627950345e-06;
            const double rev = (double)pos * cf; double t = rev - __builtin_floor(rev);
            t = t - __builtin_rint(t);
            const double q = __builtin_rint(4.0 * t); const double a = (t - 0.25 * q) * 6.283185307179586476925;
            const double a2 = a * a;
            const double sn = a * (1.0 + a2 * (-1.0 / 6 + a2 * (1.0 / 120 + a2 * (-1.0 / 5040 + a2 * (1.0 / 362880 + a2 * (-1.0 / 39916800 + a2 * (1.0 / 6227020800.0)))))));
            const double cs = 1.0 + a2 * (-0.5 + a2 * (1.0 / 24 + a2 * (-1.0 / 720 + a2 * (1.0 / 40320 + a2 * (-1.0 / 3628800 + a2 * (1.0 / 479001600 + a2 * (-1.0 / 87178291200.0)))))));
            const int qi = ((int)q) & 3;
            const double s_ = (qi == 0) ? sn : (qi == 1) ? cs : (qi == 2) ? -sn : -cs;
            const double c_ = (qi == 0) ? cs : (qi == 1) ? -sn : (qi == 2) ? -cs : sn;
            rope[(size_t)pos * 16 + d] = (float)c_; rope[(size_t)pos * 16 + 8 + d] = (float)s_;
        }
        const float* g1 = args.in[4];
        for (int m = F.gw; m < MT; m += 2 * F.NGW) {
            const bool two = (m + F.NGW < MT); const int mb = two ? m + F.NGW : m;
            const f32x4* xa = (const f32x4*)xrow_ptr(xp, xs, m) + F.lane; const f32x4* xb = (const f32x4*)xrow_ptr(xp, xs, mb) + F.lane; const f32x4* gp = (const f32x4*)g1 + F.lane;
            f32x4 va[4], vb[4], g[4]; float sa = 0.f, sb = 0.f;
#pragma unroll
            for (int j = 0; j < 4; ++j) { va[j] = xa[64 * j]; vb[j] = xb[64 * j]; g[j] = gp[64 * j]; }
#pragma unroll
            for (int j = 0; j < 4; ++j) { sa += (va[j][0] * va[j][0] + va[j][1] * va[j][1]) + (va[j][2] * va[j][2] + va[j][3] * va[j][3]);
                                          sb += (vb[j][0] * vb[j][0] + vb[j][1] * vb[j][1]) + (vb[j][2] * vb[j][2] + vb[j][3] * vb[j][3]); }
            const float rsa = 1.0f / sqrtf(wave_sum(sa) * (1.0f / DM) + EPS), rsb = 1.0f / sqrtf(wave_sum(sb) * (1.0f / DM) + EPS);
            unsigned long long* oa = (unsigned long long*)(m < SEQ ? XN + (size_t)m * DM : XNs + (size_t)(m - SEQ) * DM) + F.lane;
            unsigned long long* ob = (unsigned long long*)(mb < SEQ ? XN + (size_t)mb * DM : XNs + (size_t)(mb - SEQ) * DM) + F.lane;
#pragma unroll
            for (int j = 0; j < 4; ++j) { const f32x4 w = va[j] * g[j] * rsa; oa[64 * j] = (unsigned long long)pk2(w[0], w[1]) | ((unsigned long long)pk2(w[2], w[3]) << 32); }
            if (two) {
#pragma unroll
                for (int j = 0; j < 4; ++j) { const f32x4 w = vb[j] * g[j] * rsb; ob[64 * j] = (unsigned long long)pk2(w[0], w[1]) | ((unsigned long long)pk2(w[2], w[3]) << 32); }
            }
        }
    }
    GRID_BAR();
    if (args.ws == nullptr) grid.sync();

#endif
#if (PHM >> 1) & 1
    { pg8::Gemm g{XN, W1IN, SEQ, 2 * DFF, DM}; pg8::StaticOrder S; S.init(SEQ, 2 * DFF, F.G, (int)blockIdx.x);
      pg8::EpiSwiglu E{ACT}; pg8::gemm_phase<pg8::EpiSwiglu, pg8::StaticOrder, true, true>(F.lds, g, S, E); }
    GRID_BAR();
#endif
#if (PHM >> 2) & 1
    { pg8::Gemm g{ACT, W1OUT, SEQ, DM, DFF, nullptr, nullptr, LDF}; pg8::StaticOrder S; S.init(SEQ, DM, F.G, (int)blockIdx.x);
      pg8::EpiF32Stats E{FB, SS}; pg8::gemm_phase<pg8::EpiF32Stats, pg8::StaticOrder, false, true>(F.lds, g, S, E); }
    GRID_BAR();
#endif
#if (PHM >> 3) & 1
    row_phase<false, true>(F, F.gw, F.NGW, SEQ, FB, SS, xp, 0.5f, args.in[7], HB, args.in[8], XN);
    GRID_BAR();
#endif
#if (PHM >> 4) & 1
    { pg8::Gemm g{XN, WIN, SEQ, INC, DM}; pg8::StaticOrder S; S.init(SEQ, INC, F.G, (int)blockIdx.x);
      pg8::EpiProj E{QB, KPB, VPB, UB, GVB, SGA, SGB, out + OFF_KP, out + OFF_VP, SS, rope, false}; pg8::gemm_phase<pg8::EpiProj, pg8::StaticOrder, true, true>(F.lds, g, S, E); }
    GRID_BAR();
#endif
#if (PHM >> 5) & 1
    {
        float lam;
        { const float a = args.in[10][F.lane] * args.in[11][F.lane], b = args.in[12][F.lane] * args.in[13][F.lane];
          lam = expf(wave_sum(a)) - expf(wave_sum(b)) + LAM_INIT;
          lam = __builtin_bit_cast(float, __builtin_amdgcn_readfirstlane(__builtin_bit_cast(int, lam))); }
        unsigned* ch = ctl + CW_CH;
        int ch_ready = 0;
#define CH_N(s) ((s) == 1 || (s) == 10 ? 22 : (s) == 4 ? 28 : (s) == 5 ? 192 : ((s) == 3 || (s) == 9 || (s) == 12) ? 1 : 4)
#define CH_DONE_NOW(s, RES) do { if ((s) <= ch_ready) RES = true; else { \
            if (F.tid == 0) MISC[1] = (__hip_atomic_load(ch + 128 * (s) + 64, __ATOMIC_RELAXED, __HIP_MEMORY_SCOPE_AGENT) >= (unsigned)CH_N(s)) ? 1u : 0u; \
            __syncthreads(); RES = __builtin_amdgcn_readfirstlane((int)MISC[1]) != 0; __syncthreads(); } } while (0)
#define CH_WAIT(s) do { if ((s) > ch_ready) { \
            if (F.tid == 0) { unsigned sp_ = 0; while (__hip_atomic_load(ch + 128 * (s) + 64, __ATOMIC_RELAXED, __HIP_MEMORY_SCOPE_AGENT) < (unsigned)CH_N(s)) { __builtin_amdgcn_s_sleep(8); if (++sp_ > (1u << 22)) break; } \
                if (!((s) == 4 && !starter)) { __builtin_amdgcn_fence(__ATOMIC_ACQUIRE, "agent"); asm volatile("s_waitcnt vmcnt(0)" ::: "memory"); } } \
            __syncthreads(); ch_ready = (s); } } while (0)
#define CH_SIGNAL(s) do { asm volatile("s_waitcnt vmcnt(0)" ::: "memory"); __syncthreads(); \
            if (F.tid == 0) { __builtin_amdgcn_fence(__ATOMIC_RELEASE, "agent"); asm volatile("s_waitcnt vmcnt(0)" ::: "memory"); \
                __hip_atomic_fetch_add(ch + 128 * (s) + 64, 1u, __ATOMIC_RELAXED, __HIP_MEMORY_SCOPE_AGENT); } } while (0)
#define WP(T, off) ((T*)(w_ + (off)))
#define CH_UNIT(s, u) do { \
            if ((s) == 1 || (s) == 10) { pg8::Gemm g{WP(bf16, SA_XN), (s) == 1 ? WP(bf16, WS_W1IN) : WP(bf16, WS_W2IN), 256, 2 * DFF, DM}; pg8::OneUnit S{0, (u)}; pg8::EpiSwiglu E{WP(bf16, SA_ACT)}; pg8::gemm_phase<pg8::EpiSwiglu, pg8::OneUnit, false, true>(F.lds, g, S, E); } \
            else if ((s) == 2 || (s) == 11) { pg8::Gemm g{WP(bf16, SA_ACT), (s) == 2 ? WP(bf16, WS_W1OUT) : WP(bf16, WS_W2OUT), 256, DM, DFF, nullptr, nullptr, LDF}; pg8::OneUnit S{0, (u)}; pg8::EpiF32Stats E{WP(bf16, SA_F), WP(float, SA_SS)}; pg8::gemm_phase<pg8::EpiF32Stats, pg8::OneUnit, false, true>(F.lds, g, S, E); } \
            else if ((s) == 8) { pg8::Gemm g{WP(bf16, SA_XN), WP(bf16, WS_WO), 256, DM, DM}; pg8::OneUnit S{0, (u)}; pg8::EpiF32Stats E{WP(bf16, SA_F), WP(float, SA_SS)}; pg8::gemm_phase<pg8::EpiF32Stats, pg8::OneUnit, false, true>(F.lds, g, S, E); } \
            else if ((s) == 4) { pg8::Gemm g{WP(bf16, SA_XN), WP(bf16, WS_WIN), 256, INC, DM}; pg8::OneUnit S{0, (u)}; \
                               pg8::EpiProj E{WP(bf16, SA_Q), nullptr, nullptr, WP(bf16, SA_U), WP(bf16, SA_GV), WP(bf16, SA_SGA), WP(bf16, SA_SGB), o_ + OFF_KS, o_ + OFF_VS, WP(float, SA_SS), WP(float, WS_ROPE), true}; \
                               pg8::gemm_phase<pg8::EpiProj, pg8::OneUnit, false, true>(F.lds, g, S, E); } \
            else if ((s) == 6) { pg8::Gemm g{WP(bf16, SA_ATT), WP(bf16, WS_WA), 256, DM, DM}; pg8::OneUnit S{0, (u)}; pg8::EpiGateA E{WP(float, SA_T1), WP(bf16, SA_SGA)}; pg8::gemm_phase<pg8::EpiGateA, pg8::OneUnit, false, true>(F.lds, g, S, E); } \
            else if ((s) == 7) { pg8::Gemm g{WP(bf16, SA_SGU), WP(bf16, WS_WB), 256, DM, DM}; pg8::OneUnit S{0, (u)}; pg8::EpiGateB E{WP(float, SA_T1), WP(bf16, SA_SGB), WP(bf16, SA_XN)}; pg8::gemm_phase<pg8::EpiGateB, pg8::OneUnit, false, true>(F.lds, g, S, E); } \
            else if ((s) == 3) row_phase<false, false>(F, F.wave, NWAVES, 256, WP(bf16, SA_F), WP(float, SA_SS), KIN(1), 0.5f, KIN(7), WP(float, SA_H), KIN(8), WP(bf16, SA_XN)); \
            else if ((s) == 9) row_phase<false, false>(F, F.wave, NWAVES, 256, WP(bf16, SA_F), WP(float, SA_SS), WP(float, SA_H), 1.0f, KIN(21), WP(float, SA_H), KIN(22), WP(bf16, SA_XN)); \
            else if ((s) == 12) row_phase<false, false>(F, F.wave, NWAVES, 256, WP(bf16, SA_F), WP(float, SA_SS), WP(float, SA_H), 0.5f, KIN(25), o_ + OFF_Y + (size_t)SEQ * DM, nullptr, nullptr); \
            else {} } while (0)
#ifndef P5_REPS
#define P5_REPS 1
#endif
#ifndef NDED
#define NDED 16
#endif
        const int h8 = blockIdx.x & 7;
#pragma unroll 1
        for (int rep = 0; rep < P5_REPS; ++rep) {
        unsigned* qb_ = ctl + CW_Q + rep * 1024;
        const bool starter = (int)blockIdx.x >= (int)F.G - NDED;
        int st = starter ? 0 : 1, cs = starter ? 1 : 5, hh = 0; bool s5_open = true, try5 = false;
        for (;;) {
            int kind = 0, a0 = 0, a1 = 0, dep = 0, sig = 0;
            if (st == 0 || st == 3) {
                while (cs <= 12) { const int u = queue_pop(ch + 128 * cs, MISC); if (u < CH_N(cs)) { kind = 3; a0 = cs; a1 = u; dep = cs - 1; sig = cs; break; } ++cs; }
                if (kind == 0) { if (st == 0) { st = 1; cs = 5; continue; } break; }
            } else if (st == 1) {
                if (try5) { try5 = false; bool rdy_; CH_DONE_NOW(4, rdy_);
                    if (rdy_) { const int u = queue_pop(ch + 128 * 5, MISC); if (u < CH_N(5)) { kind = 3; a0 = 5; a1 = u; dep = 4; sig = 5; } else s5_open = false; } }
                if (kind == 0) {
                    while (hh < 8) { const int hq = (h8 + hh) & 7; const int idx = queue_pop(qb_ + 64 * hq, MISC); if (idx < 128) { kind = 1; a0 = hq; a1 = 127 - idx; try5 = s5_open; break; } ++hh; }
                    if (kind == 0) { st = 2; continue; }
                }
            } else {
                const int idx = queue_pop(qb_ + 64 * 8, MISC);
                if (idx < 512) { kind = 2; a0 = idx >> 2; a1 = idx & 3; } else { st = 3; cs = 5; continue; }
            }
            if (dep) CH_WAIT(dep);
            typedef __attribute__((address_space(4))) const unsigned long long* kptr_t;
            kptr_t kq_ = (kptr_t)__builtin_amdgcn_kernarg_segment_ptr(); asm volatile("" : "+s"(kq_));
#define KIN(k) ((const float*)(const GAS float*)kq_[k])
            unsigned char* w_ = (unsigned char*)(GAS unsigned char*)kq_[27]; float* o_ = (float*)(GAS float*)kq_[26];
            if (kind == 1 || (kind == 3 && a0 == 5 && a1 < 128)) {
                att::Args AA{WP(bf16, WS_QB), WP(bf16, WS_KPB), WP(bf16, WS_VPB), KIN(2), KIN(3), o_ + OFF_KS, o_ + OFF_VS, WP(bf16, WS_ATT), KIN(14), WP(bf16, SA_Q), WP(bf16, SA_ATT), o_ + OFF_KP, o_ + OFF_VP};
                if (kind == 1) att::attn_unit<false>(AA, a0, a1, (char*)lds, lam); else att::attn_unit<true>(AA, a1 & 7, a1 >> 3, (char*)lds, lam);
            } else if (kind == 2 || (kind == 3 && a0 == 5)) { const bool smp = (kind == 3);
                att::SpArgs SA{WP(bf16, WS_UB), WP(bf16, WS_GVB), WP(float, WS_SS), KIN(15), KIN(16), KIN(17), WP(bf16, WS_SGU), o_ + OFF_GS, WP(bf16, SA_U), WP(bf16, SA_GV), WP(float, SA_SS), WP(bf16, SA_SGU)};
                if (smp) att::spatial_unit(SA, true, (a1 - 128) >> 2, (a1 - 128) & 3, (char*)lds); else att::spatial_unit_prompt(SA, a0, a1, (char*)lds); }
            else CH_UNIT(a0, a1);
            if (sig) CH_SIGNAL(sig);
        }
        if (rep + 1 < P5_REPS) GRID_BAR();
        }
    }
    GRID_BAR();
#endif
#if (PHM >> 6) & 1
    { pg8::Gemm g{ATT, WA, SEQ, DM, DM, SGU, WB}; pg8::DualOrder S; S.init(SEQ, DM, F.G, (int)blockIdx.x);
      pg8::EpiGateAB E{SGA, SGB, XN}; pg8::gemm_phase<pg8::EpiGateAB, pg8::DualOrder, true, true>(F.lds, g, S, E); }
    GRID_BAR();
#endif
#if (PHM >> 8) & 1
    { pg8::Gemm g{XN, WO, SEQ, DM, DM}; pg8::StaticOrder S; S.init(SEQ, DM, F.G, (int)blockIdx.x);
      pg8::EpiF32Stats E{FB, SS}; pg8::gemm_phase<pg8::EpiF32Stats, pg8::StaticOrder, false, true>(F.lds, g, S, E); }
    GRID_BAR();
#endif
#if (PHM >> 9) & 1
    row_phase<true, true>(F, F.gw, F.NGW, SEQ, FB, SS, HB, 1.0f, args.in[21], HB, args.in[22], XN);
    GRID_BAR();
#endif
#if (PHM >> 10) & 1
    { pg8::Gemm g{XN, W2IN, SEQ, 2 * DFF, DM}; pg8::StaticOrder S; S.init(SEQ, 2 * DFF, F.G, (int)blockIdx.x);
      pg8::EpiSwiglu E{ACT}; pg8::gemm_phase<pg8::EpiSwiglu, pg8::StaticOrder, true, true>(F.lds, g, S, E); }
    GRID_BAR();
    { pg8::Gemm g{ACT, W2OUT, SEQ, DM, DFF, nullptr, nullptr, LDF}; pg8::StaticOrder S; S.init(SEQ, DM, F.G, (int)blockIdx.x);
      pg8::EpiF32Stats E{FB, SS}; pg8::gemm_phase<pg8::EpiF32Stats, pg8::StaticOrder, false, true>(F.lds, g, S, E); }
    GRID_BAR();
#endif
#if (PHM >> 11) & 1
        row_phase<true, false>(F, F.gw, F.NGW, SEQ, FB, SS, HB, 0.5f, args.in[25], out + OFF_Y, nullptr, nullptr);
#endif
#ifdef PROBE_BF16
    for (size_t i = (size_t)blockIdx.x * 512 + F.tid; i < (size_t)MT * DM; i += (size_t)F.G * 512) out[OFF_Y + i] = bf2f(((const bf16*)PROBE_BF16)[i]);
#elif !((PHM >> 11) & 1)
    for (size_t i = (size_t)blockIdx.x * 512 + F.tid; i < (size_t)MT * DM / 4; i += (size_t)F.G * 512) ((f32x4*)(out + OFF_Y))[i] = (f32x4){0.f, 0.f, 0.f, 0.f};
#endif
#if !((PHM >> 5) & 1)
    for (size_t i = (size_t)blockIdx.x * 512 + F.tid; i < (size_t)256 * DM / 4; i += (size_t)F.G * 512) ((f32x4*)(out + OFF_GS))[i] = (f32x4){0.f, 0.f, 0.f, 0.f};
#endif
}

extern "C" void kernel_launch(void* const* d_in, const int* in_sizes, int n_in, void* d_out, int out_size, void* d_ws, size_t ws_size, hipStream_t stream) {
    static int grid = 0;
    if (grid == 0) {
        if (n_in != 26 || ws_size < WS_END) { fprintf(stderr, "kernel_launch: unexpected n_in %d / ws %zu\n", n_in, ws_size); grid = -1; return; }
        int dev = 0, cus = 0, per_cu = 0;
        if (hipGetDevice(&dev) != hipSuccess || hipDeviceGetAttribute(&cus, hipDeviceAttributeMultiprocessorCount, dev) != hipSuccess) { grid = -1; return; }
        if (hipFuncSetAttribute((const void*)mk_fwd, hipFuncAttributeMaxDynamicSharedMemorySize, LDS_BYTES) != hipSuccess) { fprintf(stderr, "kernel_launch: hipFuncSetAttribute failed\n"); grid = -1; return; }
        if (hipOccupancyMaxActiveBlocksPerMultiprocessor(&per_cu, (const void*)mk_fwd, NWAVES * 64, LDS_BYTES) != hipSuccess || per_cu < 1) { fprintf(stderr, "kernel_launch: occupancy query says %d\n", per_cu); per_cu = 1; }
        (void)hipGetLastError();
        grid = cus;
    }
    if (grid < 0) return;
    (void)hipMemsetAsync((char*)d_ws + WS_CTL, 0, CTL_ZERO_BYTES, stream);
    KArgs a{};
    for (int i = 0; i < 26; ++i) a.in[i] = (const float*)d_in[i];
    a.out = (float*)d_out; a.ws = (unsigned char*)d_ws;
    void* kargs[] = {&a};
    hipError_t e = hipLaunchCooperativeKernel((const void*)mk_fwd, dim3(grid), dim3(NWAVES * 64), kargs, LDS_BYTES, stream);
    if (e != hipSuccess) fprintf(stderr, "kernel_launch: cooperative launch failed: %s (grid %d)\n", hipGetErrorString(e), grid);
}
```

```cpp
#include <hip/hip_runtime.h>
#include <hip/hip_cooperative_groups.h>
#include <cstdio>
#include <cstdint>
namespace cg = cooperative_groups;
#ifndef P5M
#define P5M 7
#endif
#ifndef PHM
#define PHM 0xFFF
#endif

namespace pg8 {
#define PG8_LAS __attribute__((address_space(3)))
typedef unsigned short bf16_t;
typedef short bf16x8 __attribute__((ext_vector_type(8)));
typedef float f32x4 __attribute__((ext_vector_type(4)));
typedef float f32x2 __attribute__((ext_vector_type(2)));
typedef unsigned u32x4 __attribute__((ext_vector_type(4)));
typedef unsigned u32x2 __attribute__((ext_vector_type(2)));
constexpr int BM = 256, BK = 64, HALF = 128, HTB = HALF * BK * 2, STAGE_BYTES = 8 * HTB, NXCD = 8, WGM = 4;

__host__ __device__ __forceinline__ int lds_byte(int r, int c) { const int st = (r >> 4) * 2 + (c >> 5), rr = r & 15, cc = c & 31, ob = rr * 64 + cc * 2; return st * 1024 + (ob ^ (((ob >> 9) & 1) << 5)); }
__host__ __device__ __forceinline__ void stage_rc(int b, int& R, int& C) { const int st = b / 1024, sb = b % 1024, swz = sb ^ (((sb >> 9) & 1) << 5); R = (st >> 1) * 16 + swz / 64; C = (st & 1) * 32 + (swz % 64) / 2; }
__host__ __device__ __forceinline__ int perm32(int rho) { const int n = rho >> 4, i = rho & 15; return 8 * (i >> 2) + 4 * n + (i & 3); }

struct Unit { int pm, pn, w; };
struct Gemm { const bf16_t* A; const bf16_t* Bt; int M, N, K; const bf16_t* A2 = nullptr; const bf16_t* Bt2 = nullptr; int ld = 0; };

struct StaticOrder {
    int nM, nN, nwg, G, c;
    __host__ __device__ void init(int M, int N, int G_, int c_) { nM = M / BM; nN = N / BM; nwg = nM * nN; G = G_; c = c_; }
    __host__ __device__ bool next(int i, Unit& u) const {
        const long L = (long)i * G + c; if (L >= nwg) return false;
        int wgid = (int)L; { const int q = nwg / NXCD, r = nwg % NXCD, xcd = wgid % NXCD, off = wgid / NXCD; wgid = (xcd < r ? xcd * (q + 1) : r * (q + 1) + (xcd - r) * q) + off; }
        const int nig = WGM * nN, gid = wgid / nig, fm = gid * WGM, gsz = (nM - fm) < WGM ? (nM - fm) : WGM;
        u.pm = fm + ((wgid % nig) % gsz); u.pn = (wgid % nig) / gsz; u.w = 0; return true;
    }
    __device__ __forceinline__ void a_ready(const Unit&) const {}
    __device__ __forceinline__ void done(const Unit&) const {}
};
struct DualOrder {
    StaticOrder so;
    __host__ __device__ void init(int M, int N, int G_, int c_) { so.init(M, N, G_, c_); }
    __host__ __device__ bool next(int i, Unit& u) const { if (!so.next(i >> 1, u)) return false; u.w = i & 1; return true; }
    __device__ __forceinline__ void a_ready(const Unit&) const {}
    __device__ __forceinline__ void done(const Unit&) const {}
};

typedef float f32x2_cv __attribute__((ext_vector_type(2))); typedef __bf16 bf16x2_cv __attribute__((ext_vector_type(2)));
struct OneUnit {
    int pm, pn;
    __device__ __forceinline__ bool next(int i, Unit& u) const { if (i > 0) return false; u.pm = pm; u.pn = pn; u.w = 0; return true; }
    __device__ __forceinline__ void a_ready(const Unit&) const {}
    __device__ __forceinline__ void done(const Unit&) const {}
};
__device__ __forceinline__ unsigned cvt_pk_bf16(float lo, float hi) { f32x2_cv v = {lo, hi}; bf16x2_cv b = __builtin_convertvector(v, bf16x2_cv); return __builtin_bit_cast(unsigned, b); }

template <class Epi, class Sched, bool ALIGN_EPI = false, bool SP2 = false>
__device__ __forceinline__ void gemm_phase(PG8_LAS unsigned char* lds, const Gemm g, const Sched& S, const Epi& E) {
    int tid = threadIdx.x; asm volatile("" : "+v"(tid));
    const int wid = __builtin_amdgcn_readfirstlane(tid >> 6), lane = tid & 63, wr = wid >> 2, wc = wid & 3, fr = lane & 15, fq = lane >> 4;
    const int K = g.K, nt = K / BK, LD = g.ld ? g.ld : g.K;
    unsigned voffA[2], voffB[2];
#pragma unroll
    for (int i = 0; i < 2; ++i) { int R, C; stage_rc(tid * 16 + i * 8192, R, C); const int Rb = Epi::PERM ? ((R & ~31) + perm32(R & 31)) : R;
        voffA[i] = (unsigned)(R * LD + C) * 2u; voffB[i] = (unsigned)(Rb * LD + C) * 2u; }
    const size_t kstep = (size_t)(BK * 2);
    const size_t hstep = (size_t)HALF * LD * 2;
    const size_t tstep = 2 * hstep;
    const unsigned ldsw = (unsigned)wid * 1024u;
    const int aoff = lds_byte(wr * 64 + fr, fq * 8), boff = lds_byte(wc * 32 + fr, fq * 8);
#define PG8_SA(b, h) (((b) * 2 + (h)) * HTB)
#define PG8_SB(b, h) ((4 + (b) * 2 + (h)) * HTB)
#define PG8_STAGE(bufoff, gbase, voff) do { _Pragma("unroll") for (int _i = 0; _i < 2; ++_i) \
        __builtin_amdgcn_global_load_lds((const unsigned*)((const char*)(gbase) + (voff)[_i]), (PG8_LAS unsigned*)(lds + (bufoff) + ldsw + _i * 8192), 16, 0, 0); } while (0)
#define PG8_LDA(dst, b, h) do { _Pragma("unroll") for (int m = 0; m < 4; ++m) _Pragma("unroll") for (int k = 0; k < 2; ++k) dst[m][k] = *(const PG8_LAS bf16x8*)(lds + PG8_SA(b, h) + aoff + m * 2048 + k * 1024); } while (0)
#define PG8_LDB(dst, b, h) do { _Pragma("unroll") for (int n = 0; n < 2; ++n) _Pragma("unroll") for (int k = 0; k < 2; ++k) dst[n][k] = *(const PG8_LAS bf16x8*)(lds + PG8_SB(b, h) + boff + n * 2048 + k * 1024); } while (0)
#define PG8_MMA(ai, bj, At, Bt) do { __builtin_amdgcn_s_setprio(1); _Pragma("unroll") for (int m = 0; m < 4; ++m) _Pragma("unroll") for (int n = 0; n < 2; ++n) _Pragma("unroll") for (int k = 0; k < 2; ++k) \
        acc[ai][bj][m][n] = __builtin_amdgcn_mfma_f32_16x16x32_bf16(Bt[n][k], At[m][k], acc[ai][bj][m][n], 0, 0, 0); __builtin_amdgcn_s_setprio(0); } while (0)
#define PG8_WAIT_V(n) asm volatile("s_waitcnt vmcnt(" #n ")" ::: "memory")
#define PG8_WAIT_L(n) asm volatile("s_waitcnt lgkmcnt(" #n ")" ::: "memory")
#define PG8_BAR __builtin_amdgcn_s_barrier()
#define PG8_SCHED __builtin_amdgcn_sched_barrier(0)
    Unit cur, nxt; int ui = 0;
    if (!S.next(0, cur)) return;
    f32x4 acc[2][2][4][2];
#pragma unroll
    for (int a = 0; a < 2; ++a)
#pragma unroll
        for (int b = 0; b < 2; ++b)
#pragma unroll
            for (int m = 0; m < 4; ++m)
#pragma unroll
                for (int n = 0; n < 2; ++n) acc[a][b][m][n] = (f32x4){0.f, 0.f, 0.f, 0.f};
    bf16x8 At[4][2], B0[2][2], B1[2][2];
    const char* cA = (const char*)(cur.w ? g.A2 : g.A) + (size_t)cur.pm * tstep; const char* cB = (const char*)(cur.w ? g.Bt2 : g.Bt) + (size_t)cur.pn * tstep;
    S.a_ready(cur);
    if constexpr (SP2) {
        PG8_STAGE(PG8_SB(0, 0), cB, voffB); PG8_STAGE(PG8_SB(0, 1), cB + hstep, voffB); PG8_STAGE(PG8_SA(0, 0), cA, voffA); PG8_STAGE(PG8_SA(0, 1), cA + hstep, voffA);
        if (wr == 1) PG8_BAR;
        PG8_WAIT_V(2); PG8_BAR;
        PG8_STAGE(PG8_SB(1, 0), cB + kstep, voffB); PG8_STAGE(PG8_SA(1, 0), cA + kstep, voffA); PG8_STAGE(PG8_SB(1, 1), cB + hstep + kstep, voffB);
        PG8_WAIT_V(6); PG8_BAR;
    } else {
        PG8_STAGE(PG8_SB(0, 0), cB, voffB); PG8_STAGE(PG8_SA(0, 0), cA, voffA); PG8_STAGE(PG8_SB(0, 1), cB + hstep, voffB); PG8_STAGE(PG8_SA(0, 1), cA + hstep, voffA);
        if (wr == 1) PG8_BAR;
        PG8_WAIT_V(4); PG8_BAR;
        PG8_STAGE(PG8_SB(1, 0), cB + kstep, voffB); PG8_STAGE(PG8_SA(1, 0), cA + kstep, voffA); PG8_STAGE(PG8_SB(1, 1), cB + hstep + kstep, voffB);
        PG8_WAIT_V(6); PG8_BAR;
    }
    for (;;) {
        const bool has_next = S.next(ui + 1, nxt);
        const char* nA = has_next ? (const char*)(nxt.w ? g.A2 : g.A) + (size_t)nxt.pm * tstep : cA; const char* nB = has_next ? (const char*)(nxt.w ? g.Bt2 : g.Bt) + (size_t)nxt.pn * tstep : cB;
        for (int t = 0; t < nt; t += 2) {
            const bool last = (t == nt - 2);
            const char* a1 = cA + (size_t)(t + 1) * kstep;
            const char* a2 = last ? nA : cA + (size_t)(t + 2) * kstep; const char* b2 = last ? nB : cB + (size_t)(t + 2) * kstep;
            const char* a3 = a2 + kstep; const char* b3 = b2 + kstep;
            if (last && has_next) S.a_ready(nxt);
            if constexpr (SP2) {
            PG8_LDB(B0, 0, 0); PG8_LDB(B1, 0, 1); PG8_SCHED; PG8_LDA(At, 0, 0); PG8_STAGE(PG8_SA(1, 1), a1 + hstep, voffA);
            PG8_WAIT_V(8); PG8_WAIT_L(0); PG8_BAR; PG8_MMA(0, 0, At, B0); PG8_MMA(0, 1, At, B1); PG8_BAR; PG8_SCHED;
            PG8_LDA(At, 0, 1); PG8_STAGE(PG8_SB(0, 0), b2, voffB); PG8_STAGE(PG8_SB(0, 1), b2 + hstep, voffB); PG8_STAGE(PG8_SA(0, 0), a2, voffA);
            PG8_WAIT_V(8); PG8_WAIT_L(0); PG8_BAR; PG8_MMA(1, 0, At, B0); PG8_MMA(1, 1, At, B1); PG8_BAR; PG8_SCHED;
            PG8_LDB(B0, 1, 0); PG8_LDB(B1, 1, 1); PG8_SCHED; PG8_LDA(At, 1, 0); PG8_STAGE(PG8_SA(0, 1), a2 + hstep, voffA);
            PG8_WAIT_V(8); PG8_WAIT_L(0); PG8_BAR; PG8_MMA(0, 0, At, B0); PG8_MMA(0, 1, At, B1); PG8_BAR; PG8_SCHED;
            PG8_LDA(At, 1, 1); PG8_STAGE(PG8_SB(1, 0), b3, voffB); PG8_STAGE(PG8_SB(1, 1), b3 + hstep, voffB); PG8_STAGE(PG8_SA(1, 0), a3, voffA);
            PG8_WAIT_V(8); PG8_WAIT_L(0); PG8_BAR; PG8_MMA(1, 0, At, B0); PG8_MMA(1, 1, At, B1); PG8_BAR; PG8_SCHED;
            } else {
            PG8_LDB(B0, 0, 0); PG8_SCHED; PG8_LDA(At, 0, 0); PG8_STAGE(PG8_SA(1, 1), a1 + hstep, voffA);
            PG8_WAIT_L(8); PG8_BAR; PG8_WAIT_L(0); PG8_MMA(0, 0, At, B0); PG8_BAR; PG8_SCHED;
            PG8_LDB(B1, 0, 1); PG8_STAGE(PG8_SB(0, 0), b2, voffB);
            PG8_BAR; PG8_WAIT_L(0); PG8_MMA(0, 1, At, B1); PG8_BAR;
            PG8_LDA(At, 0, 1); PG8_STAGE(PG8_SA(0, 0), a2, voffA);
            PG8_BAR; PG8_WAIT_L(0); PG8_MMA(1, 0, At, B0); PG8_BAR; PG8_SCHED;
            PG8_STAGE(PG8_SB(0, 1), b2 + hstep, voffB);
            PG8_WAIT_V(6); PG8_BAR; PG8_MMA(1, 1, At, B1); PG8_BAR;
            PG8_LDB(B0, 1, 0); PG8_SCHED; PG8_LDA(At, 1, 0); PG8_STAGE(PG8_SA(0, 1), a2 + hstep, voffA);
            PG8_WAIT_L(8); PG8_BAR; PG8_WAIT_L(0); PG8_MMA(0, 0, At, B0); PG8_BAR; PG8_SCHED;
            PG8_LDB(B1, 1, 1); PG8_STAGE(PG8_SB(1, 0), b3, voffB);
            PG8_BAR; PG8_WAIT_L(0); PG8_MMA(0, 1, At, B1); PG8_BAR;
            PG8_LDA(At, 1, 1); PG8_STAGE(PG8_SA(1, 0), a3, voffA);
            PG8_BAR; PG8_WAIT_L(0); PG8_MMA(1, 0, At, B0); PG8_BAR; PG8_SCHED;
            PG8_STAGE(PG8_SB(1, 1), b3 + hstep, voffB);
            PG8_WAIT_V(6); PG8_BAR; PG8_MMA(1, 1, At, B1); PG8_BAR;
            }
        }
        if constexpr (ALIGN_EPI) { if (wr == 0) PG8_BAR; }
        E(acc, cur, wr, wc, fr, fq); S.done(cur);
        if (!has_next) break;
        if (!(Epi::DUAL && cur.w == 0)) {
#pragma unroll
        for (int a = 0; a < 2; ++a)
#pragma unroll
            for (int b = 0; b < 2; ++b)
#pragma unroll
                for (int m = 0; m < 4; ++m)
#pragma unroll
                    for (int n = 0; n < 2; ++n) acc[a][b][m][n] = (f32x4){0.f, 0.f, 0.f, 0.f};
        }
        cur = nxt; cA = nA; cB = nB; ++ui;
        if constexpr (ALIGN_EPI) { if (wr == 1) PG8_BAR; }
    }
    PG8_WAIT_V(0);
    if constexpr (!ALIGN_EPI) { if (wr == 0) PG8_BAR; }
    PG8_BAR;
#undef PG8_SA
#undef PG8_SB
#undef PG8_STAGE
#undef PG8_LDA
#undef PG8_LDB
#undef PG8_MMA
#undef PG8_WAIT_V
#undef PG8_WAIT_L
#undef PG8_BAR
#undef PG8_SCHED
}
}

constexpr int DM = 1024, SEQ = 16384, DECB = 16, DECS = 16, PAST = 2048, NH = 8, DFF = 2816, INC = 7168;
constexpr int MT = SEQ + DECB * DECS;
constexpr int LDF = 2880;
constexpr float EPS = 1e-6f;
constexpr float C2 = 0.18033688011112042f;
constexpr float LAM_INIT = 0.2f;

constexpr size_t OFF_Y = 0, OFF_KP = (size_t)MT * DM, OFF_VP = OFF_KP + (size_t)SEQ * DM, OFF_KS = OFF_VP + (size_t)SEQ * DM,
                 OFF_VS = OFF_KS + (size_t)256 * DM, OFF_GS = OFF_VS + (size_t)256 * DM;

constexpr size_t MiB = 1u << 20;
constexpr size_t WS_CTL = 0, CTL_ZERO_BYTES = 64 * 1024;
constexpr size_t WS_ROPE = 1 * MiB;
constexpr size_t WS_SS = 2 * MiB;
constexpr size_t WS_W1IN = 4 * MiB;
constexpr size_t WS_W1OUT = 15 * MiB;
constexpr size_t WS_WIN = 21 * MiB;
constexpr size_t WS_WA = 35 * MiB, WS_WB = 37 * MiB, WS_WO = 39 * MiB;
constexpr size_t WS_W2IN = 41 * MiB, WS_W2OUT = 52 * MiB;
constexpr size_t WS_XN = 58 * MiB;
constexpr size_t WS_ACT = 91 * MiB;
constexpr size_t WS_UB = WS_ACT, WS_GVB = WS_ACT + 33 * MiB;
constexpr size_t WS_F = 184 * MiB;
constexpr size_t WS_ATT = WS_F, WS_SGU = WS_F + 33 * MiB;
constexpr size_t WS_H = 250 * MiB;
constexpr size_t WS_QB = 316 * MiB, WS_KPB = 349 * MiB, WS_VPB = 382 * MiB;
constexpr size_t WS_T1 = WS_QB;
constexpr size_t WS_SGA = 415 * MiB, WS_SGB = 448 * MiB;
constexpr size_t WS_SA = 481 * MiB;
constexpr size_t SA_XN = WS_SA, SA_ACT = WS_SA + 1 * MiB, SA_F = WS_SA + 3 * MiB, SA_H = WS_SA + 4 * MiB, SA_T1 = WS_SA + 5 * MiB, SA_Q = WS_SA + 6 * MiB,
                 SA_U = SA_Q + 512 * 1024, SA_GV = SA_U + 512 * 1024, SA_SGA = SA_GV + 512 * 1024, SA_SGB = SA_SGA + 512 * 1024, SA_ATT = SA_SGB + 512 * 1024,
                 SA_SGU = SA_ATT + 512 * 1024, SA_SS = SA_SGU + 512 * 1024;
constexpr size_t WS_END = 493 * MiB;
static_assert(WS_SS + (size_t)MT * 16 * 4 <= WS_W1IN && WS_XN + (size_t)MT * DM * 2 <= WS_ACT && WS_ACT + (size_t)MT * LDF * 2 <= WS_F &&
              WS_F + (size_t)MT * DM * 4 <= WS_H && WS_H + (size_t)MT * DM * 4 <= WS_QB &&
              WS_GVB + (size_t)MT * DM * 2 <= WS_F && WS_SGU + (size_t)MT * DM * 2 <= WS_H && true &&
              WS_W2OUT + (size_t)DM * LDF * 2 <= WS_XN && WS_W1IN + (size_t)2 * DFF * DM * 2 <= WS_W1OUT && WS_W1OUT + (size_t)DM * LDF * 2 <= WS_WIN &&
              WS_WIN + (size_t)INC * DM * 2 <= WS_WA && WS_W2IN + (size_t)2 * DFF * DM * 2 <= WS_W2OUT, "d_ws map");
constexpr int CW_BAR = 4096;
constexpr int CW_CH = 2048;
constexpr int CW_Q = 1024;

constexpr int RING_BYTES = 131072, MISC_OFF = RING_BYTES + 320, LDS_BYTES = 147456;
constexpr int NWAVES = 8;

#define GAS __attribute__((address_space(1)))
#define LAS __attribute__((address_space(3)))
typedef unsigned short bf16;
typedef unsigned v4u __attribute__((ext_vector_type(4)));
typedef unsigned v2u __attribute__((ext_vector_type(2)));
typedef float f32x4 __attribute__((ext_vector_type(4)));
#define LDS_WAIT() asm volatile("s_waitcnt lgkmcnt(0)" ::: "memory")
__device__ __forceinline__ unsigned f2bf(float f) { unsigned u = __builtin_bit_cast(unsigned, f); return (u + 0x7fffu + ((u >> 16) & 1u)) >> 16; }
__device__ __forceinline__ unsigned pk2(float lo, float hi) { return f2bf(lo) | (f2bf(hi) << 16); }
__device__ __forceinline__ float bf2f(unsigned short b) { return __builtin_bit_cast(float, (unsigned)b << 16); }
__device__ __forceinline__ float bflo(unsigned w) { return __builtin_bit_cast(float, w << 16); }
__device__ __forceinline__ float bfhi(unsigned w) { return __builtin_bit_cast(float, w & 0xffff0000u); }
__device__ __forceinline__ float wave_sum(float v) {
#pragma unroll
    for (int o = 1; o < 64; o <<= 1) v += __shfl_xor(v, o);
    return v;
}
__device__ __forceinline__ float fast_rcp(float x) { return __builtin_amdgcn_rcpf(x); }
__device__ __forceinline__ float sigmoidf_(float x) { return fast_rcp(1.0f + __builtin_amdgcn_exp2f(-1.4426950408889634f * x)); }
__device__ __forceinline__ float siluf_(float x) { return x * sigmoidf_(x); }
__device__ __forceinline__ float geluf_(float x) { const float z = 1.5957691216057308f * (x + 0.044715f * x * x * x); return x * sigmoidf_(z); }

namespace pg8 {
struct EpiSwiglu {
    static constexpr bool PERM = true, DUAL = false;
    bf16_t* O;
    __device__ __forceinline__ void operator()(const f32x4 (&acc)[2][2][4][2], const Unit& u, int wr, int wc, int fr, int fq) const {
        const int row0 = u.pm * BM + wr * 64 + fr, col0 = u.pn * 128 + wc * 32 + 8 * fq;
#pragma unroll
        for (int ai = 0; ai < 2; ++ai)
#pragma unroll
            for (int m = 0; m < 4; ++m) {
                const f32x4 a0 = acc[ai][0][m][0], a1 = acc[ai][0][m][1], b0 = acc[ai][1][m][0], b1 = acc[ai][1][m][1];
                u32x4 w;
                w.x = cvt_pk_bf16(siluf_(a0[0]) * b0[0], siluf_(a0[1]) * b0[1]); w.y = cvt_pk_bf16(siluf_(a0[2]) * b0[2], siluf_(a0[3]) * b0[3]);
                w.z = cvt_pk_bf16(siluf_(a1[0]) * b1[0], siluf_(a1[1]) * b1[1]); w.w = cvt_pk_bf16(siluf_(a1[2]) * b1[2], siluf_(a1[3]) * b1[3]);
                *(u32x4*)(O + (size_t)(row0 + ai * HALF + m * 16) * LDF + col0) = w;
            }
    }
};
struct EpiF32Stats {
    static constexpr bool PERM = true, DUAL = false;
    bf16_t* O; float* SS;
    __device__ __forceinline__ void operator()(const f32x4 (&acc)[2][2][4][2], const Unit& u, int wr, int wc, int fr, int fq) const {
        const int row0 = u.pm * BM + wr * 64 + fr, col0 = u.pn * BM + wc * 32 + 8 * fq;
#pragma unroll
        for (int ai = 0; ai < 2; ++ai)
#pragma unroll
            for (int m = 0; m < 4; ++m) {
                const int row = row0 + ai * HALF + m * 16; float s = 0.f;
#pragma unroll
                for (int bj = 0; bj < 2; ++bj) { const f32x4 v0 = acc[ai][bj][m][0], v1 = acc[ai][bj][m][1];
                    u32x4 w; w.x = cvt_pk_bf16(v0[0], v0[1]); w.y = cvt_pk_bf16(v0[2], v0[3]); w.z = cvt_pk_bf16(v1[0], v1[1]); w.w = cvt_pk_bf16(v1[2], v1[3]);
                    *(u32x4*)(O + (size_t)row * DM + col0 + bj * HALF) = w;
                    s += (v0[0] * v0[0] + v0[1] * v0[1]) + (v0[2] * v0[2] + v0[3] * v0[3]) + (v1[0] * v1[0] + v1[1] * v1[1]) + (v1[2] * v1[2] + v1[3] * v1[3]); }
                s += __shfl_xor(s, 16); s += __shfl_xor(s, 32);
                if (fq == 0) SS[(size_t)row * 16 + u.pn * 4 + wc] = s;
            }
    }
};
struct EpiProj {
    static constexpr bool PERM = true, DUAL = false;
    bf16_t *Qb, *Kp, *Vp, *Ub, *GVb, *SGA, *SGB; float* kout; float* vout; float* SS; const float* rope; bool samp;
    __device__ __forceinline__ void operator()(const f32x4 (&acc)[2][2][4][2], const Unit& u, int wr, int wc, int fr, int fq) const {
        const int type = u.pn >> 2, cb = (u.pn & 3) * 256;
        const int row0 = u.pm * BM + wr * 64 + fr, col0 = cb + wc * 32 + 8 * fq;
        if (type <= 1) {
            const bool ropew = ((wc & 1) == 0);
#pragma unroll
            for (int ai = 0; ai < 2; ++ai)
#pragma unroll
                for (int m = 0; m < 4; ++m) {
                    const int row = row0 + ai * HALF + m * 16;
                    f32x4 v[2][2];
#pragma unroll
                    for (int bj = 0; bj < 2; ++bj)
#pragma unroll
                        for (int n = 0; n < 2; ++n) v[bj][n] = acc[ai][bj][m][n];
                    if (ropew) {
                        const int pos = samp ? (PAST + (row & 15)) : row;
                        const f32x4* cp = (const f32x4*)(rope + (size_t)pos * 16);
                        const f32x4 cs[2] = {cp[0], cp[1]}, sn[2] = {cp[2], cp[3]};
#pragma unroll
                        for (int bj = 0; bj < 2; ++bj)
#pragma unroll
                            for (int n = 0; n < 2; ++n)
#pragma unroll
                                for (int e = 0; e < 4; ++e) {
                                    const float x = v[bj][n][e], p = __shfl_xor(x, 16);
                                    const float sgn = (fq == 0) ? -sn[n][e] : sn[n][e];
                                    const float rot = x * cs[n][e] + p * sgn;
                                    v[bj][n][e] = (fq < 2) ? rot : x;
                                }
                    }
                    if (type == 0) {
#pragma unroll
                        for (int bj = 0; bj < 2; ++bj) {
                            u32x4 w; w.x = cvt_pk_bf16(v[bj][0][0] * C2, v[bj][0][1] * C2); w.y = cvt_pk_bf16(v[bj][0][2] * C2, v[bj][0][3] * C2);
                            w.z = cvt_pk_bf16(v[bj][1][0] * C2, v[bj][1][1] * C2); w.w = cvt_pk_bf16(v[bj][1][2] * C2, v[bj][1][3] * C2);
                            *(u32x4*)(Qb + (size_t)row * DM + col0 + bj * HALF) = w;
                        }
                    } else {
                        float* kp = kout + (size_t)row * DM;
#pragma unroll
                        for (int bj = 0; bj < 2; ++bj) {
                            if (samp) { *(f32x4*)(kp + col0 + bj * HALF) = v[bj][0]; *(f32x4*)(kp + col0 + bj * HALF + 4) = v[bj][1]; }
                            if (!samp) {
                                u32x4 w; w.x = cvt_pk_bf16(v[bj][0][0], v[bj][0][1]); w.y = cvt_pk_bf16(v[bj][0][2], v[bj][0][3]);
                                w.z = cvt_pk_bf16(v[bj][1][0], v[bj][1][1]); w.w = cvt_pk_bf16(v[bj][1][2], v[bj][1][3]);
                                *(u32x4*)(Kp + (size_t)row * DM + col0 + bj * HALF) = w;
                            }
                        }
                    }
                }
        } else if (type == 2) {
#pragma unroll
            for (int ai = 0; ai < 2; ++ai)
#pragma unroll
                for (int m = 0; m < 4; ++m) {
                    const int row = row0 + ai * HALF + m * 16;
                    float* vp = vout + (size_t)row * DM;
#pragma unroll
                    for (int bj = 0; bj < 2; ++bj) {
                        const f32x4 v0 = acc[ai][bj][m][0], v1 = acc[ai][bj][m][1];
                        if (samp) { *(f32x4*)(vp + col0 + bj * HALF) = v0; *(f32x4*)(vp + col0 + bj * HALF + 4) = v1; }
                        if (!samp) {
                            const int c8 = col0 + bj * HALF, hh = c8 >> 7, cc = c8 & 127;
                            bf16_t* vt = Vp + (((size_t)(hh * (SEQ / 64) + (row >> 6)) * 128 + cc) << 6) + (row & 63);
                            vt[0 * 64] = (bf16_t)(cvt_pk_bf16(v0[0], 0.f) & 0xffffu); vt[1 * 64] = (bf16_t)(cvt_pk_bf16(v0[1], 0.f) & 0xffffu);
                            vt[2 * 64] = (bf16_t)(cvt_pk_bf16(v0[2], 0.f) & 0xffffu); vt[3 * 64] = (bf16_t)(cvt_pk_bf16(v0[3], 0.f) & 0xffffu);
                            vt[4 * 64] = (bf16_t)(cvt_pk_bf16(v1[0], 0.f) & 0xffffu); vt[5 * 64] = (bf16_t)(cvt_pk_bf16(v1[1], 0.f) & 0xffffu);
                            vt[6 * 64] = (bf16_t)(cvt_pk_bf16(v1[2], 0.f) & 0xffffu); vt[7 * 64] = (bf16_t)(cvt_pk_bf16(v1[3], 0.f) & 0xffffu);
                        }
                    }
                }
        } else if (type <= 4) {
            bf16_t* O = (type == 3) ? Ub : GVb;
#pragma unroll
            for (int ai = 0; ai < 2; ++ai)
#pragma unroll
                for (int m = 0; m < 4; ++m) {
                    const int row = row0 + ai * HALF + m * 16; float s = 0.f;
#pragma unroll
                    for (int bj = 0; bj < 2; ++bj) {
                        f32x4 v0 = acc[ai][bj][m][0], v1 = acc[ai][bj][m][1];
#pragma unroll
                        for (int e = 0; e < 4; ++e) { v0[e] = geluf_(v0[e]); v1[e] = geluf_(v1[e]); }
                        s += (v0[0] * v0[0] + v0[1] * v0[1]) + (v0[2] * v0[2] + v0[3] * v0[3]) + (v1[0] * v1[0] + v1[1] * v1[1]) + (v1[2] * v1[2] + v1[3] * v1[3]);
                        u32x4 w; w.x = cvt_pk_bf16(v0[0], v0[1]); w.y = cvt_pk_bf16(v0[2], v0[3]); w.z = cvt_pk_bf16(v1[0], v1[1]); w.w = cvt_pk_bf16(v1[2], v1[3]);
                        *(u32x4*)(O + (size_t)row * DM + col0 + bj * HALF) = w;
                    }
                    if (type == 4) { s += __shfl_xor(s, 16); s += __shfl_xor(s, 32); if (fq == 0) SS[(size_t)row * 16 + (u.pn & 3) * 4 + wc] = s; }
                }
        } else {
            bf16_t* O = (type == 5) ? SGA : SGB;
#pragma unroll
            for (int ai = 0; ai < 2; ++ai)
#pragma unroll
                for (int m = 0; m < 4; ++m) {
                    const int row = row0 + ai * HALF + m * 16;
#pragma unroll
                    for (int bj = 0; bj < 2; ++bj) {
                        const f32x4 v0 = acc[ai][bj][m][0], v1 = acc[ai][bj][m][1];
#ifdef EXP_CONST
                        u32x4 w; w.x = 0x3f803f80u; w.y = 0x3f803f80u; w.z = 0x3f803f80u; w.w = 0x3f803f80u; (void)v0; (void)v1;
#else
                        u32x4 w; w.x = cvt_pk_bf16(sigmoidf_(v0[0]), sigmoidf_(v0[1])); w.y = cvt_pk_bf16(sigmoidf_(v0[2]), sigmoidf_(v0[3]));
                        w.z = cvt_pk_bf16(sigmoidf_(v1[0]), sigmoidf_(v1[1])); w.w = cvt_pk_bf16(sigmoidf_(v1[2]), sigmoidf_(v1[3]));
#endif
                        *(u32x4*)(O + (size_t)row * DM + col0 + bj * HALF) = w;
                    }
                }
        }
    }
};
struct EpiGateA {
    static constexpr bool PERM = false, DUAL = false;
    float* T1; const bf16_t* SG;
    __device__ __forceinline__ void operator()(const f32x4 (&acc)[2][2][4][2], const Unit& u, int wr, int wc, int fr, int fq) const {
        const int row0 = u.pm * BM + wr * 64 + fr, col0 = u.pn * BM + wc * 32 + 4 * fq;
#pragma unroll
        for (int ai = 0; ai < 2; ++ai)
#pragma unroll
            for (int m = 0; m < 4; ++m) {
                const size_t ro = (size_t)(row0 + ai * HALF + m * 16) * DM + col0;
#pragma unroll
                for (int bj = 0; bj < 2; ++bj)
#pragma unroll
                    for (int n = 0; n < 2; ++n) {
                        const u32x2 g = *(const u32x2*)(SG + ro + bj * HALF + n * 16); const f32x4 v = acc[ai][bj][m][n];
                        f32x4 o; o[0] = v[0] * bflo(g.x); o[1] = v[1] * bfhi(g.x); o[2] = v[2] * bflo(g.y); o[3] = v[3] * bfhi(g.y);
                        *(f32x4*)(T1 + ro + bj * HALF + n * 16) = o;
                    }
            }
    }
};
struct EpiGateB {
    static constexpr bool PERM = true, DUAL = false;
    const float* T1; const bf16_t* SG; bf16_t* O;
    __device__ __forceinline__ void operator()(const f32x4 (&acc)[2][2][4][2], const Unit& u, int wr, int wc, int fr, int fq) const {
        const int row0 = u.pm * BM + wr * 64 + fr, col0 = u.pn * BM + wc * 32 + 8 * fq;
#pragma unroll
        for (int ai = 0; ai < 2; ++ai)
#pragma unroll
            for (int m = 0; m < 4; ++m) {
                const size_t ro = (size_t)(row0 + ai * HALF + m * 16) * DM + col0;
#pragma unroll
                for (int bj = 0; bj < 2; ++bj) {
                    const u32x4 g = *(const u32x4*)(SG + ro + bj * HALF);
                    const f32x4 t0 = *(const f32x4*)(T1 + ro + bj * HALF), t1 = *(const f32x4*)(T1 + ro + bj * HALF + 4);
                    const f32x4 v0 = acc[ai][bj][m][0], v1 = acc[ai][bj][m][1];
                    u32x4 w;
#ifndef GATEB_MODE
#define GATEB_MODE 0
#endif
                    const float ka = (GATEB_MODE == 2) ? 0.f : 1.f, kb = (GATEB_MODE == 1) ? 0.f : 1.f;
                    w.x = cvt_pk_bf16(ka * t0[0] + kb * v0[0] * bflo(g.x), ka * t0[1] + kb * v0[1] * bfhi(g.x)); w.y = cvt_pk_bf16(ka * t0[2] + kb * v0[2] * bflo(g.y), ka * t0[3] + kb * v0[3] * bfhi(g.y));
                    w.z = cvt_pk_bf16(ka * t1[0] + kb * v1[0] * bflo(g.z), ka * t1[1] + kb * v1[1] * bfhi(g.z)); w.w = cvt_pk_bf16(ka * t1[2] + kb * v1[2] * bflo(g.w), ka * t1[3] + kb * v1[3] * bfhi(g.w));
                    *(u32x4*)(O + ro + bj * HALF) = w;
                }
            }
    }
};
struct EpiGateAB {
    static constexpr bool PERM = true, DUAL = true;
    const bf16_t* SGa; const bf16_t* SGb; bf16_t* O;
    __device__ __forceinline__ void operator()(f32x4 (&acc)[2][2][4][2], const Unit& u, int wr, int wc, int fr, int fq) const {
        const int row0 = u.pm * BM + wr * 64 + fr, col0 = u.pn * BM + wc * 32 + 8 * fq;
#pragma unroll
        for (int ai = 0; ai < 2; ++ai)
#pragma unroll
            for (int m = 0; m < 4; ++m) {
                const size_t ro = (size_t)(row0 + ai * HALF + m * 16) * DM + col0;
#pragma unroll
                for (int bj = 0; bj < 2; ++bj) {
                    const u32x4 gb = *(const u32x4*)(SGb + ro + bj * HALF);
                    f32x4& v0 = acc[ai][bj][m][0]; f32x4& v1 = acc[ai][bj][m][1];
                    if (u.w == 0) {
                        const u32x4 ga = *(const u32x4*)(SGa + ro + bj * HALF);
                        v0[0] *= bflo(ga.x) * __builtin_amdgcn_rcpf(bflo(gb.x)); v0[1] *= bfhi(ga.x) * __builtin_amdgcn_rcpf(bfhi(gb.x));
                        v0[2] *= bflo(ga.y) * __builtin_amdgcn_rcpf(bflo(gb.y)); v0[3] *= bfhi(ga.y) * __builtin_amdgcn_rcpf(bfhi(gb.y));
                        v1[0] *= bflo(ga.z) * __builtin_amdgcn_rcpf(bflo(gb.z)); v1[1] *= bfhi(ga.z) * __builtin_amdgcn_rcpf(bfhi(gb.z));
                        v1[2] *= bflo(ga.w) * __builtin_amdgcn_rcpf(bflo(gb.w)); v1[3] *= bfhi(ga.w) * __builtin_amdgcn_rcpf(bfhi(gb.w));
                    } else {
                        u32x4 w;
                        w.x = cvt_pk_bf16(v0[0] * bflo(gb.x), v0[1] * bfhi(gb.x)); w.y = cvt_pk_bf16(v0[2] * bflo(gb.y), v0[3] * bfhi(gb.y));
                        w.z = cvt_pk_bf16(v1[0] * bflo(gb.z), v1[1] * bfhi(gb.z)); w.w = cvt_pk_bf16(v1[2] * bflo(gb.w), v1[3] * bfhi(gb.w));
                        *(u32x4*)(O + ro + bj * HALF) = w;
                    }
                }
            }
    }
};
}

namespace att {
using bf16x8 = __attribute__((ext_vector_type(8))) short;
using s16x4 = __attribute__((ext_vector_type(4))) short;
using f32x16 = __attribute__((ext_vector_type(16))) float;
using f32x8 = __attribute__((ext_vector_type(8))) float;
using u32x4 = __attribute__((ext_vector_type(4))) unsigned;
constexpr int KVBLK = 64, LDR = 1024;
constexpr int SHM_V = KVBLK * 128 * 2, SHM_K = KVBLK * 128 * 2, SHM_ATTN = 3 * SHM_V + 3 * SHM_K + 8 * 64 * 4;
constexpr float THRL = 8.f;
#define KSWZ(row, colB) ((row) * 256 + ((colB) ^ (((row) & 15) << 4)))
#define SBAR() __builtin_amdgcn_sched_barrier(0)
__device__ __forceinline__ int crow(int r, int hi) { return (r & 3) + 8 * (r >> 2) + 4 * hi; }
__device__ __forceinline__ unsigned cvtpk(float lo, float hi) { return pg8::cvt_pk_bf16(lo, hi); }
__device__ __forceinline__ bf16x8 tobf(f32x8 x) { u32x4 w = {cvtpk(x[0], x[1]), cvtpk(x[2], x[3]), cvtpk(x[4], x[5]), cvtpk(x[6], x[7])}; return *reinterpret_cast<bf16x8*>(&w); }

__device__ __forceinline__ void partialSM(f32x16& p0, f32x16& p1, float& m_reg, float& alpha) {
    float m0 = fmaxf(fmaxf(p0[0], p0[1]), p0[2]), m1 = fmaxf(fmaxf(p0[3], p0[4]), p0[5]), m2 = fmaxf(fmaxf(p1[0], p1[1]), p1[2]), m3 = fmaxf(fmaxf(p1[3], p1[4]), p1[5]);
    m0 = fmaxf(fmaxf(m0, p0[6]), p0[7]); m1 = fmaxf(fmaxf(m1, p0[8]), p0[9]); m2 = fmaxf(fmaxf(m2, p1[6]), p1[7]); m3 = fmaxf(fmaxf(m3, p1[8]), p1[9]);
    m0 = fmaxf(fmaxf(m0, p0[10]), p0[11]); m1 = fmaxf(fmaxf(m1, p0[12]), p0[13]); m2 = fmaxf(fmaxf(m2, p1[10]), p1[11]); m3 = fmaxf(fmaxf(m3, p1[12]), p1[13]);
    m0 = fmaxf(fmaxf(m0, p0[14]), p0[15]); m2 = fmaxf(fmaxf(m2, p1[14]), p1[15]);
    float pmax = fmaxf(fmaxf(m0, m1), fmaxf(m2, m3));
    { auto rr = __builtin_amdgcn_permlane32_swap(__float_as_uint(pmax), __float_as_uint(pmax), false, false);
      pmax = fmaxf(__uint_as_float(rr[0]), __uint_as_float(rr[1])); }
    float mn;
    if (__builtin_expect(__all(pmax - m_reg <= THRL), 1)) { mn = m_reg; alpha = 1.f; }
    else { mn = fmaxf(m_reg, pmax); alpha = __builtin_amdgcn_exp2f(m_reg - mn); m_reg = mn; }
#pragma unroll
    for (int r = 0; r < 16; ++r) p0[r] = p0[r] - mn;
#pragma unroll
    for (int r = 0; r < 16; ++r) p1[r] = p1[r] - mn;
#pragma unroll
    for (int r = 0; r < 16; ++r) p0[r] = __builtin_amdgcn_exp2f(p0[r]);
}
__device__ __forceinline__ void finishSM(f32x16& p0, f32x16& p1, float alpha, float& l_reg, bf16x8& pa0, bf16x8& pa1, bf16x8& pa2, bf16x8& pa3) {
#pragma unroll
    for (int r = 0; r < 16; ++r) p1[r] = __builtin_amdgcn_exp2f(p1[r]);
    float s0 = p0[0] + p0[1], s1 = p0[2] + p0[3], s2 = p1[0] + p1[1], s3 = p1[2] + p1[3];
#pragma unroll
    for (int r = 4; r < 16; r += 2) { if (r & 2) { s1 += p0[r] + p0[r + 1]; s3 += p1[r] + p1[r + 1]; } else { s0 += p0[r] + p0[r + 1]; s2 += p1[r] + p1[r + 1]; } }
    float ps = (s0 + s1) + (s2 + s3);
    { auto rr = __builtin_amdgcn_permlane32_swap(__float_as_uint(ps), __float_as_uint(ps), false, false);
      ps = __uint_as_float(rr[0]) + __uint_as_float(rr[1]); }
    l_reg = l_reg * alpha + ps;
#define PK4(P, BASE, OUT) do { unsigned a0 = cvtpk(P[BASE + 0], P[BASE + 1]), a1 = cvtpk(P[BASE + 2], P[BASE + 3]);   \
    unsigned b0 = cvtpk(P[BASE + 4], P[BASE + 5]), b1 = cvtpk(P[BASE + 6], P[BASE + 7]);                              \
    auto r0 = __builtin_amdgcn_permlane32_swap(a0, b0, false, false); auto r1 = __builtin_amdgcn_permlane32_swap(a1, b1, false, false); \
    u32x4 w = {r0[0], r1[0], r0[1], r1[1]}; OUT = *reinterpret_cast<bf16x8*>(&w); } while (0)
    PK4(p0, 0, pa0); PK4(p0, 8, pa1); PK4(p1, 0, pa2); PK4(p1, 8, pa3);
#undef PK4
}
__device__ __forceinline__ void qkt(f32x16& p0, f32x16& p1, const char* Ks, const bf16x8* qr, int r32, int hi, int sub) {
    p0 = f32x16{}; p1 = f32x16{};
#pragma unroll
    for (int d0 = 0; d0 < 4; ++d0) { const int cb = (sub * 64 + d0 * 16 + hi * 8) * 2;
        const bf16x8 b0 = *reinterpret_cast<const bf16x8*>(Ks + KSWZ(r32, cb));
        const bf16x8 b1 = *reinterpret_cast<const bf16x8*>(Ks + KSWZ(32 + r32, cb));
        p0 = __builtin_amdgcn_mfma_f32_32x32x16_bf16(b0, qr[d0], p0, 0, 0, 0);
        p1 = __builtin_amdgcn_mfma_f32_32x32x16_bf16(b1, qr[d0], p1, 0, 0, 0); }
}
__device__ __forceinline__ int v_st(int k, int c) { const int kk = (k & ~0xC) | ((k & 4) << 1) | ((k & 8) >> 1); return ((kk >> 3) * 4 + (c >> 5)) * 512 + ((kk & 7) * 32 + (c & 31)) * 2; }
__device__ __forceinline__ int v_rd_base(int lane) { return ((lane & 3) << 3) | (((lane >> 2) & 3) << 6) | (((lane >> 4) & 1) << 5) | (((lane >> 5) & 1) << 8); }
constexpr int v_rd_off(int d0, int ks, int half) { return d0 * 512 + ks * 4096 + half * 2048; }
typedef short v4i16_t __attribute__((ext_vector_type(4)));
typedef __attribute__((address_space(3))) const char* lds_cptr;
template <int OFF> __device__ __forceinline__ s16x4 tr_read(lds_cptr vp) {
    return __builtin_bit_cast(s16x4, __builtin_amdgcn_ds_read_tr16_b64_v4i16((__attribute__((address_space(3))) v4i16_t*)(vp + OFF)));
}
template <int D0> __device__ __forceinline__ void pv_one(f32x16& od, lds_cptr vb, bf16x8 pa0, bf16x8 pa1, bf16x8 pa2, bf16x8 pa3) {
    const s16x4 l0 = tr_read<v_rd_off(D0, 0, 0)>(vb), h0 = tr_read<v_rd_off(D0, 0, 1)>(vb), l1 = tr_read<v_rd_off(D0, 1, 0)>(vb), h1 = tr_read<v_rd_off(D0, 1, 1)>(vb);
    const s16x4 l2 = tr_read<v_rd_off(D0, 2, 0)>(vb), h2 = tr_read<v_rd_off(D0, 2, 1)>(vb), l3 = tr_read<v_rd_off(D0, 3, 0)>(vb), h3 = tr_read<v_rd_off(D0, 3, 1)>(vb);
#define PK(L, H) (bf16x8){L[0], L[1], L[2], L[3], H[0], H[1], H[2], H[3]}
    od = __builtin_amdgcn_mfma_f32_32x32x16_bf16(pa0, PK(l0, h0), od, 0, 0, 0);
    od = __builtin_amdgcn_mfma_f32_32x32x16_bf16(pa1, PK(l1, h1), od, 0, 0, 0);
    od = __builtin_amdgcn_mfma_f32_32x32x16_bf16(pa2, PK(l2, h2), od, 0, 0, 0);
    od = __builtin_amdgcn_mfma_f32_32x32x16_bf16(pa3, PK(l3, h3), od, 0, 0, 0);
#undef PK
}
__device__ __forceinline__ void pv_t(f32x16* o, const char* vt, const int* ko, bf16x8 pa0, bf16x8 pa1, bf16x8 pa2, bf16x8 pa3) {
#pragma unroll
    for (int d0 = 0; d0 < 4; ++d0) {
        const bf16x8 b0 = *reinterpret_cast<const bf16x8*>(vt + d0 * 4096 + ko[0]), b1 = *reinterpret_cast<const bf16x8*>(vt + d0 * 4096 + ko[1]);
        const bf16x8 b2 = *reinterpret_cast<const bf16x8*>(vt + d0 * 4096 + ko[2]), b3 = *reinterpret_cast<const bf16x8*>(vt + d0 * 4096 + ko[3]);
        o[d0] = __builtin_amdgcn_mfma_f32_32x32x16_bf16(pa0, b0, o[d0], 0, 0, 0);
        o[d0] = __builtin_amdgcn_mfma_f32_32x32x16_bf16(pa1, b1, o[d0], 0, 0, 0);
        o[d0] = __builtin_amdgcn_mfma_f32_32x32x16_bf16(pa2, b2, o[d0], 0, 0, 0);
        o[d0] = __builtin_amdgcn_mfma_f32_32x32x16_bf16(pa3, b3, o[d0], 0, 0, 0);
    }
}
__device__ __forceinline__ void pv_d0(f32x16* o, lds_cptr vb, bf16x8 pa0, bf16x8 pa1, bf16x8 pa2, bf16x8 pa3) {
    pv_one<0>(o[0], vb, pa0, pa1, pa2, pa3); pv_one<1>(o[1], vb, pa0, pa1, pa2, pa3); pv_one<2>(o[2], vb, pa0, pa1, pa2, pa3); pv_one<3>(o[3], vb, pa0, pa1, pa2, pa3);
}

struct Args {
    const unsigned short* Qb; const unsigned short* Kp; const unsigned short* Vp;
    const float* cK; const float* cV;
    const float* nK; const float* nV;
    unsigned short* ATT; const float* gsub;
    const unsigned short* Qs; unsigned short* ATTs;
    float* kpo; float* vpo;
};

template <bool SAMPLE>
__device__ __forceinline__ void attn_unit(const Args& A, int h, int qi, char* lds, float lam) {
    asm volatile("" : "+s"(h), "+s"(qi));
    int tid = threadIdx.x; asm volatile("" : "+v"(tid));
    const int lane = tid & 63, r32 = lane & 31, hi = lane >> 5;
    const int wid = __builtin_amdgcn_readfirstlane(tid >> 6), sub = wid >> 2, rg = wid & 3;
    char* V_lds = lds; char* K_lds = lds + 2 * SHM_V;
    float* ws = (float*)(lds + 3 * SHM_V + 3 * SHM_K) + wid * 64; float* li_l = ws; float* al_l = ws + 32;
    const int NT = SAMPLE ? 33 : 2 * qi + 2;
    float m_reg = -1e30f, l_reg = 0; f32x16 o[4] = {}; bf16x8 qr[4];
    {
        const int qrow = SAMPLE ? (qi * 16 + (r32 & 15)) : (qi * 128 + rg * 32 + r32);
        const unsigned short* Qw = (SAMPLE ? A.Qs : A.Qb) + (size_t)qrow * LDR + h * 128 + sub * 64 + hi * 8;
#pragma unroll
        for (int d0 = 0; d0 < 4; ++d0) qr[d0] = *reinterpret_cast<const bf16x8*>(Qw + d0 * 16);
    }
    const int sr = tid >> 4, sc = (tid & 15) * 8;
    const int vcol0 = tid >> 3, vcol1 = 64 + (tid >> 3), vch = tid & 7;
    const int vst0 = SAMPLE ? v_st(sr, sc) : vcol0 * 128 + ((vch ^ ((vcol0 >> 1) & 7)) << 4), vst1 = SAMPLE ? v_st(32 + sr, sc) : vcol1 * 128 + ((vch ^ ((vcol1 >> 1) & 7)) << 4);
    const lds_cptr vb0 = (lds_cptr)V_lds + v_rd_base(lane);
    const char* vtb = V_lds + r32 * 128; int vko[4];
#pragma unroll
    for (int ks = 0; ks < 4; ++ks) vko[ks] = ((2 * ks + hi) ^ ((r32 >> 1) & 7)) << 4;
    constexpr int SDEPTH = SAMPLE ? 2 : 1;
    using ST = typename std::conditional<SAMPLE, f32x8, bf16x8>::type;
    struct { ST vs0, vs1, ks0, ks1; } sr_[SDEPTH];
    constexpr unsigned ESZ = SAMPLE ? 4u : 2u;
    const unsigned lo0 = (unsigned)(sr * LDR + sc) * ESZ, lo1 = lo0 + 32u * LDR * ESZ, lon = (unsigned)((sr & 15) * LDR + sc) * 4u;
    const __amdgpu_buffer_rsrc_t rK = __builtin_amdgcn_make_buffer_rsrc((void*)(SAMPLE ? (const void*)A.cK : (const void*)A.Kp), 0, SAMPLE ? 16 * PAST * LDR * 4 : SEQ * LDR * 2, 0x00020000);
    const __amdgpu_buffer_rsrc_t rV = __builtin_amdgcn_make_buffer_rsrc((void*)(SAMPLE ? (const void*)A.cV : (const void*)A.Vp), 0, SAMPLE ? 16 * PAST * LDR * 4 : SEQ * LDR * 2, 0x00020000);
    const __amdgpu_buffer_rsrc_t rKn = __builtin_amdgcn_make_buffer_rsrc((void*)A.nK, 0, 256 * LDR * 4, 0x00020000);
    const __amdgpu_buffer_rsrc_t rVn = __builtin_amdgcn_make_buffer_rsrc((void*)A.nV, 0, 256 * LDR * 4, 0x00020000);
    const unsigned sbase = SAMPLE ? (unsigned)((qi * PAST * LDR + h * 128) * 4) : (unsigned)(h * 256), sbn = (unsigned)((qi * 16 * LDR + h * 128) * 4);
    const unsigned vl0 = (unsigned)tid * 16u, vl1 = vl0 + 8192u, vsb = (unsigned)h * (unsigned)(SEQ / 64) * 16384u;
    auto cv = [](ST x) -> bf16x8 { if constexpr (SAMPLE) return tobf(x); else return x; };
    auto bld = [](__amdgpu_buffer_rsrc_t r, unsigned vo, unsigned so) -> ST {
        if constexpr (SAMPLE) { const u32x4 a = __builtin_amdgcn_raw_buffer_load_b128(r, vo, so, 0), b = __builtin_amdgcn_raw_buffer_load_b128(r, vo + 16u, so, 0);
            f32x8 o; o[0] = __uint_as_float(a[0]); o[1] = __uint_as_float(a[1]); o[2] = __uint_as_float(a[2]); o[3] = __uint_as_float(a[3]);
            o[4] = __uint_as_float(b[0]); o[5] = __uint_as_float(b[1]); o[6] = __uint_as_float(b[2]); o[7] = __uint_as_float(b[3]); return o; }
        else { const u32x4 a = __builtin_amdgcn_raw_buffer_load_b128(r, vo, so, 0); return __builtin_bit_cast(bf16x8, a); }
    };
#define SLOAD(i, t) do { if (SAMPLE && (t) >= 32) { \
        sr_[i].vs0 = bld(rVn, lon, sbn); sr_[i].vs1 = sr_[i].vs0; sr_[i].ks0 = bld(rKn, lon, sbn); sr_[i].ks1 = sr_[i].ks0; \
    } else { const unsigned so_ = sbase + (unsigned)(t) * (64u * LDR * ESZ); \
        if constexpr (SAMPLE) { sr_[i].vs0 = bld(rV, lo0, so_); sr_[i].vs1 = bld(rV, lo1, so_); } else { const unsigned sv_ = vsb + (unsigned)(t) * 16384u; sr_[i].vs0 = bld(rV, vl0, sv_); sr_[i].vs1 = bld(rV, vl1, sv_); } \
        sr_[i].ks0 = bld(rK, lo0, so_); sr_[i].ks1 = bld(rK, lo1, so_); } } while (0)
#define SWRITE(b, i) do { *(bf16x8*)(V_lds + (b) * SHM_V + vst0) = cv(sr_[i].vs0);          \
    *(bf16x8*)(V_lds + (b) * SHM_V + vst1) = cv(sr_[i].vs1); const int kc = sc * 2;               \
    *(bf16x8*)(K_lds + (b) * SHM_K + KSWZ(sr, kc)) = cv(sr_[i].ks0);                       \
    *(bf16x8*)(K_lds + (b) * SHM_K + KSWZ(32 + sr, kc)) = cv(sr_[i].ks1); } while (0)
#define SWAIT() do { if constexpr (SDEPTH == 2) asm volatile("s_waitcnt vmcnt(4)" ::: "memory"); else asm volatile("s_waitcnt vmcnt(0)" ::: "memory"); } while (0)
#define RESC(a) do { if (__any((a) < 1.f)) { if (hi == 0) al_l[r32] = (a); asm volatile("s_waitcnt lgkmcnt(0)" ::: "memory"); \
    _Pragma("unroll") for (int d = 0; d < 4; ++d) _Pragma("unroll") for (int r = 0; r < 16; ++r) o[d][r] *= al_l[crow(r, hi)]; } } while (0)
#define MASK(P0, P1, t) do { if constexpr (SAMPLE) { if ((t) >= 32) { _Pragma("unroll") for (int r = 0; r < 16; ++r) { if (crow(r, hi) >= 16) P0[r] = -INFINITY; P1[r] = -INFINITY; } } } \
    else { if ((t) == NT - 1 && rg < 2) { _Pragma("unroll") for (int r = 0; r < 16; ++r) { P0[r] = -INFINITY; P1[r] = -INFINITY; } } } } while (0)
    bf16x8 pa0, pa1, pa2, pa3;
    if constexpr (SAMPLE) {
        f32x16 pA0, pA1; float alA = 1.f;
        SLOAD(0, 0); SLOAD(1, 1);
#define STILE(t, SL) do { SWRITE(SL, SL); if ((t) + 2 < NT) SLOAD(SL, (t) + 2); __syncthreads(); \
            if (rg == 0) { SBAR(); qkt(pA0, pA1, K_lds + (SL) * SHM_K, qr, r32, hi, sub); MASK(pA0, pA1, t); partialSM(pA0, pA1, m_reg, alA); RESC(alA); \
                finishSM(pA0, pA1, alA, l_reg, pa0, pa1, pa2, pa3); SBAR(); pv_d0(o, vb0 + (SL) * SHM_V, pa0, pa1, pa2, pa3); } } while (0)
        for (int t = 0; t + 1 < NT; t += 2) { STILE(t, 0); STILE(t + 1, 1); }
        STILE(NT - 1, 0);
#undef STILE
        __syncthreads();
    } else {
    f32x16 S0, S1; float alpha = 1.f; bf16x8 kf[4], vf[8], pl, ph_, pbl, pbh;
    const int grp = sub;
    typedef __attribute__((address_space(3))) unsigned lds_u;
    char* Kr = lds + 3 * SHM_V;
    int so_p = 2 * SHM_K, so_c = 0, so_n = SHM_K;
    const int krow0 = 8 * wid + (lane >> 4), krow1 = krow0 + 4, vcl0 = 16 * wid + (lane >> 3), vcl1 = vcl0 + 8;
    const unsigned kdo0 = (unsigned)krow0 * (LDR * 2u) + (unsigned)(((lane & 15) ^ (krow0 & 15)) << 4), kdo1 = (unsigned)krow1 * (LDR * 2u) + (unsigned)(((lane & 15) ^ (krow1 & 15)) << 4);
    const unsigned vdo0 = (unsigned)vcl0 * 128u + (unsigned)(((lane & 7) ^ ((vcl0 >> 1) & 7)) << 4), vdo1 = (unsigned)vcl1 * 128u + (unsigned)(((lane & 7) ^ ((vcl1 >> 1) & 7)) << 4);
#define KDMA_(t, so) do { const unsigned s_ = sbase + (unsigned)(t) * (64u * LDR * 2u); \
        __builtin_amdgcn_raw_ptr_buffer_load_lds(rK, (lds_u*)(Kr + (so) + wid * 2048), 16, kdo0, s_, 0, 0); \
        __builtin_amdgcn_raw_ptr_buffer_load_lds(rK, (lds_u*)(Kr + (so) + wid * 2048 + 1024), 16, kdo1, s_, 0, 0); } while (0)
#define VDMA_(t, so) do { const unsigned s_ = vsb + (unsigned)(t) * 16384u; \
        __builtin_amdgcn_raw_ptr_buffer_load_lds(rV, (lds_u*)(V_lds + (so) + wid * 2048), 16, vdo0, s_, 0, 0); \
        __builtin_amdgcn_raw_ptr_buffer_load_lds(rV, (lds_u*)(V_lds + (so) + wid * 2048 + 1024), 16, vdo1, s_, 0, 0); } while (0)
#define DST_(t) do { if ((t) + 3 < NT) KDMA_((t) + 3, so_c); if ((t) + 2 < NT) VDMA_((t) + 2, so_p); } while (0)
#define WAITV_(t) do { if ((t) + 2 < NT) asm volatile("s_waitcnt vmcnt(4)" ::: "memory"); else asm volatile("s_waitcnt vmcnt(0)" ::: "memory"); } while (0)
#define ROT_() do { const int t_ = so_p; so_p = so_c; so_c = so_n; so_n = t_; } while (0)
#define MEET_() do { asm volatile("s_waitcnt lgkmcnt(0)" ::: "memory"); __builtin_amdgcn_s_barrier(); asm volatile("" ::: "memory"); } while (0)
#define LSEG(HAVE_K, KSO, KH, HAVE_V, VSO, VH, STG, WT) do { \
        if (HAVE_K) { const char* kb_ = Kr + (KSO); \
            _Pragma("unroll") for (int d0 = 0; d0 < 4; ++d0) kf[d0] = *reinterpret_cast<const bf16x8*>(kb_ + KSWZ(32 * (KH) + r32, (sub * 64 + d0 * 16 + hi * 8) * 2)); } \
        if (HAVE_V) { const char* vb_ = vtb + (VSO); \
            _Pragma("unroll") for (int d0 = 0; d0 < 4; ++d0) { vf[2 * d0] = *reinterpret_cast<const bf16x8*>(vb_ + d0 * 4096 + vko[2 * (VH)]); vf[2 * d0 + 1] = *reinterpret_cast<const bf16x8*>(vb_ + d0 * 4096 + vko[2 * (VH) + 1]); } } \
        STG; \
        if ((WT) >= 0 && grp == 1) WAITV_(WT); \
        MEET_(); } while (0)
#define MF_(acc, A_, B_) acc = __builtin_amdgcn_mfma_f32_32x32x16_bf16(A_, B_, acc, 0, 0, 0)
#define EX_(SC, i) SC[i] = __builtin_amdgcn_exp2f(SC[i])
#define PKH_(SC, B0, OUT) do { const unsigned a0_ = cvtpk(SC[B0 + 0], SC[B0 + 1]), a1_ = cvtpk(SC[B0 + 2], SC[B0 + 3]), b0_ = cvtpk(SC[B0 + 4], SC[B0 + 5]), b1_ = cvtpk(SC[B0 + 6], SC[B0 + 7]); \
        auto r0_ = __builtin_amdgcn_permlane32_swap(a0_, b0_, false, false); auto r1_ = __builtin_amdgcn_permlane32_swap(a1_, b1_, false, false); \
        u32x4 w_ = {r0_[0], r1_[0], r0_[1], r1_[1]}; OUT = *reinterpret_cast<bf16x8*>(&w_); } while (0)
#define GQ_(HAVE_QK, X) do { SBAR(); if (HAVE_QK) { X; } SBAR(); } while (0)
#define CSEG(HAVE_QK, HAVE_PV, HAVE_SM, FIRST, SC, SN, PRL, PRH, PWL, PWH, WT) do { \
        float s0_ = 0.f, s1_ = 0.f, s2_ = 0.f, s3_ = 0.f, pmax_ = pmx, dlt_ = 0.f, n0_ = 0.f, n1_ = 0.f, n2_ = 0.f, n3_ = 0.f; bool ok_ = true; \
        unsigned c0_ = 0, c1_ = 0, c2_ = 0, c3_ = 0, c4_ = 0, c5_ = 0, c6_ = 0, c7_ = 0; \
        __builtin_amdgcn_s_setprio(2); \
        GQ_(HAVE_QK, SN = __builtin_amdgcn_mfma_f32_32x32x16_bf16(kf[0], qr[0], negm, 0, 0, 0)); \
        if (HAVE_SM) { ok_ = (FIRST) ? false : (bool)__all(pmax_ <= THRL);        \
            if (__builtin_expect(!ok_, 0)) { { auto rr_ = __builtin_amdgcn_permlane32_swap(__float_as_uint(pmax_), __float_as_uint(pmax_), false, false); pmax_ = fmaxf(__uint_as_float(rr_[0]), __uint_as_float(rr_[1])); } \
                dlt_ = (FIRST) ? pmax_ : fmaxf(pmax_, 0.f); m_reg += dlt_; alpha = (FIRST) ? 1.f : __builtin_amdgcn_exp2f(-dlt_); l_reg *= alpha; \
                _Pragma("unroll") for (int r = 0; r < 16; ++r) SC[r] -= dlt_; } \
            EX_(SC, 0); EX_(SC, 1); } \
        GQ_(HAVE_QK, MF_(SN, kf[1], qr[1])); if (HAVE_SM) { EX_(SC, 2); EX_(SC, 3); EX_(SC, 4); } \
        GQ_(HAVE_QK, MF_(SN, kf[2], qr[2])); if (HAVE_SM) { EX_(SC, 5); EX_(SC, 6); EX_(SC, 7); } \
        GQ_(HAVE_QK, MF_(SN, kf[3], qr[3])); if (HAVE_SM) { EX_(SC, 8); EX_(SC, 9); EX_(SC, 10); } \
        GQ_(HAVE_PV, MF_(o[0], PRL, vf[0])); if (HAVE_SM) { EX_(SC, 11); EX_(SC, 12); EX_(SC, 13); } \
        GQ_(HAVE_PV, MF_(o[0], PRH, vf[1])); if (HAVE_SM) { EX_(SC, 14); EX_(SC, 15); c0_ = cvtpk(SC[0], SC[1]); c1_ = cvtpk(SC[2], SC[3]); } \
        GQ_(HAVE_PV, MF_(o[1], PRL, vf[2])); if (HAVE_SM) { c2_ = cvtpk(SC[4], SC[5]); c3_ = cvtpk(SC[6], SC[7]); \
            auto r0_ = __builtin_amdgcn_permlane32_swap(c0_, c2_, false, false); auto r1_ = __builtin_amdgcn_permlane32_swap(c1_, c3_, false, false); \
            u32x4 w_ = {r0_[0], r1_[0], r0_[1], r1_[1]}; PWL = *reinterpret_cast<bf16x8*>(&w_); } \
        if (HAVE_QK) { n0_ = fmaxf(fmaxf(SN[0], SN[1]), SN[2]); n1_ = fmaxf(fmaxf(SN[3], SN[4]), SN[5]); }        \
        GQ_(HAVE_PV, MF_(o[1], PRH, vf[3])); if (HAVE_SM) { c4_ = cvtpk(SC[8], SC[9]); c5_ = cvtpk(SC[10], SC[11]); c6_ = cvtpk(SC[12], SC[13]); c7_ = cvtpk(SC[14], SC[15]); } \
        if (HAVE_QK) { n2_ = fmaxf(fmaxf(SN[6], SN[7]), SN[8]); n3_ = fmaxf(fmaxf(SN[9], SN[10]), SN[11]); } \
        GQ_(HAVE_PV, MF_(o[2], PRL, vf[4])); if (HAVE_SM) { auto r0_ = __builtin_amdgcn_permlane32_swap(c4_, c6_, false, false); auto r1_ = __builtin_amdgcn_permlane32_swap(c5_, c7_, false, false); \
            u32x4 w_ = {r0_[0], r1_[0], r0_[1], r1_[1]}; PWH = *reinterpret_cast<bf16x8*>(&w_); } \
        if (HAVE_QK) { const float n4_ = fmaxf(fmaxf(SN[12], SN[13]), SN[14]); n0_ = fmaxf(fmaxf(n0_, n1_), n2_); n3_ = fmaxf(fmaxf(n3_, n4_), SN[15]); } \
        GQ_(HAVE_PV, MF_(o[2], PRH, vf[5])); if (HAVE_QK) pmx = fmaxf(n0_, n3_); \
        if (HAVE_SM) { s0_ = SC[0] + SC[1]; s1_ = SC[2] + SC[3]; s2_ = SC[4] + SC[5]; s3_ = SC[6] + SC[7]; s0_ += SC[8]; s1_ += SC[9]; s2_ += SC[10]; s3_ += SC[11]; \
            s0_ += SC[12]; s1_ += SC[13]; s2_ += SC[14]; s3_ += SC[15]; s0_ += s1_; s2_ += s3_; s0_ += s2_; l_reg += s0_; }    \
        GQ_(HAVE_PV, MF_(o[3], PRL, vf[6])); \
        GQ_(HAVE_PV, MF_(o[3], PRH, vf[7])); \
        SBAR(); \
        if (HAVE_SM) { if (__builtin_expect(!ok_, 0)) { if (!(FIRST)) RESC(alpha); \
            if (HAVE_QK) { _Pragma("unroll") for (int r = 0; r < 16; ++r) SN[r] -= dlt_; pmx -= dlt_; } \
            _Pragma("unroll") for (int r = 0; r < 16; ++r) negm[r] = -m_reg; } } \
        __builtin_amdgcn_s_setprio(0); if ((WT) >= 0 && grp == 0) WAITV_(WT); MEET_(); } while (0)
    float pmx = 0.f;
    f32x16 negm = {}; m_reg = 0.f;
    KDMA_(0, 0); VDMA_(0, 0); KDMA_(1, SHM_K); VDMA_(1, SHM_V); if (2 < NT) KDMA_(2, 2 * SHM_K);
    asm volatile("s_waitcnt vmcnt(0)" ::: "memory");
    MEET_();
    if (grp == 1) MEET_();
    LSEG(true, 0, 0, false, 0, 0, (void)0, -1);             CSEG(true, false, false, false, S1, S0, pbl, pbh, pl, ph_, -1);
    LSEG(true, so_c, 1, false, 0, 0, (void)0, 0);           CSEG(true, false, true, true, S0, S1, pbl, pbh, pl, ph_, 0);
    LSEG(true, so_n, 0, true, so_c, 0, DST_(0), -1);        CSEG(true, true, true, false, S1, S0, pl, ph_, pbl, pbh, -1);
    ROT_();
#pragma clang loop unroll(disable)
    for (int t = 1; t < NT - 1; ++t) {
        LSEG(true, so_c, 1, true, so_p, 1, (void)0, t);     CSEG(true, true, true, false, S0, S1, pbl, pbh, pl, ph_, t);
        LSEG(true, so_n, 0, true, so_c, 0, DST_(t), -1);    CSEG(true, true, true, false, S1, S0, pl, ph_, pbl, pbh, -1);
        ROT_();
    }
    if (rg < 2) {
        LSEG(false, 0, 0, true, so_p, 1, (void)0, NT - 1);  CSEG(false, true, false, false, S0, S1, pbl, pbh, pl, ph_, NT - 1);
        LSEG(false, 0, 0, false, 0, 0, (void)0, -1);        CSEG(false, false, false, false, S0, S1, pbl, pbh, pl, ph_, -1);
        LSEG(false, 0, 0, false, 0, 0, (void)0, -1);        CSEG(false, false, false, false, S0, S1, pbl, pbh, pl, ph_, -1);
    } else {
        LSEG(true, so_c, 1, true, so_p, 1, (void)0, NT - 1); CSEG(true, true, true, false, S0, S1, pbl, pbh, pl, ph_, NT - 1);
        LSEG(false, 0, 0, true, so_c, 0, (void)0, -1);       CSEG(false, true, true, false, S1, S0, pl, ph_, pbl, pbh, -1);
        LSEG(false, 0, 0, true, so_c, 1, (void)0, -1);       CSEG(false, true, false, false, S0, S1, pbl, pbh, pl, ph_, -1);
    }
    if (grp == 0) MEET_();
    { auto rr_ = __builtin_amdgcn_permlane32_swap(__float_as_uint(l_reg), __float_as_uint(l_reg), false, false); l_reg = __uint_as_float(rr_[0]) + __uint_as_float(rr_[1]); }
#undef KDMA_
#undef VDMA_
#undef DST_
#undef WAITV_
#undef ROT_
#undef MEET_
#undef GQ_
#undef MF_
#undef EX_
#undef PKH_
#undef LSEG
#undef CSEG
    }
#undef SLOAD
#undef SWRITE
#undef SWAIT
#undef RESC
#undef MASK
    if (hi == 0) li_l[r32] = l_reg;
    asm volatile("s_waitcnt lgkmcnt(0)" ::: "memory");
    __syncthreads();
    float* X = (float*)lds;
    if (sub == 1 && (!SAMPLE || rg == 0)) {
#pragma unroll
        for (int r = 0; r < 16; ++r) { const float rl = __builtin_amdgcn_rcpf(li_l[crow(r, hi)]);
#pragma unroll
            for (int d0 = 0; d0 < 4; ++d0) X[((rg * 4 + d0) * 16 + r) * 64 + lane] = o[d0][r] * rl; }
    }
    __syncthreads();
    if (sub == 0 && (!SAMPLE || rg == 0)) {
        float gs[4];
#pragma unroll
        for (int d0 = 0; d0 < 4; ++d0) gs[d0] = A.gsub[d0 * 32 + r32];
#pragma unroll
        for (int r = 0; r < 16; ++r) {
            const int cr = crow(r, hi);
            const float rl = __builtin_amdgcn_rcpf(li_l[cr]);
            float d[4]; float v = 0.f;
#pragma unroll
            for (int d0 = 0; d0 < 4; ++d0) { d[d0] = o[d0][r] * rl - lam * X[((rg * 4 + d0) * 16 + r) * 64 + lane]; v += d[d0] * d[d0]; }
            v += __shfl_xor(v, 1); v += __shfl_xor(v, 2); v += __shfl_xor(v, 4); v += __shfl_xor(v, 8); v += __shfl_xor(v, 16);
            const float sc_ = (1.0f - LAM_INIT) / sqrtf(v * (1.0f / 128.0f) + EPS);
            const bool ok = SAMPLE ? (cr < 16) : true;
            const int orow = SAMPLE ? (qi * 16 + cr) : (qi * 128 + rg * 32 + cr);
            if (ok) {
                unsigned short* op = (SAMPLE ? A.ATTs : A.ATT) + (size_t)orow * LDR + h * 128 + r32;
#pragma unroll
                for (int d0 = 0; d0 < 4; ++d0) op[d0 * 32] = (unsigned short)f2bf(d[d0] * sc_ * gs[d0]);
            }
        }
    }
    if constexpr (!SAMPLE) {
    {
        const int kr_ = tid >> 2, kc_ = (tid & 3) * 32;
        const unsigned short* ks_ = A.Kp + (size_t)(qi * 128 + kr_) * LDR + h * 128 + kc_;
        float* kd_ = A.kpo + (size_t)(qi * 128 + kr_) * LDR + h * 128 + kc_;
#pragma unroll
        for (int i = 0; i < 4; ++i) { const u32x4 w = *(const u32x4*)(ks_ + 8 * i);
            f32x4 a, b; a[0] = __uint_as_float(w[0] << 16); a[1] = __uint_as_float(w[0] & 0xffff0000u); a[2] = __uint_as_float(w[1] << 16); a[3] = __uint_as_float(w[1] & 0xffff0000u);
            b[0] = __uint_as_float(w[2] << 16); b[1] = __uint_as_float(w[2] & 0xffff0000u); b[2] = __uint_as_float(w[3] << 16); b[3] = __uint_as_float(w[3] & 0xffff0000u);
            *(f32x4*)(kd_ + 8 * i) = a; *(f32x4*)(kd_ + 8 * i + 4) = b; }
        const int vt_ = 2 * qi + (wid >> 2);
        const unsigned short* vs_ = A.Vp + ((size_t)(h * (SEQ / 64) + vt_) * 128) * 64;
        float* vd_ = A.vpo + (size_t)(vt_ * 64) * LDR + h * 128;
#pragma unroll
        for (int cc = 0; cc < 2; ++cc) {
            const int col = lane + 64 * cc;
#pragma unroll
            for (int ch = 0; ch < 2; ++ch) { const int k0 = (2 * (wid & 3) + ch) * 8;
                const u32x4 w = *(const u32x4*)(vs_ + (size_t)col * 64 + k0);
#pragma unroll
                for (int e = 0; e < 4; ++e) { vd_[(size_t)(k0 + 2 * e) * LDR + col] = __uint_as_float(w[e] << 16); vd_[(size_t)(k0 + 2 * e + 1) * LDR + col] = __uint_as_float(w[e] & 0xffff0000u); } }
        }
    }
    }
    __syncthreads();
}
#undef KSWZ

struct SpArgs { const unsigned short* Ub; const unsigned short* GVb; const float* SS; const float* gsgu; const float* wsp; const float* bsp; unsigned short* SGU; float* gsout;
                const unsigned short* Us; const unsigned short* GVs; const float* SSs; unsigned short* SGUs; };
__device__ __forceinline__ void spatial_unit(const SpArgs& A, bool sample, int c, int g, char* lds) {
    asm volatile("" : "+s"(c), "+s"(g));
    int tid = threadIdx.x; asm volatile("" : "+v"(tid));
    const int lane = tid & 63, r32 = lane & 31, hi = lane >> 5;
    const int wid = __builtin_amdgcn_readfirstlane(tid >> 6);
    const int R0 = sample ? (16 * c) : (128 * c), nrows = sample ? 16 : 128;
    const unsigned short* Ubp = sample ? A.Us : A.Ub; const unsigned short* GVp = sample ? A.GVs : A.GVb; const float* SSp = sample ? A.SSs : A.SS; unsigned short* SGUp = sample ? A.SGUs : A.SGU;
    float* rs_l = (float*)lds;
    if (tid < nrows) {
        const f32x4* sp = (const f32x4*)(SSp + (size_t)(R0 + tid) * 16);
        const f32x4 a = sp[0], b = sp[1], cc = sp[2], d = sp[3];
        const float s = ((a[0] + a[1]) + (a[2] + a[3])) + ((b[0] + b[1]) + (b[2] + b[3])) + ((cc[0] + cc[1]) + (cc[2] + cc[3])) + ((d[0] + d[1]) + (d[2] + d[3]));
        rs_l[tid] = 1.0f / sqrtf(s * (1.0f / 1024.0f) + EPS);
    }
    __syncthreads();
    const int ch = g * 256 + wid * 32 + r32;
    const float gch = A.gsgu[ch];
    const int nks = sample ? 1 : 8, nrb = sample ? 1 : 4;
    bf16x8 bfr[8];
#pragma unroll
    for (int ks = 0; ks < 8; ++ks) {
        if (ks < nks) {
            float vv[8];
#pragma unroll
            for (int jj = 0; jj < 8; ++jj) {
                const int j = 16 * ks + 8 * hi + jj;
                vv[jj] = bf2f(GVp[(size_t)(R0 + j) * LDR + ch]) * rs_l[j] * gch;
                if (sample) A.gsout[(size_t)(16 * c + j) * LDR + ch] = vv[jj];
            }
            u32x4 w = {cvtpk(vv[0], vv[1]), cvtpk(vv[2], vv[3]), cvtpk(vv[4], vv[5]), cvtpk(vv[6], vv[7])};
            bfr[ks] = *reinterpret_cast<bf16x8*>(&w);
        } else bfr[ks] = bf16x8{};
    }
    const float* Wg = A.wsp + (size_t)g * 128 * 128;
#pragma unroll 1
    for (int rb = 0; rb < nrb; ++rb) {
        {
            f32x16 acc = {};
            const int i = 32 * rb + r32;
#pragma unroll
            for (int ks = 0; ks < 8; ++ks) {
                if (ks < nks && 16 * ks <= 32 * rb + 31) {
                    const int j0 = 16 * ks + 8 * hi;
                    const f32x4 w0 = *(const f32x4*)(Wg + (size_t)i * 128 + j0), w1 = *(const f32x4*)(Wg + (size_t)i * 128 + j0 + 4);
                    float wv[8] = {w0[0], w0[1], w0[2], w0[3], w1[0], w1[1], w1[2], w1[3]};
#pragma unroll
                    for (int jj = 0; jj < 8; ++jj) if (j0 + jj > i) wv[jj] = 0.f;
                    u32x4 w = {cvtpk(wv[0], wv[1]), cvtpk(wv[2], wv[3]), cvtpk(wv[4], wv[5]), cvtpk(wv[6], wv[7])};
                    acc = __builtin_amdgcn_mfma_f32_32x32x16_bf16(*reinterpret_cast<bf16x8*>(&w), bfr[ks], acc, 0, 0, 0);
                }
            }
#pragma unroll
            for (int r = 0; r < 16; ++r) {
                const int io = 32 * rb + crow(r, hi);
                if (io < nrows) {
                    const float uv = bf2f(Ubp[(size_t)(R0 + io) * LDR + ch]);
                    SGUp[(size_t)(R0 + io) * LDR + ch] = (unsigned short)f2bf(uv * (acc[r] + A.bsp[g * 128 + io]));
                }
            }
        }
    }
    __syncthreads();
}
__device__ __forceinline__ void spatial_unit_prompt(const SpArgs& A, int c, int g, char* lds) {
    asm volatile("" : "+s"(c), "+s"(g));
    int tid = threadIdx.x; asm volatile("" : "+v"(tid));
    const int lane = tid & 63, r32 = lane & 31, hi = lane >> 5;
    const int wid = __builtin_amdgcn_readfirstlane(tid >> 6);
    constexpr int GST = 528, WST = 272;
    char* Gt = lds; char* Wt = lds + 128 * GST; float* rs_l = (float*)(lds + 128 * GST + 128 * WST);
    const int R0 = 128 * c;
    u32x4 gv[8];
#pragma unroll
    for (int i = 0; i < 8; ++i) { const int q = tid + 512 * i, row = q >> 5, cc = q & 31;
        gv[i] = *(const u32x4*)(A.GVb + (size_t)(R0 + row) * LDR + g * 256 + cc * 8); }
    const int wi = tid >> 2, wj = (tid & 3) * 32;
    f32x4 wv[8];
#pragma unroll
    for (int i = 0; i < 8; ++i) wv[i] = *(const f32x4*)(A.wsp + (size_t)g * 128 * 128 + (size_t)wi * 128 + wj + 4 * i);
    if (tid < 128) {
        const f32x4* sp = (const f32x4*)(A.SS + (size_t)(R0 + tid) * 16);
        const f32x4 a = sp[0], b = sp[1], cc = sp[2], d = sp[3];
        const float s = ((a[0] + a[1]) + (a[2] + a[3])) + ((b[0] + b[1]) + (b[2] + b[3])) + ((cc[0] + cc[1]) + (cc[2] + cc[3])) + ((d[0] + d[1]) + (d[2] + d[3]));
        rs_l[tid] = 1.0f / sqrtf(s * (1.0f / 1024.0f) + EPS);
    }
#pragma unroll
    for (int i = 0; i < 8; ++i) { const int q = tid + 512 * i, row = q >> 5, cc = q & 31; *(u32x4*)(Gt + row * GST + cc * 16) = gv[i]; }
    __syncthreads();
#pragma unroll
    for (int i = 0; i < 4; ++i) {
        const f32x4 r0 = *(const f32x4*)(rs_l + wj + 8 * i), r1 = *(const f32x4*)(rs_l + wj + 8 * i + 4);
        float t[8];
#pragma unroll
        for (int e = 0; e < 4; ++e) { t[e] = (wj + 8 * i + e <= wi) ? wv[2 * i][e] * r0[e] : 0.f; t[4 + e] = (wj + 8 * i + 4 + e <= wi) ? wv[2 * i + 1][e] * r1[e] : 0.f; }
        u32x4 w = {cvtpk(t[0], t[1]), cvtpk(t[2], t[3]), cvtpk(t[4], t[5]), cvtpk(t[6], t[7])};
        *(u32x4*)(Wt + wi * WST + (wj + 8 * i) * 2) = w;
    }
    __syncthreads();
    u32x4 uu[8];
#pragma unroll
    for (int i = 0; i < 8; ++i) { const int q = tid + 512 * i, row = q >> 5, cc = q & 31;
        uu[i] = *(const u32x4*)(A.Ub + (size_t)(R0 + row) * LDR + g * 256 + cc * 8); }
    const int ccol = wid * 32 + r32, ch = g * 256 + ccol;
    const float gch = A.gsgu[ch];
    bf16x8 bfr[8];
#pragma unroll
    for (int ks = 0; ks < 8; ++ks) {
        unsigned p[4];
#pragma unroll
        for (int e = 0; e < 4; ++e) { const int j = 16 * ks + 8 * hi + 2 * e;
            const unsigned lo = *(const unsigned short*)(Gt + j * GST + ccol * 2), hi16 = *(const unsigned short*)(Gt + (j + 1) * GST + ccol * 2);
            p[e] = lo | (hi16 << 16); }
        u32x4 w = {p[0], p[1], p[2], p[3]};
        bfr[ks] = *reinterpret_cast<bf16x8*>(&w);
    }
    asm volatile("s_waitcnt lgkmcnt(0)" ::: "memory");
#pragma unroll
    for (int rb = 0; rb < 4; ++rb) {
        f32x16 acc = {};
#pragma unroll
        for (int ks = 0; ks < 8; ++ks) {
            if (ks <= 2 * rb + 1) {
                const bf16x8 af = *(const bf16x8*)(Wt + (32 * rb + r32) * WST + (16 * ks + 8 * hi) * 2);
                acc = __builtin_amdgcn_mfma_f32_32x32x16_bf16(af, bfr[ks], acc, 0, 0, 0);
            }
        }
#pragma unroll
        for (int r = 0; r < 16; ++r) { const int io = 32 * rb + crow(r, hi);
            *(unsigned short*)(Gt + io * GST + ccol * 2) = (unsigned short)f2bf(acc[r] * gch + A.bsp[g * 128 + io]); }
    }
    __syncthreads();
#pragma unroll
    for (int i = 0; i < 8; ++i) { const int q = tid + 512 * i, row = q >> 5, cc = q & 31;
        const u32x4 rv = *(const u32x4*)(Gt + row * GST + cc * 16);
        u32x4 ov;
#pragma unroll
        for (int e = 0; e < 4; ++e) { const float a0 = __builtin_bit_cast(float, rv[e] << 16) * __builtin_bit_cast(float, uu[i][e] << 16), a1 = __builtin_bit_cast(float, rv[e] & 0xffff0000u) * __builtin_bit_cast(float, uu[i][e] & 0xffff0000u);
            ov[e] = cvtpk(a0, a1); }
        *(u32x4*)(A.SGU + (size_t)(R0 + row) * LDR + g * 256 + cc * 8) = ov; }
    __syncthreads();
}
#undef SBAR
}

struct KArgs {
    const float* in[26]; float* out; unsigned char* ws;
};

struct Frame {
    LAS unsigned char* lds; int tid, lane, wave, G, gw, NGW;
};

__device__ __forceinline__ void p0_transpose_item(const float* W, int K, int N, bf16* WT, int mode, LAS float* scr, int item, int lane, int ldw = 0) {
    if (ldw == 0) ldw = K;
    const int nblk = N / 32, kb = item / nblk, nb = item % nblk, k0 = 64 * kb, n0 = 32 * nb;
    int d0 = n0;
    if (mode == 1) { const int half = N / 2; const int nn = (n0 < half) ? n0 : n0 - half; d0 = (nn >> 7) * 256 + (nn & 127) + ((n0 < half) ? 0 : 128); }
#pragma unroll
    for (int i = 0; i < 32; ++i) { const int kk = 2 * i + (lane >> 5); scr[kk * 33 + (lane & 31)] = W[(size_t)(k0 + kk) * N + n0 + (lane & 31)]; }
    LDS_WAIT(); asm volatile("" ::: "memory");
    const int c = lane & 7;
#pragma unroll
    for (int j = 0; j < 4; ++j) { const int n = (lane >> 3) + 8 * j; const LAS float* s = scr + (8 * c) * 33 + n;
        v4u o; o.x = pk2(s[0 * 33], s[1 * 33]); o.y = pk2(s[2 * 33], s[3 * 33]); o.z = pk2(s[4 * 33], s[5 * 33]); o.w = pk2(s[6 * 33], s[7 * 33]);
        *(v4u*)(WT + (size_t)(d0 + n) * ldw + k0 + 8 * c) = o; }
    LDS_WAIT(); asm volatile("" ::: "memory");
}

__device__ __forceinline__ const float* xrow_ptr(const float* xp, const float* xs, int m) { return (m < SEQ) ? xp + (size_t)m * DM : xs + (size_t)(m - SEQ) * DM; }

template <bool BIN, bool BOUT>
__device__ __forceinline__ void row_phase(const Frame& F, int m0, int mstep, int mend, const bf16* Fb, const float* SS, const void* base0, float scale,
                                          const float* gpost, void* Hout, const float* gnext, bf16* XN) {
    for (int m = m0; m < mend; m += 2 * mstep) {
        const bool two = (m + mstep < mend); const int mb = two ? m + mstep : m;
        const v2u* fa_ = (const v2u*)(Fb + (size_t)m * DM) + F.lane; const v2u* fb_ = (const v2u*)(Fb + (size_t)mb * DM) + F.lane;
        const f32x4* gp = (const f32x4*)gpost + F.lane;
        v2u fwa[4], fwb[4]; f32x4 bva[4], bvb[4], g[4];
        float ssa = SS[(size_t)m * 16 + (F.lane & 15)], ssb = SS[(size_t)mb * 16 + (F.lane & 15)];
#pragma unroll
        for (int j = 0; j < 4; ++j) { fwa[j] = fa_[64 * j]; fwb[j] = fb_[64 * j]; g[j] = gp[64 * j];
            if constexpr (BIN) { const v2u wa = ((const v2u*)((const bf16*)base0 + (size_t)m * DM) + F.lane)[64 * j], wb = ((const v2u*)((const bf16*)base0 + (size_t)mb * DM) + F.lane)[64 * j];
                bva[j] = (f32x4){bflo(wa.x), bfhi(wa.x), bflo(wa.y), bfhi(wa.y)}; bvb[j] = (f32x4){bflo(wb.x), bfhi(wb.x), bflo(wb.y), bfhi(wb.y)}; }
            else { bva[j] = ((const f32x4*)((const float*)base0 + (size_t)m * DM) + F.lane)[64 * j]; bvb[j] = ((const f32x4*)((const float*)base0 + (size_t)mb * DM) + F.lane)[64 * j]; } }
#pragma unroll
        for (int half = 0; half < 2; ++half) {
            if (half == 1 && !two) break;
            const int mm = half ? mb : m;
            float ss = half ? ssb : ssa;
            ss += __shfl_xor(ss, 1); ss += __shfl_xor(ss, 2); ss += __shfl_xor(ss, 4); ss += __shfl_xor(ss, 8);
            const float rs = 1.0f / sqrtf(ss * (1.0f / DM) + EPS);
            f32x4 hv[4]; float s2 = 0.f;
#pragma unroll
            for (int j = 0; j < 4; ++j) { const v2u fw = half ? fwb[j] : fwa[j]; const f32x4 f = {bflo(fw.x), bfhi(fw.x), bflo(fw.y), bfhi(fw.y)}; const f32x4 b = half ? bvb[j] : bva[j];
                hv[j] = b + (f * g[j]) * (rs * scale);
                s2 += (hv[j][0] * hv[j][0] + hv[j][1] * hv[j][1]) + (hv[j][2] * hv[j][2] + hv[j][3] * hv[j][3]); }
            if (Hout) {
                if constexpr (BOUT) { v2u* ho = (v2u*)((bf16*)Hout + (size_t)mm * DM) + F.lane;
#pragma unroll
                    for (int j = 0; j < 4; ++j) ho[64 * j] = (v2u){pk2(hv[j][0], hv[j][1]), pk2(hv[j][2], hv[j][3])}; }
                else { f32x4* ho = (f32x4*)((float*)Hout + (size_t)mm * DM) + F.lane;
#pragma unroll
                    for (int j = 0; j < 4; ++j) ho[64 * j] = hv[j]; }
            }
            if (gnext) {
                const float rs2 = 1.0f / sqrtf(wave_sum(s2) * (1.0f / DM) + EPS);
                const f32x4* gn = (const f32x4*)gnext + F.lane;
                unsigned long long* o8 = (unsigned long long*)(XN + (size_t)mm * DM) + F.lane;
#pragma unroll
                for (int j = 0; j < 4; ++j) { const f32x4 gq = gn[64 * j]; const f32x4 v = hv[j] * gq * rs2;
                    o8[64 * j] = (unsigned long long)pk2(v[0], v[1]) | ((unsigned long long)pk2(v[2], v[3]) << 32); }
            }
        }
    }
}


#define XB_TMO      128
#define XB_XCNT(j)  (256  + 64 * (j))
#define XB_XSUB(j)  (1280 + 64 * (j))
#define XB_XGEN(j)  (2304 + 64 * (j))
#define XB_TOP      3328
#define XB_TOPGEN   3392
#define XCD_BAR_WORDS 3456
#define XB_SPIN_CAP (1u << 20)
__device__ __forceinline__ unsigned xb_ld(unsigned* p)              { return __hip_atomic_load(p, __ATOMIC_RELAXED, __HIP_MEMORY_SCOPE_AGENT); }
__device__ __forceinline__ unsigned xb_add(unsigned* p, unsigned v) { return __hip_atomic_fetch_add(p, v, __ATOMIC_RELAXED, __HIP_MEMORY_SCOPE_AGENT); }
__device__ __forceinline__ unsigned xb_xcc_id() { return (unsigned)__builtin_amdgcn_s_getreg((3 << 11) | 20) & 0xFu; }
#define XB_SPIN(cond, bar) do { unsigned _sp = 0; while (cond) { __builtin_amdgcn_s_sleep(1); \
    if ((++_sp & 255u) == 0u) { if (xb_ld(&(bar)[XB_TMO])) break; if (_sp > XB_SPIN_CAP) { atomicAdd(&(bar)[XB_TMO], 1u); break; } } } } while (0)
struct XcdBarrier { unsigned* bar; unsigned x; volatile LAS unsigned* st; };
__device__ __forceinline__ XcdBarrier xcd_barrier_post(unsigned* bar, volatile LAS unsigned* st) {
    XcdBarrier b; b.bar = bar; b.x = xb_xcc_id(); b.st = st;
    if (threadIdx.x == 0) (void)xb_add(&bar[XB_XCNT(b.x)], 1u);
    return b;
}
__device__ __forceinline__ void xcd_barrier_complete(unsigned* bar, unsigned x, unsigned& nloc, unsigned& nx) {
    const unsigned G = gridDim.x * gridDim.y * gridDim.z;
    unsigned sum, cnt, mine, sp = 0u;
    for (;;) {
        sum = 0u; cnt = 0u; mine = 0u;
#pragma unroll
        for (unsigned j = 0; j < 16; ++j) { const unsigned c = xb_ld(&bar[XB_XCNT(j)]); sum += c; cnt += (c > 0u) ? 1u : 0u; mine = (j == x) ? c : mine; }
        if (sum == G) break;
        __builtin_amdgcn_s_sleep(1);
        if ((++sp & 255u) == 0u) { if (xb_ld(&bar[XB_TMO])) break; if (sp > XB_SPIN_CAP) { atomicAdd(&bar[XB_TMO], 1u); break; } }
    }
    nloc = mine > 0u ? mine : 1u; nx = cnt > 0u ? cnt : 1u;
}
__device__ __forceinline__ void xcd_barrier(const XcdBarrier& b) {
    asm volatile("s_waitcnt vmcnt(0)" ::: "memory");
    __syncthreads();
    if (threadIdx.x == 0) {
        unsigned* bar = b.bar;
        __builtin_amdgcn_s_waitcnt(0);
        unsigned nloc = b.st[0], nx = b.st[1];
        if (nloc == 0u) { xcd_barrier_complete(bar, b.x, nloc, nx); b.st[0] = nloc; b.st[1] = nx; }
        const unsigned old = xb_add(&bar[XB_XSUB(b.x)], 1u);
        const unsigned gen = old / nloc;
        if (old + 1u == (gen + 1u) * nloc) {
            __builtin_amdgcn_fence(__ATOMIC_RELEASE, "agent");
            asm volatile("s_waitcnt vmcnt(0)" ::: "memory");
            const unsigned og = xb_add(&bar[XB_TOP], 1u);
            const unsigned tg = og / nx;
            if (og + 1u == (tg + 1u) * nx) xb_add(&bar[XB_TOPGEN], 1u);
            else XB_SPIN(xb_ld(&bar[XB_TOPGEN]) == tg, bar);
            __builtin_amdgcn_fence(__ATOMIC_ACQUIRE, "agent");
            xb_add(&bar[XB_XGEN(b.x)], 1u);
            asm volatile("s_waitcnt vmcnt(0)" ::: "memory");
        } else {
            XB_SPIN(xb_ld(&bar[XB_XGEN(b.x)]) == gen, bar);
            __builtin_amdgcn_fence(__ATOMIC_ACQUIRE, "agent");
            asm volatile("s_waitcnt vmcnt(0)" ::: "memory");
        }
    }
    __syncthreads();
}

__device__ __forceinline__ int queue_pop(unsigned* ctr, volatile LAS unsigned* slot) {
    if (threadIdx.x == 0) *slot = __hip_atomic_fetch_add(ctr, 1u, __ATOMIC_RELAXED, __HIP_MEMORY_SCOPE_AGENT);
    __syncthreads();
    const int v = __builtin_amdgcn_readfirstlane((int)*slot);
    __syncthreads();
    return v;
}

__global__ void __launch_bounds__(NWAVES * 64, 2) mk_fwd(KArgs args) {
    extern __shared__ __attribute__((aligned(16))) unsigned char lds[];
    cg::grid_group grid = cg::this_grid();
    Frame F;
    F.lds = (LAS unsigned char*)lds;
    F.tid = threadIdx.x; F.lane = F.tid & 63; F.wave = __builtin_amdgcn_readfirstlane(F.tid >> 6);
    F.G = gridDim.x; F.gw = blockIdx.x * NWAVES + F.wave; F.NGW = F.G * NWAVES;
    unsigned char* ws = args.ws;
    unsigned* ctl = (unsigned*)(ws + WS_CTL);
    const float* xp = args.in[0]; const float* xs = args.in[1];
    float* rope = (float*)(ws + WS_ROPE); float* SS = (float*)(ws + WS_SS);
    bf16 *W1IN = (bf16*)(ws + WS_W1IN), *W1OUT = (bf16*)(ws + WS_W1OUT), *WIN = (bf16*)(ws + WS_WIN), *WA = (bf16*)(ws + WS_WA), *WB = (bf16*)(ws + WS_WB), *WO = (bf16*)(ws + WS_WO),
         *W2IN = (bf16*)(ws + WS_W2IN), *W2OUT = (bf16*)(ws + WS_W2OUT);
    bf16 *XN = (bf16*)(ws + WS_XN), *ACT = (bf16*)(ws + WS_ACT), *UB = (bf16*)(ws + WS_UB), *GVB = (bf16*)(ws + WS_GVB), *ATT = (bf16*)(ws + WS_ATT), *SGU = (bf16*)(ws + WS_SGU),
         *QB = (bf16*)(ws + WS_QB), *KPB = (bf16*)(ws + WS_KPB), *VPB = (bf16*)(ws + WS_VPB), *SGA = (bf16*)(ws + WS_SGA), *SGB = (bf16*)(ws + WS_SGB);
    bf16* FB = (bf16*)(ws + WS_F); bf16* HB = (bf16*)(ws + WS_H); float* T1 = (float*)(ws + WS_T1);
    bf16 *XNs = (bf16*)(ws + SA_XN), *ACTs = (bf16*)(ws + SA_ACT), *Qs = (bf16*)(ws + SA_Q), *Us = (bf16*)(ws + SA_U), *GVs = (bf16*)(ws + SA_GV), *SGAs = (bf16*)(ws + SA_SGA),
         *SGBs = (bf16*)(ws + SA_SGB), *ATTs = (bf16*)(ws + SA_ATT), *SGUs = (bf16*)(ws + SA_SGU);
    bf16* Fs = (bf16*)(ws + SA_F); float *Hs = (float*)(ws + SA_H), *T1s = (float*)(ws + SA_T1), *SSs = (float*)(ws + SA_SS);
    float* out = args.out;
    volatile LAS unsigned* MISC = (volatile LAS unsigned*)(F.lds + MISC_OFF);
    if (F.tid < 32) MISC[F.tid] = 0u;
    __syncthreads();
    XcdBarrier bar = xcd_barrier_post(ctl + CW_BAR, MISC + 8);
#define GRID_BAR() xcd_barrier(bar)

#if (PHM >> 0) & 1
    {
        LAS float* scr = (LAS float*)(F.lds + F.wave * 16384);
        constexpr int I_FIN = (DM / 64) * (2 * DFF / 32), I_FOUT = (DFF / 64) * (DM / 32), I_IN = (DM / 64) * (INC / 32), I_SQ = (DM / 64) * (DM / 32);
        constexpr int NITEMS = 2 * I_FIN + 2 * I_FOUT + I_IN + 3 * I_SQ;
        for (int it = F.gw; it < NITEMS; it += F.NGW) {
            int r = it;
            if (r < I_FIN) { p0_transpose_item(args.in[5], DM, 2 * DFF, W1IN, 1, scr, r, F.lane); continue; } r -= I_FIN;
            if (r < I_FOUT) { p0_transpose_item(args.in[6], DFF, DM, W1OUT, 0, scr, r, F.lane, LDF); continue; } r -= I_FOUT;
            if (r < I_IN) { p0_transpose_item(args.in[9], DM, INC, WIN, 0, scr, r, F.lane); continue; } r -= I_IN;
            if (r < I_SQ) { p0_transpose_item(args.in[18], DM, DM, WA, 0, scr, r, F.lane); continue; } r -= I_SQ;
            if (r < I_SQ) { p0_transpose_item(args.in[19], DM, DM, WB, 0, scr, r, F.lane); continue; } r -= I_SQ;
            if (r < I_SQ) { p0_transpose_item(args.in[20], DM, DM, WO, 0, scr, r, F.lane); continue; } r -= I_SQ;
            if (r < I_FIN) { p0_transpose_item(args.in[23], DM, 2 * DFF, W2IN, 1, scr, r, F.lane); continue; } r -= I_FIN;
            p0_transpose_item(args.in[24], DFF, DM, W2OUT, 0, scr, r, F.lane, LDF);
        }
        for (int i = blockIdx.x * (NWAVES * 64) + F.tid; i < SEQ * 8; i += F.G * NWAVES * 64) {
            const int pos = i >> 3, d = i & 7;
            const double cf = (d == 0) ? 0.15915494309189535 : (d == 1) ? 0.03086376340470123 : (d == 2) ? 0.005985185712713705 : (d == 3) ? 0.001160663641240061 :
                              (d == 4) ? 0.00022507907903927653 : (d == 5) ? 4.364795279280289e-05 : (d == 6) ? 8.464330808241401e-06 : 1.6414262627950345e-06;
            const double rev = (double)pos * cf; double t = rev - __builtin_floor(rev);
            t = t - __builtin_rint(t);
            const double q = __builtin_rint(4.0 * t); const double a = (t - 0.25 * q) * 6.283185307179586476925;
            const double a2 = a * a;
            const double sn = a * (1.0 + a2 * (-1.0 / 6 + a2 * (1.0 / 120 + a2 * (-1.0 / 5040 + a2 * (1.0 / 362880 + a2 * (-1.0 / 39916800 + a2 * (1.0 / 6227020800.0)))))));
            const double cs = 1.0 + a2 * (-0.5 + a2 * (1.0 / 24 + a2 * (-1.0 / 720 + a2 * (1.0 / 40320 + a2 * (-1.0 / 3628800 + a2 * (1.0 / 479001600 + a2 * (-1.0 / 87178291200.0)))))));
            const int qi = ((int)q) & 3;
            const double s_ = (qi == 0) ? sn : (qi == 1) ? cs : (qi == 2) ? -sn : -cs;
            const double c_ = (qi == 0) ? cs : (qi == 1) ? -sn : (qi == 2) ? -cs : sn;
            rope[(size_t)pos * 16 + d] = (float)c_; rope[(size_t)pos * 16 + 8 + d] = (float)s_;
        }
        const float* g1 = args.in[4];
        for (int m = F.gw; m < MT; m += 2 * F.NGW) {
            const bool two = (m + F.NGW < MT); const int mb = two ? m + F.NGW : m;
            const f32x4* xa = (const f32x4*)xrow_ptr(xp, xs, m) + F.lane; const f32x4* xb = (const f32x4*)xrow_ptr(xp, xs, mb) + F.lane; const f32x4* gp = (const f32x4*)g1 + F.lane;
            f32x4 va[4], vb[4], g[4]; float sa = 0.f, sb = 0.f;
#pragma unroll
            for (int j = 0; j < 4; ++j) { va[j] = xa[64 * j]; vb[j] = xb[64 * j]; g[j] = gp[64 * j]; }
#pragma unroll
            for (int j = 0; j < 4; ++j) { sa += (va[j][0] * va[j][0] + va[j][1] * va[j][1]) + (va[j][2] * va[j][2] + va[j][3] * va[j][3]);
                                          sb += (vb[j][0] * vb[j][0] + vb[j][1] * vb[j][1]) + (vb[j][2] * vb[j][2] + vb[j][3] * vb[j][3]); }
            const float rsa = 1.0f / sqrtf(wave_sum(sa) * (1.0f / DM) + EPS), rsb = 1.0f / sqrtf(wave_sum(sb) * (1.0f / DM) + EPS);
            unsigned long long* oa = (unsigned long long*)(m < SEQ ? XN + (size_t)m * DM : XNs + (size_t)(m - SEQ) * DM) + F.lane;
            unsigned long long* ob = (unsigned long long*)(mb < SEQ ? XN + (size_t)mb * DM : XNs + (size_t)(mb - SEQ) * DM) + F.lane;
#pragma unroll
            for (int j = 0; j < 4; ++j) { const f32x4 w = va[j] * g[j] * rsa; oa[64 * j] = (unsigned long long)pk2(w[0], w[1]) | ((unsigned long long)pk2(w[2], w[3]) << 32); }
            if (two) {
#pragma unroll
                for (int j = 0; j < 4; ++j) { const f32x4 w = vb[j] * g[j] * rsb; ob[64 * j] = (unsigned long long)pk2(w[0], w[1]) | ((unsigned long long)pk2(w[2], w[3]) << 32); }
            }
        }
    }
    GRID_BAR();
    if (args.ws == nullptr) grid.sync();

#endif
#if (PHM >> 1) & 1
    { pg8::Gemm g{XN, W1IN, SEQ, 2 * DFF, DM}; pg8::StaticOrder S; S.init(SEQ, 2 * DFF, F.G, (int)blockIdx.x);
      pg8::EpiSwiglu E{ACT}; pg8::gemm_phase<pg8::EpiSwiglu, pg8::StaticOrder, true, true>(F.lds, g, S, E); }
    GRID_BAR();
#endif
#if (PHM >> 2) & 1
    { pg8::Gemm g{ACT, W1OUT, SEQ, DM, DFF, nullptr, nullptr, LDF}; pg8::StaticOrder S; S.init(SEQ, DM, F.G, (int)blockIdx.x);
      pg8::EpiF32Stats E{FB, SS}; pg8::gemm_phase<pg8::EpiF32Stats, pg8::StaticOrder, false, true>(F.lds, g, S, E); }
    GRID_BAR();
#endif
#if (PHM >> 3) & 1
    row_phase<false, true>(F, F.gw, F.NGW, SEQ, FB, SS, xp, 0.5f, args.in[7], HB, args.in[8], XN);
    GRID_BAR();
#endif
#if (PHM >> 4) & 1
    { pg8::Gemm g{XN, WIN, SEQ, INC, DM}; pg8::StaticOrder S; S.init(SEQ, INC, F.G, (int)blockIdx.x);
      pg8::EpiProj E{QB, KPB, VPB, UB, GVB, SGA, SGB, out + OFF_KP, out + OFF_VP, SS, rope, false}; pg8::gemm_phase<pg8::EpiProj, pg8::StaticOrder, true, true>(F.lds, g, S, E); }
    GRID_BAR();
#endif
#if (PHM >> 5) & 1
    {
        float lam;
        { const float a = args.in[10][F.lane] * args.in[11][F.lane], b = args.in[12][F.lane] * args.in[13][F.lane];
          lam = expf(wave_sum(a)) - expf(wave_sum(b)) + LAM_INIT;
          lam = __builtin_bit_cast(float, __builtin_amdgcn_readfirstlane(__builtin_bit_cast(int, lam))); }
        unsigned* ch = ctl + CW_CH;
        int ch_ready = 0;
#define CH_N(s) ((s) == 1 || (s) == 10 ? 22 : (s) == 4 ? 28 : (s) == 5 ? 192 : ((s) == 3 || (s) == 9 || (s) == 12) ? 1 : 4)
#define CH_DONE_NOW(s, RES) do { if ((s) <= ch_ready) RES = true; else { \
            if (F.tid == 0) MISC[1] = (__hip_atomic_load(ch + 128 * (s) + 64, __ATOMIC_RELAXED, __HIP_MEMORY_SCOPE_AGENT) >= (unsigned)CH_N(s)) ? 1u : 0u; \
            __syncthreads(); RES = __builtin_amdgcn_readfirstlane((int)MISC[1]) != 0; __syncthreads(); } } while (0)
#define CH_WAIT(s) do { if ((s) > ch_ready) { \
            if (F.tid == 0) { unsigned sp_ = 0; while (__hip_atomic_load(ch + 128 * (s) + 64, __ATOMIC_RELAXED, __HIP_MEMORY_SCOPE_AGENT) < (unsigned)CH_N(s)) { __builtin_amdgcn_s_sleep(8); if (++sp_ > (1u << 22)) break; } \
                if (!((s) == 4 && !starter)) { __builtin_amdgcn_fence(__ATOMIC_ACQUIRE, "agent"); asm volatile("s_waitcnt vmcnt(0)" ::: "memory"); } } \
            __syncthreads(); ch_ready = (s); } } while (0)
#define CH_SIGNAL(s) do { asm volatile("s_waitcnt vmcnt(0)" ::: "memory"); __syncthreads(); \
            if (F.tid == 0) { __builtin_amdgcn_fence(__ATOMIC_RELEASE, "agent"); asm volatile("s_waitcnt vmcnt(0)" ::: "memory"); \
                __hip_atomic_fetch_add(ch + 128 * (s) + 64, 1u, __ATOMIC_RELAXED, __HIP_MEMORY_SCOPE_AGENT); } } while (0)
#define WP(T, off) ((T*)(w_ + (off)))
#define CH_UNIT(s, u) do { \
            if ((s) == 1 || (s) == 10) { pg8::Gemm g{WP(bf16, SA_XN), (s) == 1 ? WP(bf16, WS_W1IN) : WP(bf16, WS_W2IN), 256, 2 * DFF, DM}; pg8::OneUnit S{0, (u)}; pg8::EpiSwiglu E{WP(bf16, SA_ACT)}; pg8::gemm_phase<pg8::EpiSwiglu, pg8::OneUnit, false, true>(F.lds, g, S, E); } \
            else if ((s) == 2 || (s) == 11) { pg8::Gemm g{WP(bf16, SA_ACT), (s) == 2 ? WP(bf16, WS_W1OUT) : WP(bf16, WS_W2OUT), 256, DM, DFF, nullptr, nullptr, LDF}; pg8::OneUnit S{0, (u)}; pg8::EpiF32Stats E{WP(bf16, SA_F), WP(float, SA_SS)}; pg8::gemm_phase<pg8::EpiF32Stats, pg8::OneUnit, false, true>(F.lds, g, S, E); } \
            else if ((s) == 8) { pg8::Gemm g{WP(bf16, SA_XN), WP(bf16, WS_WO), 256, DM, DM}; pg8::OneUnit S{0, (u)}; pg8::EpiF32Stats E{WP(bf16, SA_F), WP(float, SA_SS)}; pg8::gemm_phase<pg8::EpiF32Stats, pg8::OneUnit, false, true>(F.lds, g, S, E); } \
            else if ((s) == 4) { pg8::Gemm g{WP(bf16, SA_XN), WP(bf16, WS_WIN), 256, INC, DM}; pg8::OneUnit S{0, (u)}; \
                               pg8::EpiProj E{WP(bf16, SA_Q), nullptr, nullptr, WP(bf16, SA_U), WP(bf16, SA_GV), WP(bf16, SA_SGA), WP(bf16, SA_SGB), o_ + OFF_KS, o_ + OFF_VS, WP(float, SA_SS), WP(float, WS_ROPE), true}; \
                               pg8::gemm_phase<pg8::EpiProj, pg8::OneUnit, false, true>(F.lds, g, S, E); } \
            else if ((s) == 6) { pg8::Gemm g{WP(bf16, SA_ATT), WP(bf16, WS_WA), 256, DM, DM}; pg8::OneUnit S{0, (u)}; pg8::EpiGateA E{WP(float, SA_T1), WP(bf16, SA_SGA)}; pg8::gemm_phase<pg8::EpiGateA, pg8::OneUnit, false, true>(F.lds, g, S, E); } \
            else if ((s) == 7) { pg8::Gemm g{WP(bf16, SA_SGU), WP(bf16, WS_WB), 256, DM, DM}; pg8::OneUnit S{0, (u)}; pg8::EpiGateB E{WP(float, SA_T1), WP(bf16, SA_SGB), WP(bf16, SA_XN)}; pg8::gemm_phase<pg8::EpiGateB, pg8::OneUnit, false, true>(F.lds, g, S, E); } \
            else if ((s) == 3) row_phase<false, false>(F, F.wave, NWAVES, 256, WP(bf16, SA_F), WP(float, SA_SS), KIN(1), 0.5f, KIN(7), WP(float, SA_H), KIN(8), WP(bf16, SA_XN)); \
            else if ((s) == 9) row_phase<false, false>(F, F.wave, NWAVES, 256, WP(bf16, SA_F), WP(float, SA_SS), WP(float, SA_H), 1.0f, KIN(21), WP(float, SA_H), KIN(22), WP(bf16, SA_XN)); \
            else if ((s) == 12) row_phase<false, false>(F, F.wave, NWAVES, 256, WP(bf16, SA_F), WP(float, SA_SS), WP(float, SA_H), 0.5f, KIN(25), o_ + OFF_Y + (size_t)SEQ * DM, nullptr, nullptr); \
            else {} } while (0)
#ifndef P5_REPS
#define P5_REPS 1
#endif
#ifndef NDED
#define NDED 16
#endif
        const int h8 = blockIdx.x & 7;
#pragma unroll 1
        for (int rep = 0; rep < P5_REPS; ++rep) {
        unsigned* qb_ = ctl + CW_Q + rep * 1024;
        const bool starter = (int)blockIdx.x >= (int)F.G - NDED;
        int st = starter ? 0 : 1, cs = starter ? 1 : 5, hh = 0; bool s5_open = true, try5 = false;
        for (;;) {
            int kind = 0, a0 = 0, a1 = 0, dep = 0, sig = 0;
            if (st == 0 || st == 3) {
                while (cs <= 12) { const int u = queue_pop(ch + 128 * cs, MISC); if (u < CH_N(cs)) { kind = 3; a0 = cs; a1 = u; dep = cs - 1; sig = cs; break; } ++cs; }
                if (kind == 0) { if (st == 0) { st = 1; cs = 5; continue; } break; }
            } else if (st == 1) {
                if (try5) { try5 = false; bool rdy_; CH_DONE_NOW(4, rdy_);
                    if (rdy_) { const int u = queue_pop(ch + 128 * 5, MISC); if (u < CH_N(5)) { kind = 3; a0 = 5; a1 = u; dep = 4; sig = 5; } else s5_open = false; } }
                if (kind == 0) {
                    while (hh < 8) { const int hq = (h8 + hh) & 7; const int idx = queue_pop(qb_ + 64 * hq, MISC); if (idx < 128) { kind = 1; a0 = hq; a1 = 127 - idx; try5 = s5_open; break; } ++hh; }
                    if (kind == 0) { st = 2; continue; }
                }
            } else {
                const int idx = queue_pop(qb_ + 64 * 8, MISC);
                if (idx < 512) { kind = 2; a0 = idx >> 2; a1 = idx & 3; } else { st = 3; cs = 5; continue; }
            }
            if (dep) CH_WAIT(dep);
            typedef __attribute__((address_space(4))) const unsigned long long* kptr_t;
            kptr_t kq_ = (kptr_t)__builtin_amdgcn_kernarg_segment_ptr(); asm volatile("" : "+s"(kq_));
#define KIN(k) ((const float*)(const GAS float*)kq_[k])
            unsigned char* w_ = (unsigned char*)(GAS unsigned char*)kq_[27]; float* o_ = (float*)(GAS float*)kq_[26];
            if (kind == 1 || (kind == 3 && a0 == 5 && a1 < 128)) {
                att::Args AA{WP(bf16, WS_QB), WP(bf16, WS_KPB), WP(bf16, WS_VPB), KIN(2), KIN(3), o_ + OFF_KS, o_ + OFF_VS, WP(bf16, WS_ATT), KIN(14), WP(bf16, SA_Q), WP(bf16, SA_ATT), o_ + OFF_KP, o_ + OFF_VP};
                if (kind == 1) att::attn_unit<false>(AA, a0, a1, (char*)lds, lam); else att::attn_unit<true>(AA, a1 & 7, a1 >> 3, (char*)lds, lam);
            } else if (kind == 2 || (kind == 3 && a0 == 5)) { const bool smp = (kind == 3);
                att::SpArgs SA{WP(bf16, WS_UB), WP(bf16, WS_GVB), WP(float, WS_SS), KIN(15), KIN(16), KIN(17), WP(bf16, WS_SGU), o_ + OFF_GS, WP(bf16, SA_U), WP(bf16, SA_GV), WP(float, SA_SS), WP(bf16, SA_SGU)};
                if (smp) att::spatial_unit(SA, true, (a1 - 128) >> 2, (a1 - 128) & 3, (char*)lds); else att::spatial_unit_prompt(SA, a0, a1, (char*)lds); }
            else CH_UNIT(a0, a1);
            if (sig) CH_SIGNAL(sig);
        }
        if (rep + 1 < P5_REPS) GRID_BAR();
        }
    }
    GRID_BAR();
#endif
#if (PHM >> 6) & 1
    { pg8::Gemm g{ATT, WA, SEQ, DM, DM, SGU, WB}; pg8::DualOrder S; S.init(SEQ, DM, F.G, (int)blockIdx.x);
      pg8::EpiGateAB E{SGA, SGB, XN}; pg8::gemm_phase<pg8::EpiGateAB, pg8::DualOrder, true, true>(F.lds, g, S, E); }
    GRID_BAR();
#endif
#if (PHM >> 8) & 1
    { pg8::Gemm g{XN, WO, SEQ, DM, DM}; pg8::StaticOrder S; S.init(SEQ, DM, F.G, (int)blockIdx.x);
      pg8::EpiF32Stats E{FB, SS}; pg8::gemm_phase<pg8::EpiF32Stats, pg8::StaticOrder, false, true>(F.lds, g, S, E); }
    GRID_BAR();
#endif
#if (PHM >> 9) & 1
    row_phase<true, true>(F, F.gw, F.NGW, SEQ, FB, SS, HB, 1.0f, args.in[21], HB, args.in[22], XN);
    GRID_BAR();
#endif
#if (PHM >> 10) & 1
    { pg8::Gemm g{XN, W2IN, SEQ, 2 * DFF, DM}; pg8::StaticOrder S; S.init(SEQ, 2 * DFF, F.G, (int)blockIdx.x);
      pg8::EpiSwiglu E{ACT}; pg8::gemm_phase<pg8::EpiSwiglu, pg8::StaticOrder, true, true>(F.lds, g, S, E); }
    GRID_BAR();
    { pg8::Gemm g{ACT, W2OUT, SEQ, DM, DFF, nullptr, nullptr, LDF}; pg8::StaticOrder S; S.init(SEQ, DM, F.G, (int)blockIdx.x);
      pg8::EpiF32Stats E{FB, SS}; pg8::gemm_phase<pg8::EpiF32Stats, pg8::StaticOrder, false, true>(F.lds, g, S, E); }
    GRID_BAR();
#endif
#if (PHM >> 11) & 1
        row_phase<true, false>(F, F.gw, F.NGW, SEQ, FB, SS, HB, 0.5f, args.in[25], out + OFF_Y, nullptr, nullptr);
#endif
#ifdef PROBE_BF16
    for (size_t i = (size_t)blockIdx.x * 512 + F.tid; i < (size_t)MT * DM; i += (size_t)F.G * 512) out[OFF_Y + i] = bf2f(((const bf16*)PROBE_BF16)[i]);
#elif !((PHM >> 11) & 1)
    for (size_t i = (size_t)blockIdx.x * 512 + F.tid; i < (size_t)MT * DM / 4; i += (size_t)F.G * 512) ((f32x4*)(out + OFF_Y))[i] = (f32x4){0.f, 0.f, 0.f, 0.f};
#endif
#if !((PHM >> 5) & 1)
    for (size_t i = (size_t)blockIdx.x * 512 + F.tid; i < (size_t)256 * DM / 4; i += (size_t)F.G * 512) ((f32x4*)(out + OFF_GS))[i] = (f32x4){0.f, 0.f, 0.f, 0.f};
#endif
}

extern "C" void kernel_launch(void* const* d_in, const int* in_sizes, int n_in, void* d_out, int out_size, void* d_ws, size_t ws_size, hipStream_t stream) {
    static int grid = 0;
    if (grid == 0) {
        if (n_in != 26 || ws_size < WS_END) { fprintf(stderr, "kernel_launch: unexpected n_in %d / ws %zu\n", n_in, ws_size); grid = -1; return; }
        int dev = 0, cus = 0, per_cu = 0;
        if (hipGetDevice(&dev) != hipSuccess || hipDeviceGetAttribute(&cus, hipDeviceAttributeMultiprocessorCount, dev) != hipSuccess) { grid = -1; return; }
        if (hipFuncSetAttribute((const void*)mk_fwd, hipFuncAttributeMaxDynamicSharedMemorySize, LDS_BYTES) != hipSuccess) { fprintf(stderr, "kernel_launch: hipFuncSetAttribute failed\n"); grid = -1; return; }
        if (hipOccupancyMaxActiveBlocksPerMultiprocessor(&per_cu, (const void*)mk_fwd, NWAVES * 64, LDS_BYTES) != hipSuccess || per_cu < 1) { fprintf(stderr, "kernel_launch: occupancy query says %d\n", per_cu); per_cu = 1; }
        (void)hipGetLastError();
        grid = cus;
    }
    if (grid < 0) return;
    (void)hipMemsetAsync((char*)d_ws + WS_CTL, 0, CTL_ZERO_BYTES, stream);
    KArgs a{};
    for (int i = 0; i < 26; ++i) a.in[i] = (const float*)d_in[i];
    a.out = (float*)d_out; a.ws = (unsigned char*)d_ws;
    void* kargs[] = {&a};
    hipError_t e = hipLaunchCooperativeKernel((const void*)mk_fwd, dim3(grid), dim3(NWAVES * 64), kargs, LDS_BYTES, stream);
    if (e != hipSuccess) fprintf(stderr, "kernel_launch: cooperative launch failed: %s (grid %d)\n", hipGetErrorString(e), grid);
}
```

```cpp
#include <hip/hip_runtime.h>
#include <hip/hip_cooperative_groups.h>
#include <cstdio>
#include <cstdint>
namespace cg = cooperative_groups;
#ifndef P5M
#define P5M 7
#endif
#ifndef PHM
#define PHM 0xFFF
#endif

namespace pg8 {
#define PG8_LAS __attribute__((address_space(3)))
typedef unsigned short bf16_t;
typedef short bf16x8 __attribute__((ext_vector_type(8)));
typedef float f32x4 __attribute__((ext_vector_type(4)));
typedef float f32x2 __attribute__((ext_vector_type(2)));
typedef unsigned u32x4 __attribute__((ext_vector_type(4)));
typedef unsigned u32x2 __attribute__((ext_vector_type(2)));
constexpr int BM = 256, BK = 64, HALF = 128, HTB = HALF * BK * 2, STAGE_BYTES = 8 * HTB, NXCD = 8, WGM = 8;

__host__ __device__ __forceinline__ int lds_byte(int r, int c) { const int st = (r >> 4) * 2 + (c >> 5), rr = r & 15, cc = c & 31, ob = rr * 64 + cc * 2; return st * 1024 + (ob ^ (((ob >> 9) & 1) << 5)); }
__host__ __device__ __forceinline__ void stage_rc(int b, int& R, int& C) { const int st = b / 1024, sb = b % 1024, swz = sb ^ (((sb >> 9) & 1) << 5); R = (st >> 1) * 16 + swz / 64; C = (st & 1) * 32 + (swz % 64) / 2; }
__host__ __device__ __forceinline__ int perm32(int rho) { const int n = rho >> 4, i = rho & 15; return 8 * (i >> 2) + 4 * n + (i & 3); }

struct Unit { int pm, pn, w; };
struct Gemm { const bf16_t* A; const bf16_t* Bt; int M, N, K; const bf16_t* A2 = nullptr; const bf16_t* Bt2 = nullptr; int ld = 0; };

struct StaticOrder {
    int nM, nN, nwg, G, c;
    __host__ __device__ void init(int M, int N, int G_, int c_) { nM = M / BM; nN = N / BM; nwg = nM * nN; G = G_; c = c_; }
    __host__ __device__ bool next(int i, Unit& u) const {
        const long L = (long)i * G + c; if (L >= nwg) return false;
        int wgid = (int)L; { const int q = nwg / NXCD, r = nwg % NXCD, xcd = wgid % NXCD, off = wgid / NXCD; wgid = (xcd < r ? xcd * (q + 1) : r * (q + 1) + (xcd - r) * q) + off; }
        const int nig = WGM * nN, gid = wgid / nig, fm = gid * WGM, gsz = (nM - fm) < WGM ? (nM - fm) : WGM;
        u.pm = fm + ((wgid % nig) % gsz); u.pn = (wgid % nig) / gsz; u.w = 0; return true;
    }
    __device__ __forceinline__ void a_ready(const Unit&) const {}
    __device__ __forceinline__ void done(const Unit&) const {}
};
struct DualOrder {
    StaticOrder so;
    __host__ __device__ void init(int M, int N, int G_, int c_) { so.init(M, N, G_, c_); }
    __host__ __device__ bool next(int i, Unit& u) const { if (!so.next(i >> 1, u)) return false; u.w = i & 1; return true; }
    __device__ __forceinline__ void a_ready(const Unit&) const {}
    __device__ __forceinline__ void done(const Unit&) const {}
};

typedef float f32x2_cv __attribute__((ext_vector_type(2))); typedef __bf16 bf16x2_cv __attribute__((ext_vector_type(2)));
struct OneUnit {
    int pm, pn;
    __device__ __forceinline__ bool next(int i, Unit& u) const { if (i > 0) return false; u.pm = pm; u.pn = pn; u.w = 0; return true; }
    __device__ __forceinline__ void a_ready(const Unit&) const {}
    __device__ __forceinline__ void done(const Unit&) const {}
};
__device__ __forceinline__ unsigned cvt_pk_bf16(float lo, float hi) { f32x2_cv v = {lo, hi}; bf16x2_cv b = __builtin_convertvector(v, bf16x2_cv); return __builtin_bit_cast(unsigned, b); }

template <class Epi, class Sched, bool ALIGN_EPI = false, bool SP2 = false>
__device__ __forceinline__ void gemm_phase(PG8_LAS unsigned char* lds, const Gemm g, const Sched& S, const Epi& E) {
    int tid = threadIdx.x; asm volatile("" : "+v"(tid));
    const int wid = __builtin_amdgcn_readfirstlane(tid >> 6), lane = tid & 63, wr = wid >> 2, wc = wid & 3, fr = lane & 15, fq = lane >> 4;
    const int K = g.K, nt = K / BK, LD = g.ld ? g.ld : g.K;
    unsigned voffA[2], voffB[2];
#pragma unroll
    for (int i = 0; i < 2; ++i) { int R, C; stage_rc(tid * 16 + i * 8192, R, C); const int Rb = Epi::PERM ? ((R & ~31) + perm32(R & 31)) : R;
        voffA[i] = (unsigned)(R * LD + C) * 2u; voffB[i] = (unsigned)(Rb * LD + C) * 2u; }
    const size_t kstep = (size_t)(BK * 2);
    const size_t hstep = (size_t)HALF * LD * 2;
    const size_t tstep = 2 * hstep;
    const unsigned ldsw = (unsigned)wid * 1024u;
    const int aoff = lds_byte(wr * 64 + fr, fq * 8), boff = lds_byte(wc * 32 + fr, fq * 8);
#define PG8_SA(b, h) (((b) * 2 + (h)) * HTB)
#define PG8_SB(b, h) ((4 + (b) * 2 + (h)) * HTB)
#define PG8_STAGE(bufoff, gbase, voff) do { _Pragma("unroll") for (int _i = 0; _i < 2; ++_i) \
        __builtin_amdgcn_global_load_lds((const unsigned*)((const char*)(gbase) + (voff)[_i]), (PG8_LAS unsigned*)(lds + (bufoff) + ldsw + _i * 8192), 16, 0, 0); } while (0)
#define PG8_LDA(dst, b, h) do { _Pragma("unroll") for (int m = 0; m < 4; ++m) _Pragma("unroll") for (int k = 0; k < 2; ++k) dst[m][k] = *(const PG8_LAS bf16x8*)(lds + PG8_SA(b, h) + aoff + m * 2048 + k * 1024); } while (0)
#define PG8_LDB(dst, b, h) do { _Pragma("unroll") for (int n = 0; n < 2; ++n) _Pragma("unroll") for (int k = 0; k < 2; ++k) dst[n][k] = *(const PG8_LAS bf16x8*)(lds + PG8_SB(b, h) + boff + n * 2048 + k * 1024); } while (0)
#define PG8_MMA(ai, bj, At, Bt) do { __builtin_amdgcn_s_setprio(1); _Pragma("unroll") for (int m = 0; m < 4; ++m) _Pragma("unroll") for (int n = 0; n < 2; ++n) _Pragma("unroll") for (int k = 0; k < 2; ++k) \
        acc[ai][bj][m][n] = __builtin_amdgcn_mfma_f32_16x16x32_bf16(Bt[n][k], At[m][k], acc[ai][bj][m][n], 0, 0, 0); __builtin_amdgcn_s_setprio(0); } while (0)
#define PG8_WAIT_V(n) asm volatile("s_waitcnt vmcnt(" #n ")" ::: "memory")
#define PG8_WAIT_L(n) asm volatile("s_waitcnt lgkmcnt(" #n ")" ::: "memory")
#define PG8_BAR __builtin_amdgcn_s_barrier()
#define PG8_SCHED __builtin_amdgcn_sched_barrier(0)
    Unit cur, nxt; int ui = 0;
    if (!S.next(0, cur)) return;
    f32x4 acc[2][2][4][2];
#pragma unroll
    for (int a = 0; a < 2; ++a)
#pragma unroll
        for (int b = 0; b < 2; ++b)
#pragma unroll
            for (int m = 0; m < 4; ++m)
#pragma unroll
                for (int n = 0; n < 2; ++n) acc[a][b][m][n] = (f32x4){0.f, 0.f, 0.f, 0.f};
    bf16x8 At[4][2], B0[2][2], B1[2][2];
    const char* cA = (const char*)(cur.w ? g.A2 : g.A) + (size_t)cur.pm * tstep; const char* cB = (const char*)(cur.w ? g.Bt2 : g.Bt) + (size_t)cur.pn * tstep;
    S.a_ready(cur);
    if constexpr (SP2) {
        PG8_STAGE(PG8_SB(0, 0), cB, voffB); PG8_STAGE(PG8_SB(0, 1), cB + hstep, voffB); PG8_STAGE(PG8_SA(0, 0), cA, voffA); PG8_STAGE(PG8_SA(0, 1), cA + hstep, voffA);
        if (wr == 1) PG8_BAR;
        PG8_WAIT_V(2); PG8_BAR;
        PG8_STAGE(PG8_SB(1, 0), cB + kstep, voffB); PG8_STAGE(PG8_SA(1, 0), cA + kstep, voffA); PG8_STAGE(PG8_SB(1, 1), cB + hstep + kstep, voffB);
        PG8_WAIT_V(6); PG8_BAR;
    } else {
        PG8_STAGE(PG8_SB(0, 0), cB, voffB); PG8_STAGE(PG8_SA(0, 0), cA, voffA); PG8_STAGE(PG8_SB(0, 1), cB + hstep, voffB); PG8_STAGE(PG8_SA(0, 1), cA + hstep, voffA);
        if (wr == 1) PG8_BAR;
        PG8_WAIT_V(4); PG8_BAR;
        PG8_STAGE(PG8_SB(1, 0), cB + kstep, voffB); PG8_STAGE(PG8_SA(1, 0), cA + kstep, voffA); PG8_STAGE(PG8_SB(1, 1), cB + hstep + kstep, voffB);
        PG8_WAIT_V(6); PG8_BAR;
    }
    for (;;) {
        const bool has_next = S.next(ui + 1, nxt);
        const char* nA = has_next ? (const char*)(nxt.w ? g.A2 : g.A) + (size_t)nxt.pm * tstep : cA; const char* nB = has_next ? (const char*)(nxt.w ? g.Bt2 : g.Bt) + (size_t)nxt.pn * tstep : cB;
        for (int t = 0; t < nt; t += 2) {
            const bool last = (t == nt - 2);
            const char* a1 = cA + (size_t)(t + 1) * kstep;
            const char* a2 = last ? nA : cA + (size_t)(t + 2) * kstep; const char* b2 = last ? nB : cB + (size_t)(t + 2) * kstep;
            const char* a3 = a2 + kstep; const char* b3 = b2 + kstep;
            if (last && has_next) S.a_ready(nxt);
            if constexpr (SP2) {
            PG8_LDB(B0, 0, 0); PG8_LDB(B1, 0, 1); PG8_SCHED; PG8_LDA(At, 0, 0); PG8_STAGE(PG8_SA(1, 1), a1 + hstep, voffA);
            PG8_WAIT_V(8); PG8_WAIT_L(0); PG8_BAR; PG8_MMA(0, 0, At, B0); PG8_MMA(0, 1, At, B1); PG8_BAR; PG8_SCHED;
            PG8_LDA(At, 0, 1); PG8_STAGE(PG8_SB(0, 0), b2, voffB); PG8_STAGE(PG8_SB(0, 1), b2 + hstep, voffB); PG8_STAGE(PG8_SA(0, 0), a2, voffA);
            PG8_WAIT_V(8); PG8_WAIT_L(0); PG8_BAR; PG8_MMA(1, 0, At, B0); PG8_MMA(1, 1, At, B1); PG8_BAR; PG8_SCHED;
            PG8_LDB(B0, 1, 0); PG8_LDB(B1, 1, 1); PG8_SCHED; PG8_LDA(At, 1, 0); PG8_STAGE(PG8_SA(0, 1), a2 + hstep, voffA);
            PG8_WAIT_V(8); PG8_WAIT_L(0); PG8_BAR; PG8_MMA(0, 0, At, B0); PG8_MMA(0, 1, At, B1); PG8_BAR; PG8_SCHED;
            PG8_LDA(At, 1, 1); PG8_STAGE(PG8_SB(1, 0), b3, voffB); PG8_STAGE(PG8_SB(1, 1), b3 + hstep, voffB); PG8_STAGE(PG8_SA(1, 0), a3, voffA);
            PG8_WAIT_V(8); PG8_WAIT_L(0); PG8_BAR; PG8_MMA(1, 0, At, B0); PG8_MMA(1, 1, At, B1); PG8_BAR; PG8_SCHED;
            } else {
            PG8_LDB(B0, 0, 0); PG8_SCHED; PG8_LDA(At, 0, 0); PG8_STAGE(PG8_SA(1, 1), a1 + hstep, voffA);
            PG8_WAIT_L(8); PG8_BAR; PG8_WAIT_L(0); PG8_MMA(0, 0, At, B0); PG8_BAR; PG8_SCHED;
            PG8_LDB(B1, 0, 1); PG8_STAGE(PG8_SB(0, 0), b2, voffB);
            PG8_BAR; PG8_WAIT_L(0); PG8_MMA(0, 1, At, B1); PG8_BAR;
            PG8_LDA(At, 0, 1); PG8_STAGE(PG8_SA(0, 0), a2, voffA);
            PG8_BAR; PG8_WAIT_L(0); PG8_MMA(1, 0, At, B0); PG8_BAR; PG8_SCHED;
            PG8_STAGE(PG8_SB(0, 1), b2 + hstep, voffB);
            PG8_WAIT_V(6); PG8_BAR; PG8_MMA(1, 1, At, B1); PG8_BAR;
            PG8_LDB(B0, 1, 0); PG8_SCHED; PG8_LDA(At, 1, 0); PG8_STAGE(PG8_SA(0, 1), a2 + hstep, voffA);
            PG8_WAIT_L(8); PG8_BAR; PG8_WAIT_L(0); PG8_MMA(0, 0, At, B0); PG8_BAR; PG8_SCHED;
            PG8_LDB(B1, 1, 1); PG8_STAGE(PG8_SB(1, 0), b3, voffB);
            PG8_BAR; PG8_WAIT_L(0); PG8_MMA(0, 1, At, B1); PG8_BAR;
            PG8_LDA(At, 1, 1); PG8_STAGE(PG8_SA(1, 0), a3, voffA);
            PG8_BAR; PG8_WAIT_L(0); PG8_MMA(1, 0, At, B0); PG8_BAR; PG8_SCHED;
            PG8_STAGE(PG8_SB(1, 1), b3 + hstep, voffB);
            PG8_WAIT_V(6); PG8_BAR; PG8_MMA(1, 1, At, B1); PG8_BAR;
            }
        }
        if constexpr (ALIGN_EPI) { if (wr == 0) PG8_BAR; }
        E(acc, cur, wr, wc, fr, fq); S.done(cur);
        if (!has_next) break;
        if (!(Epi::DUAL && cur.w == 0)) {
#pragma unroll
        for (int a = 0; a < 2; ++a)
#pragma unroll
            for (int b = 0; b < 2; ++b)
#pragma unroll
                for (int m = 0; m < 4; ++m)
#pragma unroll
                    for (int n = 0; n < 2; ++n) acc[a][b][m][n] = (f32x4){0.f, 0.f, 0.f, 0.f};
        }
        cur = nxt; cA = nA; cB = nB; ++ui;
        if constexpr (ALIGN_EPI) { if (wr == 1) PG8_BAR; }
    }
    PG8_WAIT_V(0);
    if constexpr (!ALIGN_EPI) { if (wr == 0) PG8_BAR; }
    PG8_BAR;
#undef PG8_SA
#undef PG8_SB
#undef PG8_STAGE
#undef PG8_LDA
#undef PG8_LDB
#undef PG8_MMA
#undef PG8_WAIT_V
#undef PG8_WAIT_L
#undef PG8_BAR
#undef PG8_SCHED
}
}

constexpr int DM = 1024, SEQ = 16384, DECB = 16, DECS = 16, PAST = 2048, NH = 8, DFF = 2816, INC = 7168;
constexpr int MT = SEQ + DECB * DECS;
constexpr int LDF = 2880;
constexpr float EPS = 1e-6f;
constexpr float C2 = 0.18033688011112042f;
constexpr float LAM_INIT = 0.2f;

constexpr size_t OFF_Y = 0, OFF_KP = (size_t)MT * DM, OFF_VP = OFF_KP + (size_t)SEQ * DM, OFF_KS = OFF_VP + (size_t)SEQ * DM,
                 OFF_VS = OFF_KS + (size_t)256 * DM, OFF_GS = OFF_VS + (size_t)256 * DM;

constexpr size_t MiB = 1u << 20;
constexpr size_t WS_CTL = 0, CTL_ZERO_BYTES = 64 * 1024;
constexpr size_t WS_ROPE = 1 * MiB;
constexpr size_t WS_SS = 2 * MiB;
constexpr size_t WS_W1IN = 4 * MiB;
constexpr size_t WS_W1OUT = 15 * MiB;
constexpr size_t WS_WIN = 21 * MiB;
constexpr size_t WS_WA = 35 * MiB, WS_WB = 37 * MiB, WS_WO = 39 * MiB;
constexpr size_t WS_W2IN = 41 * MiB, WS_W2OUT = 52 * MiB;
constexpr size_t WS_XN = 58 * MiB;
constexpr size_t WS_ACT = 91 * MiB;
constexpr size_t WS_UB = WS_ACT, WS_GVB = WS_ACT + 33 * MiB;
constexpr size_t WS_F = 184 * MiB;
constexpr size_t WS_ATT = WS_F, WS_SGU = WS_F + 33 * MiB;
constexpr size_t WS_H = 250 * MiB;
constexpr size_t WS_QB = 316 * MiB, WS_KPB = 349 * MiB, WS_VPB = 382 * MiB;
constexpr size_t WS_T1 = WS_QB;
constexpr size_t WS_SGA = 415 * MiB, WS_SGB = 448 * MiB;
constexpr size_t WS_SA = 481 * MiB;
constexpr size_t SA_XN = WS_SA, SA_ACT = WS_SA + 1 * MiB, SA_F = WS_SA + 3 * MiB, SA_H = WS_SA + 4 * MiB, SA_T1 = WS_SA + 5 * MiB, SA_Q = WS_SA + 6 * MiB,
                 SA_U = SA_Q + 512 * 1024, SA_GV = SA_U + 512 * 1024, SA_SGA = SA_GV + 512 * 1024, SA_SGB = SA_SGA + 512 * 1024, SA_ATT = SA_SGB + 512 * 1024,
                 SA_SGU = SA_ATT + 512 * 1024, SA_SS = SA_SGU + 512 * 1024;
constexpr size_t WS_END = 493 * MiB;
static_assert(WS_SS + (size_t)MT * 16 * 4 <= WS_W1IN && WS_XN + (size_t)MT * DM * 2 <= WS_ACT && WS_ACT + (size_t)MT * LDF * 2 <= WS_F &&
              WS_F + (size_t)MT * DM * 4 <= WS_H && WS_H + (size_t)MT * DM * 4 <= WS_QB &&
              WS_GVB + (size_t)MT * DM * 2 <= WS_F && WS_SGU + (size_t)MT * DM * 2 <= WS_H && true &&
              WS_W2OUT + (size_t)DM * LDF * 2 <= WS_XN && WS_W1IN + (size_t)2 * DFF * DM * 2 <= WS_W1OUT && WS_W1OUT + (size_t)DM * LDF * 2 <= WS_WIN &&
              WS_WIN + (size_t)INC * DM * 2 <= WS_WA && WS_W2IN + (size_t)2 * DFF * DM * 2 <= WS_W2OUT, "d_ws map");
constexpr int CW_BAR = 4096;
constexpr int CW_CH = 2048;
constexpr int CW_Q = 1024;

constexpr int RING_BYTES = 131072, MISC_OFF = RING_BYTES + 320, LDS_BYTES = 147456;
constexpr int NWAVES = 8;

#define GAS __attribute__((address_space(1)))
#define LAS __attribute__((address_space(3)))
typedef unsigned short bf16;
typedef unsigned v4u __attribute__((ext_vector_type(4)));
typedef unsigned v2u __attribute__((ext_vector_type(2)));
typedef float f32x4 __attribute__((ext_vector_type(4)));
#define LDS_WAIT() asm volatile("s_waitcnt lgkmcnt(0)" ::: "memory")
__device__ __forceinline__ unsigned f2bf(float f) { unsigned u = __builtin_bit_cast(unsigned, f); return (u + 0x7fffu + ((u >> 16) & 1u)) >> 16; }
__device__ __forceinline__ unsigned pk2(float lo, float hi) { return f2bf(lo) | (f2bf(hi) << 16); }
__device__ __forceinline__ float bf2f(unsigned short b) { return __builtin_bit_cast(float, (unsigned)b << 16); }
__device__ __forceinline__ float bflo(unsigned w) { return __builtin_bit_cast(float, w << 16); }
__device__ __forceinline__ float bfhi(unsigned w) { return __builtin_bit_cast(float, w & 0xffff0000u); }
__device__ __forceinline__ float wave_sum(float v) {
#pragma unroll
    for (int o = 1; o < 64; o <<= 1) v += __shfl_xor(v, o);
    return v;
}
__device__ __forceinline__ float fast_rcp(float x) { return __builtin_amdgcn_rcpf(x); }
__device__ __forceinline__ float sigmoidf_(float x) { return fast_rcp(1.0f + __builtin_amdgcn_exp2f(-1.4426950408889634f * x)); }
__device__ __forceinline__ float siluf_(float x) { return x * sigmoidf_(x); }
__device__ __forceinline__ float geluf_(float x) { const float z = 1.5957691216057308f * (x + 0.044715f * x * x * x); return x * sigmoidf_(z); }

namespace pg8 {
struct EpiSwiglu {
    static constexpr bool PERM = true, DUAL = false;
    bf16_t* O;
    __device__ __forceinline__ void operator()(const f32x4 (&acc)[2][2][4][2], const Unit& u, int wr, int wc, int fr, int fq) const {
        const int row0 = u.pm * BM + wr * 64 + fr, col0 = u.pn * 128 + wc * 32 + 8 * fq;
#pragma unroll
        for (int ai = 0; ai < 2; ++ai)
#pragma unroll
            for (int m = 0; m < 4; ++m) {
                const f32x4 a0 = acc[ai][0][m][0], a1 = acc[ai][0][m][1], b0 = acc[ai][1][m][0], b1 = acc[ai][1][m][1];
                u32x4 w;
                w.x = cvt_pk_bf16(siluf_(a0[0]) * b0[0], siluf_(a0[1]) * b0[1]); w.y = cvt_pk_bf16(siluf_(a0[2]) * b0[2], siluf_(a0[3]) * b0[3]);
                w.z = cvt_pk_bf16(siluf_(a1[0]) * b1[0], siluf_(a1[1]) * b1[1]); w.w = cvt_pk_bf16(siluf_(a1[2]) * b1[2], siluf_(a1[3]) * b1[3]);
                *(u32x4*)(O + (size_t)(row0 + ai * HALF + m * 16) * LDF + col0) = w;
            }
    }
};
struct EpiF32Stats {
    static constexpr bool PERM = true, DUAL = false;
    bf16_t* O; float* SS;
    __device__ __forceinline__ void operator()(const f32x4 (&acc)[2][2][4][2], const Unit& u, int wr, int wc, int fr, int fq) const {
        const int row0 = u.pm * BM + wr * 64 + fr, col0 = u.pn * BM + wc * 32 + 8 * fq;
#pragma unroll
        for (int ai = 0; ai < 2; ++ai)
#pragma unroll
            for (int m = 0; m < 4; ++m) {
                const int row = row0 + ai * HALF + m * 16; float s = 0.f;
#pragma unroll
                for (int bj = 0; bj < 2; ++bj) { const f32x4 v0 = acc[ai][bj][m][0], v1 = acc[ai][bj][m][1];
                    u32x4 w; w.x = cvt_pk_bf16(v0[0], v0[1]); w.y = cvt_pk_bf16(v0[2], v0[3]); w.z = cvt_pk_bf16(v1[0], v1[1]); w.w = cvt_pk_bf16(v1[2], v1[3]);
                    *(u32x4*)(O + (size_t)row * DM + col0 + bj * HALF) = w;
                    s += (v0[0] * v0[0] + v0[1] * v0[1]) + (v0[2] * v0[2] + v0[3] * v0[3]) + (v1[0] * v1[0] + v1[1] * v1[1]) + (v1[2] * v1[2] + v1[3] * v1[3]); }
                s += __shfl_xor(s, 16); s += __shfl_xor(s, 32);
                if (fq == 0) SS[(size_t)row * 16 + u.pn * 4 + wc] = s;
            }
    }
};
struct EpiProj {
    static constexpr bool PERM = true, DUAL = false;
    bf16_t *Qb, *Kp, *Vp, *Ub, *GVb, *SGA, *SGB; float* kout; float* vout; float* SS; const float* rope; bool samp;
    __device__ __forceinline__ void operator()(const f32x4 (&acc)[2][2][4][2], const Unit& u, int wr, int wc, int fr, int fq) const {
        const int type = u.pn >> 2, cb = (u.pn & 3) * 256;
        const int row0 = u.pm * BM + wr * 64 + fr, col0 = cb + wc * 32 + 8 * fq;
        if (type <= 1) {
            const bool ropew = ((wc & 1) == 0);
#pragma unroll
            for (int ai = 0; ai < 2; ++ai)
#pragma unroll
                for (int m = 0; m < 4; ++m) {
                    const int row = row0 + ai * HALF + m * 16;
                    f32x4 v[2][2];
#pragma unroll
                    for (int bj = 0; bj < 2; ++bj)
#pragma unroll
                        for (int n = 0; n < 2; ++n) v[bj][n] = acc[ai][bj][m][n];
                    if (ropew) {
                        const int pos = samp ? (PAST + (row & 15)) : row;
                        const f32x4* cp = (const f32x4*)(rope + (size_t)pos * 16);
                        const f32x4 cs[2] = {cp[0], cp[1]}, sn[2] = {cp[2], cp[3]};
#pragma unroll
                        for (int bj = 0; bj < 2; ++bj)
#pragma unroll
                            for (int n = 0; n < 2; ++n)
#pragma unroll
                                for (int e = 0; e < 4; ++e) {
                                    const float x = v[bj][n][e], p = __shfl_xor(x, 16);
                                    const float sgn = (fq == 0) ? -sn[n][e] : sn[n][e];
                                    const float rot = x * cs[n][e] + p * sgn;
                                    v[bj][n][e] = (fq < 2) ? rot : x;
                                }
                    }
                    if (type == 0) {
#pragma unroll
                        for (int bj = 0; bj < 2; ++bj) {
                            u32x4 w; w.x = cvt_pk_bf16(v[bj][0][0] * C2, v[bj][0][1] * C2); w.y = cvt_pk_bf16(v[bj][0][2] * C2, v[bj][0][3] * C2);
                            w.z = cvt_pk_bf16(v[bj][1][0] * C2, v[bj][1][1] * C2); w.w = cvt_pk_bf16(v[bj][1][2] * C2, v[bj][1][3] * C2);
                            *(u32x4*)(Qb + (size_t)row * DM + col0 + bj * HALF) = w;
                        }
                    } else {
                        float* kp = kout + (size_t)row * DM;
#pragma unroll
                        for (int bj = 0; bj < 2; ++bj) {
                            if (samp) { *(f32x4*)(kp + col0 + bj * HALF) = v[bj][0]; *(f32x4*)(kp + col0 + bj * HALF + 4) = v[bj][1]; }
                            if (!samp) {
                                u32x4 w; w.x = cvt_pk_bf16(v[bj][0][0], v[bj][0][1]); w.y = cvt_pk_bf16(v[bj][0][2], v[bj][0][3]);
                                w.z = cvt_pk_bf16(v[bj][1][0], v[bj][1][1]); w.w = cvt_pk_bf16(v[bj][1][2], v[bj][1][3]);
                                *(u32x4*)(Kp + (size_t)row * DM + col0 + bj * HALF) = w;
                            }
                        }
                    }
                }
        } else if (type == 2) {
#pragma unroll
            for (int ai = 0; ai < 2; ++ai)
#pragma unroll
                for (int m = 0; m < 4; ++m) {
                    const int row = row0 + ai * HALF + m * 16;
                    float* vp = vout + (size_t)row * DM;
#pragma unroll
                    for (int bj = 0; bj < 2; ++bj) {
                        const f32x4 v0 = acc[ai][bj][m][0], v1 = acc[ai][bj][m][1];
                        if (samp) { *(f32x4*)(vp + col0 + bj * HALF) = v0; *(f32x4*)(vp + col0 + bj * HALF + 4) = v1; }
                        if (!samp) {
                            const int c8 = col0 + bj * HALF, hh = c8 >> 7, cc = c8 & 127;
                            bf16_t* vt = Vp + (((size_t)(hh * (SEQ / 64) + (row >> 6)) * 128 + cc) << 6) + (row & 63);
                            vt[0 * 64] = (bf16_t)(cvt_pk_bf16(v0[0], 0.f) & 0xffffu); vt[1 * 64] = (bf16_t)(cvt_pk_bf16(v0[1], 0.f) & 0xffffu);
                            vt[2 * 64] = (bf16_t)(cvt_pk_bf16(v0[2], 0.f) & 0xffffu); vt[3 * 64] = (bf16_t)(cvt_pk_bf16(v0[3], 0.f) & 0xffffu);
                            vt[4 * 64] = (bf16_t)(cvt_pk_bf16(v1[0], 0.f) & 0xffffu); vt[5 * 64] = (bf16_t)(cvt_pk_bf16(v1[1], 0.f) & 0xffffu);
                            vt[6 * 64] = (bf16_t)(cvt_pk_bf16(v1[2], 0.f) & 0xffffu); vt[7 * 64] = (bf16_t)(cvt_pk_bf16(v1[3], 0.f) & 0xffffu);
                        }
                    }
                }
        } else if (type <= 4) {
            bf16_t* O = (type == 3) ? Ub : GVb;
#pragma unroll
            for (int ai = 0; ai < 2; ++ai)
#pragma unroll
                for (int m = 0; m < 4; ++m) {
                    const int row = row0 + ai * HALF + m * 16; float s = 0.f;
#pragma unroll
                    for (int bj = 0; bj < 2; ++bj) {
                        f32x4 v0 = acc[ai][bj][m][0], v1 = acc[ai][bj][m][1];
#pragma unroll
                        for (int e = 0; e < 4; ++e) { v0[e] = geluf_(v0[e]); v1[e] = geluf_(v1[e]); }
                        s += (v0[0] * v0[0] + v0[1] * v0[1]) + (v0[2] * v0[2] + v0[3] * v0[3]) + (v1[0] * v1[0] + v1[1] * v1[1]) + (v1[2] * v1[2] + v1[3] * v1[3]);
                        u32x4 w; w.x = cvt_pk_bf16(v0[0], v0[1]); w.y = cvt_pk_bf16(v0[2], v0[3]); w.z = cvt_pk_bf16(v1[0], v1[1]); w.w = cvt_pk_bf16(v1[2], v1[3]);
                        *(u32x4*)(O + (size_t)row * DM + col0 + bj * HALF) = w;
                    }
                    if (type == 4) { s += __shfl_xor(s, 16); s += __shfl_xor(s, 32); if (fq == 0) SS[(size_t)row * 16 + (u.pn & 3) * 4 + wc] = s; }
                }
        } else {
            bf16_t* O = (type == 5) ? SGA : SGB;
#pragma unroll
            for (int ai = 0; ai < 2; ++ai)
#pragma unroll
                for (int m = 0; m < 4; ++m) {
                    const int row = row0 + ai * HALF + m * 16;
#pragma unroll
                    for (int bj = 0; bj < 2; ++bj) {
                        const f32x4 v0 = acc[ai][bj][m][0], v1 = acc[ai][bj][m][1];
#ifdef EXP_CONST
                        u32x4 w; w.x = 0x3f803f80u; w.y = 0x3f803f80u; w.z = 0x3f803f80u; w.w = 0x3f803f80u; (void)v0; (void)v1;
#else
                        u32x4 w; w.x = cvt_pk_bf16(sigmoidf_(v0[0]), sigmoidf_(v0[1])); w.y = cvt_pk_bf16(sigmoidf_(v0[2]), sigmoidf_(v0[3]));
                        w.z = cvt_pk_bf16(sigmoidf_(v1[0]), sigmoidf_(v1[1])); w.w = cvt_pk_bf16(sigmoidf_(v1[2]), sigmoidf_(v1[3]));
#endif
                        *(u32x4*)(O + (size_t)row * DM + col0 + bj * HALF) = w;
                    }
                }
        }
    }
};
struct EpiGateA {
    static constexpr bool PERM = false, DUAL = false;
    float* T1; const bf16_t* SG;
    __device__ __forceinline__ void operator()(const f32x4 (&acc)[2][2][4][2], const Unit& u, int wr, int wc, int fr, int fq) const {
        const int row0 = u.pm * BM + wr * 64 + fr, col0 = u.pn * BM + wc * 32 + 4 * fq;
#pragma unroll
        for (int ai = 0; ai < 2; ++ai)
#pragma unroll
            for (int m = 0; m < 4; ++m) {
                const size_t ro = (size_t)(row0 + ai * HALF + m * 16) * DM + col0;
#pragma unroll
                for (int bj = 0; bj < 2; ++bj)
#pragma unroll
                    for (int n = 0; n < 2; ++n) {
                        const u32x2 g = *(const u32x2*)(SG + ro + bj * HALF + n * 16); const f32x4 v = acc[ai][bj][m][n];
                        f32x4 o; o[0] = v[0] * bflo(g.x); o[1] = v[1] * bfhi(g.x); o[2] = v[2] * bflo(g.y); o[3] = v[3] * bfhi(g.y);
                        *(f32x4*)(T1 + ro + bj * HALF + n * 16) = o;
                    }
            }
    }
};
struct EpiGateB {
    static constexpr bool PERM = true, DUAL = false;
    const float* T1; const bf16_t* SG; bf16_t* O;
    __device__ __forceinline__ void operator()(const f32x4 (&acc)[2][2][4][2], const Unit& u, int wr, int wc, int fr, int fq) const {
        const int row0 = u.pm * BM + wr * 64 + fr, col0 = u.pn * BM + wc * 32 + 8 * fq;
#pragma unroll
        for (int ai = 0; ai < 2; ++ai)
#pragma unroll
            for (int m = 0; m < 4; ++m) {
                const size_t ro = (size_t)(row0 + ai * HALF + m * 16) * DM + col0;
#pragma unroll
                for (int bj = 0; bj < 2; ++bj) {
                    const u32x4 g = *(const u32x4*)(SG + ro + bj * HALF);
                    const f32x4 t0 = *(const f32x4*)(T1 + ro + bj * HALF), t1 = *(const f32x4*)(T1 + ro + bj * HALF + 4);
                    const f32x4 v0 = acc[ai][bj][m][0], v1 = acc[ai][bj][m][1];
                    u32x4 w;
#ifndef GATEB_MODE
#define GATEB_MODE 0
#endif
                    const float ka = (GATEB_MODE == 2) ? 0.f : 1.f, kb = (GATEB_MODE == 1) ? 0.f : 1.f;
                    w.x = cvt_pk_bf16(ka * t0[0] + kb * v0[0] * bflo(g.x), ka * t0[1] + kb * v0[1] * bfhi(g.x)); w.y = cvt_pk_bf16(ka * t0[2] + kb * v0[2] * bflo(g.y), ka * t0[3] + kb * v0[3] * bfhi(g.y));
                    w.z = cvt_pk_bf16(ka * t1[0] + kb * v1[0] * bflo(g.z), ka * t1[1] + kb * v1[1] * bfhi(g.z)); w.w = cvt_pk_bf16(ka * t1[2] + kb * v1[2] * bflo(g.w), ka * t1[3] + kb * v1[3] * bfhi(g.w));
                    *(u32x4*)(O + ro + bj * HALF) = w;
                }
            }
    }
};
struct EpiGateAB {
    static constexpr bool PERM = true, DUAL = true;
    const bf16_t* SGa; const bf16_t* SGb; bf16_t* O;
    __device__ __forceinline__ void operator()(f32x4 (&acc)[2][2][4][2], const Unit& u, int wr, int wc, int fr, int fq) const {
        const int row0 = u.pm * BM + wr * 64 + fr, col0 = u.pn * BM + wc * 32 + 8 * fq;
#pragma unroll
        for (int ai = 0; ai < 2; ++ai)
#pragma unroll
            for (int m = 0; m < 4; ++m) {
                const size_t ro = (size_t)(row0 + ai * HALF + m * 16) * DM + col0;
#pragma unroll
                for (int bj = 0; bj < 2; ++bj) {
                    const u32x4 gb = *(const u32x4*)(SGb + ro + bj * HALF);
                    f32x4& v0 = acc[ai][bj][m][0]; f32x4& v1 = acc[ai][bj][m][1];
                    if (u.w == 0) {
                        const u32x4 ga = *(const u32x4*)(SGa + ro + bj * HALF);
                        v0[0] *= bflo(ga.x) * __builtin_amdgcn_rcpf(bflo(gb.x)); v0[1] *= bfhi(ga.x) * __builtin_amdgcn_rcpf(bfhi(gb.x));
                        v0[2] *= bflo(ga.y) * __builtin_amdgcn_rcpf(bflo(gb.y)); v0[3] *= bfhi(ga.y) * __builtin_amdgcn_rcpf(bfhi(gb.y));
                        v1[0] *= bflo(ga.z) * __builtin_amdgcn_rcpf(bflo(gb.z)); v1[1] *= bfhi(ga.z) * __builtin_amdgcn_rcpf(bfhi(gb.z));
                        v1[2] *= bflo(ga.w) * __builtin_amdgcn_rcpf(bflo(gb.w)); v1[3] *= bfhi(ga.w) * __builtin_amdgcn_rcpf(bfhi(gb.w));
                    } else {
                        u32x4 w;
                        w.x = cvt_pk_bf16(v0[0] * bflo(gb.x), v0[1] * bfhi(gb.x)); w.y = cvt_pk_bf16(v0[2] * bflo(gb.y), v0[3] * bfhi(gb.y));
                        w.z = cvt_pk_bf16(v1[0] * bflo(gb.z), v1[1] * bfhi(gb.z)); w.w = cvt_pk_bf16(v1[2] * bflo(gb.w), v1[3] * bfhi(gb.w));
                        *(u32x4*)(O + ro + bj * HALF) = w;
                    }
                }
            }
    }
};
}

namespace att {
using bf16x8 = __attribute__((ext_vector_type(8))) short;
using s16x4 = __attribute__((ext_vector_type(4))) short;
using f32x16 = __attribute__((ext_vector_type(16))) float;
using f32x8 = __attribute__((ext_vector_type(8))) float;
using u32x4 = __attribute__((ext_vector_type(4))) unsigned;
constexpr int KVBLK = 64, LDR = 1024;
constexpr int SHM_V = KVBLK * 128 * 2, SHM_K = KVBLK * 128 * 2, SHM_ATTN = 3 * SHM_V + 3 * SHM_K + 8 * 64 * 4;
constexpr float THRL = 8.f;
#define KSWZ(row, colB) ((row) * 256 + ((colB) ^ (((row) & 15) << 4)))
#define SBAR() __builtin_amdgcn_sched_barrier(0)
__device__ __forceinline__ int crow(int r, int hi) { return (r & 3) + 8 * (r >> 2) + 4 * hi; }
__device__ __forceinline__ unsigned cvtpk(float lo, float hi) { return pg8::cvt_pk_bf16(lo, hi); }
__device__ __forceinline__ bf16x8 tobf(f32x8 x) { u32x4 w = {cvtpk(x[0], x[1]), cvtpk(x[2], x[3]), cvtpk(x[4], x[5]), cvtpk(x[6], x[7])}; return *reinterpret_cast<bf16x8*>(&w); }

__device__ __forceinline__ void partialSM(f32x16& p0, f32x16& p1, float& m_reg, float& alpha) {
    float m0 = fmaxf(fmaxf(p0[0], p0[1]), p0[2]), m1 = fmaxf(fmaxf(p0[3], p0[4]), p0[5]), m2 = fmaxf(fmaxf(p1[0], p1[1]), p1[2]), m3 = fmaxf(fmaxf(p1[3], p1[4]), p1[5]);
    m0 = fmaxf(fmaxf(m0, p0[6]), p0[7]); m1 = fmaxf(fmaxf(m1, p0[8]), p0[9]); m2 = fmaxf(fmaxf(m2, p1[6]), p1[7]); m3 = fmaxf(fmaxf(m3, p1[8]), p1[9]);
    m0 = fmaxf(fmaxf(m0, p0[10]), p0[11]); m1 = fmaxf(fmaxf(m1, p0[12]), p0[13]); m2 = fmaxf(fmaxf(m2, p1[10]), p1[11]); m3 = fmaxf(fmaxf(m3, p1[12]), p1[13]);
    m0 = fmaxf(fmaxf(m0, p0[14]), p0[15]); m2 = fmaxf(fmaxf(m2, p1[14]), p1[15]);
    float pmax = fmaxf(fmaxf(m0, m1), fmaxf(m2, m3));
    { auto rr = __builtin_amdgcn_permlane32_swap(__float_as_uint(pmax), __float_as_uint(pmax), false, false);
      pmax = fmaxf(__uint_as_float(rr[0]), __uint_as_float(rr[1])); }
    float mn;
    if (__builtin_expect(__all(pmax - m_reg <= THRL), 1)) { mn = m_reg; alpha = 1.f; }
    else { mn = fmaxf(m_reg, pmax); alpha = __builtin_amdgcn_exp2f(m_reg - mn); m_reg = mn; }
#pragma unroll
    for (int r = 0; r < 16; ++r) p0[r] = p0[r] - mn;
#pragma unroll
    for (int r = 0; r < 16; ++r) p1[r] = p1[r] - mn;
#pragma unroll
    for (int r = 0; r < 16; ++r) p0[r] = __builtin_amdgcn_exp2f(p0[r]);
}
__device__ __forceinline__ void finishSM(f32x16& p0, f32x16& p1, float alpha, float& l_reg, bf16x8& pa0, bf16x8& pa1, bf16x8& pa2, bf16x8& pa3) {
#pragma unroll
    for (int r = 0; r < 16; ++r) p1[r] = __builtin_amdgcn_exp2f(p1[r]);
    float s0 = p0[0] + p0[1], s1 = p0[2] + p0[3], s2 = p1[0] + p1[1], s3 = p1[2] + p1[3];
#pragma unroll
    for (int r = 4; r < 16; r += 2) { if (r & 2) { s1 += p0[r] + p0[r + 1]; s3 += p1[r] + p1[r + 1]; } else { s0 += p0[r] + p0[r + 1]; s2 += p1[r] + p1[r + 1]; } }
    float ps = (s0 + s1) + (s2 + s3);
    { auto rr = __builtin_amdgcn_permlane32_swap(__float_as_uint(ps), __float_as_uint(ps), false, false);
      ps = __uint_as_float(rr[0]) + __uint_as_float(rr[1]); }
    l_reg = l_reg * alpha + ps;
#define PK4(P, BASE, OUT) do { unsigned a0 = cvtpk(P[BASE + 0], P[BASE + 1]), a1 = cvtpk(P[BASE + 2], P[BASE + 3]);   \
    unsigned b0 = cvtpk(P[BASE + 4], P[BASE + 5]), b1 = cvtpk(P[BASE + 6], P[BASE + 7]);                              \
    auto r0 = __builtin_amdgcn_permlane32_swap(a0, b0, false, false); auto r1 = __builtin_amdgcn_permlane32_swap(a1, b1, false, false); \
    u32x4 w = {r0[0], r1[0], r0[1], r1[1]}; OUT = *reinterpret_cast<bf16x8*>(&w); } while (0)
    PK4(p0, 0, pa0); PK4(p0, 8, pa1); PK4(p1, 0, pa2); PK4(p1, 8, pa3);
#undef PK4
}
__device__ __forceinline__ void qkt(f32x16& p0, f32x16& p1, const char* Ks, const bf16x8* qr, int r32, int hi, int sub) {
    p0 = f32x16{}; p1 = f32x16{};
#pragma unroll
    for (int d0 = 0; d0 < 4; ++d0) { const int cb = (sub * 64 + d0 * 16 + hi * 8) * 2;
        const bf16x8 b0 = *reinterpret_cast<const bf16x8*>(Ks + KSWZ(r32, cb));
        const bf16x8 b1 = *reinterpret_cast<const bf16x8*>(Ks + KSWZ(32 + r32, cb));
        p0 = __builtin_amdgcn_mfma_f32_32x32x16_bf16(b0, qr[d0], p0, 0, 0, 0);
        p1 = __builtin_amdgcn_mfma_f32_32x32x16_bf16(b1, qr[d0], p1, 0, 0, 0); }
}
__device__ __forceinline__ int v_st(int k, int c) { const int kk = (k & ~0xC) | ((k & 4) << 1) | ((k & 8) >> 1); return ((kk >> 3) * 4 + (c >> 5)) * 512 + ((kk & 7) * 32 + (c & 31)) * 2; }
__device__ __forceinline__ int v_rd_base(int lane) { return ((lane & 3) << 3) | (((lane >> 2) & 3) << 6) | (((lane >> 4) & 1) << 5) | (((lane >> 5) & 1) << 8); }
constexpr int v_rd_off(int d0, int ks, int half) { return d0 * 512 + ks * 4096 + half * 2048; }
typedef short v4i16_t __attribute__((ext_vector_type(4)));
typedef __attribute__((address_space(3))) const char* lds_cptr;
template <int OFF> __device__ __forceinline__ s16x4 tr_read(lds_cptr vp) {
    return __builtin_bit_cast(s16x4, __builtin_amdgcn_ds_read_tr16_b64_v4i16((__attribute__((address_space(3))) v4i16_t*)(vp + OFF)));
}
template <int D0> __device__ __forceinline__ void pv_one(f32x16& od, lds_cptr vb, bf16x8 pa0, bf16x8 pa1, bf16x8 pa2, bf16x8 pa3) {
    const s16x4 l0 = tr_read<v_rd_off(D0, 0, 0)>(vb), h0 = tr_read<v_rd_off(D0, 0, 1)>(vb), l1 = tr_read<v_rd_off(D0, 1, 0)>(vb), h1 = tr_read<v_rd_off(D0, 1, 1)>(vb);
    const s16x4 l2 = tr_read<v_rd_off(D0, 2, 0)>(vb), h2 = tr_read<v_rd_off(D0, 2, 1)>(vb), l3 = tr_read<v_rd_off(D0, 3, 0)>(vb), h3 = tr_read<v_rd_off(D0, 3, 1)>(vb);
#define PK(L, H) (bf16x8){L[0], L[1], L[2], L[3], H[0], H[1], H[2], H[3]}
    od = __builtin_amdgcn_mfma_f32_32x32x16_bf16(pa0, PK(l0, h0), od, 0, 0, 0);
    od = __builtin_amdgcn_mfma_f32_32x32x16_bf16(pa1, PK(l1, h1), od, 0, 0, 0);
    od = __builtin_amdgcn_mfma_f32_32x32x16_bf16(pa2, PK(l2, h2), od, 0, 0, 0);
    od = __builtin_amdgcn_mfma_f32_32x32x16_bf16(pa3, PK(l3, h3), od, 0, 0, 0);
#undef PK
}
__device__ __forceinline__ void pv_t(f32x16* o, const char* vt, const int* ko, bf16x8 pa0, bf16x8 pa1, bf16x8 pa2, bf16x8 pa3) {
#pragma unroll
    for (int d0 = 0; d0 < 4; ++d0) {
        const bf16x8 b0 = *reinterpret_cast<const bf16x8*>(vt + d0 * 4096 + ko[0]), b1 = *reinterpret_cast<const bf16x8*>(vt + d0 * 4096 + ko[1]);
        const bf16x8 b2 = *reinterpret_cast<const bf16x8*>(vt + d0 * 4096 + ko[2]), b3 = *reinterpret_cast<const bf16x8*>(vt + d0 * 4096 + ko[3]);
        o[d0] = __builtin_amdgcn_mfma_f32_32x32x16_bf16(pa0, b0, o[d0], 0, 0, 0);
        o[d0] = __builtin_amdgcn_mfma_f32_32x32x16_bf16(pa1, b1, o[d0], 0, 0, 0);
        o[d0] = __builtin_amdgcn_mfma_f32_32x32x16_bf16(pa2, b2, o[d0], 0, 0, 0);
        o[d0] = __builtin_amdgcn_mfma_f32_32x32x16_bf16(pa3, b3, o[d0], 0, 0, 0);
    }
}
__device__ __forceinline__ void pv_d0(f32x16* o, lds_cptr vb, bf16x8 pa0, bf16x8 pa1, bf16x8 pa2, bf16x8 pa3) {
    pv_one<0>(o[0], vb, pa0, pa1, pa2, pa3); pv_one<1>(o[1], vb, pa0, pa1, pa2, pa3); pv_one<2>(o[2], vb, pa0, pa1, pa2, pa3); pv_one<3>(o[3], vb, pa0, pa1, pa2, pa3);
}

struct Args {
    const unsigned short* Qb; const unsigned short* Kp; const unsigned short* Vp;
    const float* cK; const float* cV;
    const float* nK; const float* nV;
    unsigned short* ATT; const float* gsub;
    const unsigned short* Qs; unsigned short* ATTs;
    float* kpo; float* vpo;
};

template <bool SAMPLE>
__device__ __forceinline__ void attn_unit(const Args& A, int h, int qi, char* lds, float lam) {
    asm volatile("" : "+s"(h), "+s"(qi));
    int tid = threadIdx.x; asm volatile("" : "+v"(tid));
    const int lane = tid & 63, r32 = lane & 31, hi = lane >> 5;
    const int wid = __builtin_amdgcn_readfirstlane(tid >> 6), sub = wid >> 2, rg = wid & 3;
    char* V_lds = lds; char* K_lds = lds + 2 * SHM_V;
    float* ws = (float*)(lds + 3 * SHM_V + 3 * SHM_K) + wid * 64; float* li_l = ws; float* al_l = ws + 32;
    const int NT = SAMPLE ? 33 : 2 * qi + 2;
    float m_reg = -1e30f, l_reg = 0; f32x16 o[4] = {}; bf16x8 qr[4];
    {
        const int qrow = SAMPLE ? (qi * 16 + (r32 & 15)) : (qi * 128 + rg * 32 + r32);
        const unsigned short* Qw = (SAMPLE ? A.Qs : A.Qb) + (size_t)qrow * LDR + h * 128 + sub * 64 + hi * 8;
#pragma unroll
        for (int d0 = 0; d0 < 4; ++d0) qr[d0] = *reinterpret_cast<const bf16x8*>(Qw + d0 * 16);
    }
    const int sr = tid >> 4, sc = (tid & 15) * 8;
    const int vcol0 = tid >> 3, vcol1 = 64 + (tid >> 3), vch = tid & 7;
    const int vst0 = SAMPLE ? v_st(sr, sc) : vcol0 * 128 + ((vch ^ ((vcol0 >> 1) & 7)) << 4), vst1 = SAMPLE ? v_st(32 + sr, sc) : vcol1 * 128 + ((vch ^ ((vcol1 >> 1) & 7)) << 4);
    const lds_cptr vb0 = (lds_cptr)V_lds + v_rd_base(lane);
    const char* vtb = V_lds + r32 * 128; int vko[4];
#pragma unroll
    for (int ks = 0; ks < 4; ++ks) vko[ks] = ((2 * ks + hi) ^ ((r32 >> 1) & 7)) << 4;
    constexpr int SDEPTH = SAMPLE ? 2 : 1;
    using ST = typename std::conditional<SAMPLE, f32x8, bf16x8>::type;
    struct { ST vs0, vs1, ks0, ks1; } sr_[SDEPTH];
    constexpr unsigned ESZ = SAMPLE ? 4u : 2u;
    const unsigned lo0 = (unsigned)(sr * LDR + sc) * ESZ, lo1 = lo0 + 32u * LDR * ESZ, lon = (unsigned)((sr & 15) * LDR + sc) * 4u;
    const __amdgpu_buffer_rsrc_t rK = __builtin_amdgcn_make_buffer_rsrc((void*)(SAMPLE ? (const void*)A.cK : (const void*)A.Kp), 0, SAMPLE ? 16 * PAST * LDR * 4 : SEQ * LDR * 2, 0x00020000);
    const __amdgpu_buffer_rsrc_t rV = __builtin_amdgcn_make_buffer_rsrc((void*)(SAMPLE ? (const void*)A.cV : (const void*)A.Vp), 0, SAMPLE ? 16 * PAST * LDR * 4 : SEQ * LDR * 2, 0x00020000);
    const __amdgpu_buffer_rsrc_t rKn = __builtin_amdgcn_make_buffer_rsrc((void*)A.nK, 0, 256 * LDR * 4, 0x00020000);
    const __amdgpu_buffer_rsrc_t rVn = __builtin_amdgcn_make_buffer_rsrc((void*)A.nV, 0, 256 * LDR * 4, 0x00020000);
    const unsigned sbase = SAMPLE ? (unsigned)((qi * PAST * LDR + h * 128) * 4) : (unsigned)(h * 256), sbn = (unsigned)((qi * 16 * LDR + h * 128) * 4);
    const unsigned vl0 = (unsigned)tid * 16u, vl1 = vl0 + 8192u, vsb = (unsigned)h * (unsigned)(SEQ / 64) * 16384u;
    auto cv = [](ST x) -> bf16x8 { if constexpr (SAMPLE) return tobf(x); else return x; };
    auto bld = [](__amdgpu_buffer_rsrc_t r, unsigned vo, unsigned so) -> ST {
        if constexpr (SAMPLE) { const u32x4 a = __builtin_amdgcn_raw_buffer_load_b128(r, vo, so, 0), b = __builtin_amdgcn_raw_buffer_load_b128(r, vo + 16u, so, 0);
            f32x8 o; o[0] = __uint_as_float(a[0]); o[1] = __uint_as_float(a[1]); o[2] = __uint_as_float(a[2]); o[3] = __uint_as_float(a[3]);
            o[4] = __uint_as_float(b[0]); o[5] = __uint_as_float(b[1]); o[6] = __uint_as_float(b[2]); o[7] = __uint_as_float(b[3]); return o; }
        else { const u32x4 a = __builtin_amdgcn_raw_buffer_load_b128(r, vo, so, 0); return __builtin_bit_cast(bf16x8, a); }
    };
#define SLOAD(i, t) do { if (SAMPLE && (t) >= 32) { \
        sr_[i].vs0 = bld(rVn, lon, sbn); sr_[i].vs1 = sr_[i].vs0; sr_[i].ks0 = bld(rKn, lon, sbn); sr_[i].ks1 = sr_[i].ks0; \
    } else { const unsigned so_ = sbase + (unsigned)(t) * (64u * LDR * ESZ); \
        if constexpr (SAMPLE) { sr_[i].vs0 = bld(rV, lo0, so_); sr_[i].vs1 = bld(rV, lo1, so_); } else { const unsigned sv_ = vsb + (unsigned)(t) * 16384u; sr_[i].vs0 = bld(rV, vl0, sv_); sr_[i].vs1 = bld(rV, vl1, sv_); } \
        sr_[i].ks0 = bld(rK, lo0, so_); sr_[i].ks1 = bld(rK, lo1, so_); } } while (0)
#define SWRITE(b, i) do { *(bf16x8*)(V_lds + (b) * SHM_V + vst0) = cv(sr_[i].vs0);          \
    *(bf16x8*)(V_lds + (b) * SHM_V + vst1) = cv(sr_[i].vs1); const int kc = sc * 2;               \
    *(bf16x8*)(K_lds + (b) * SHM_K + KSWZ(sr, kc)) = cv(sr_[i].ks0);                       \
    *(bf16x8*)(K_lds + (b) * SHM_K + KSWZ(32 + sr, kc)) = cv(sr_[i].ks1); } while (0)
#define SWAIT() do { if constexpr (SDEPTH == 2) asm volatile("s_waitcnt vmcnt(4)" ::: "memory"); else asm volatile("s_waitcnt vmcnt(0)" ::: "memory"); } while (0)
#define RESC(a) do { if (__any((a) < 1.f)) { if (hi == 0) al_l[r32] = (a); asm volatile("s_waitcnt lgkmcnt(0)" ::: "memory"); \
    _Pragma("unroll") for (int d = 0; d < 4; ++d) _Pragma("unroll") for (int r = 0; r < 16; ++r) o[d][r] *= al_l[crow(r, hi)]; } } while (0)
#define MASK(P0, P1, t) do { if constexpr (SAMPLE) { if ((t) >= 32) { _Pragma("unroll") for (int r = 0; r < 16; ++r) { if (crow(r, hi) >= 16) P0[r] = -INFINITY; P1[r] = -INFINITY; } } } \
    else { if ((t) == NT - 1 && rg < 2) { _Pragma("unroll") for (int r = 0; r < 16; ++r) { P0[r] = -INFINITY; P1[r] = -INFINITY; } } } } while (0)
    bf16x8 pa0, pa1, pa2, pa3;
    if constexpr (SAMPLE) {
        f32x16 pA0, pA1; float alA = 1.f;
        SLOAD(0, 0); SLOAD(1, 1);
#define STILE(t, SL) do { SWRITE(SL, SL); if ((t) + 2 < NT) SLOAD(SL, (t) + 2); __syncthreads(); \
            if (rg == 0) { SBAR(); qkt(pA0, pA1, K_lds + (SL) * SHM_K, qr, r32, hi, sub); MASK(pA0, pA1, t); partialSM(pA0, pA1, m_reg, alA); RESC(alA); \
                finishSM(pA0, pA1, alA, l_reg, pa0, pa1, pa2, pa3); SBAR(); pv_d0(o, vb0 + (SL) * SHM_V, pa0, pa1, pa2, pa3); } } while (0)
        for (int t = 0; t + 1 < NT; t += 2) { STILE(t, 0); STILE(t + 1, 1); }
        STILE(NT - 1, 0);
#undef STILE
        __syncthreads();
    } else {
    f32x16 S0, S1; float alpha = 1.f; bf16x8 kf[4], vf[8], pl, ph_, pbl, pbh;
    const int grp = sub;
    typedef __attribute__((address_space(3))) unsigned lds_u;
    char* Kr = lds + 3 * SHM_V;
    int so_p = 2 * SHM_K, so_c = 0, so_n = SHM_K;
    const int krow0 = 8 * wid + (lane >> 4), krow1 = krow0 + 4, vcl0 = 16 * wid + (lane >> 3), vcl1 = vcl0 + 8;
    const unsigned kdo0 = (unsigned)krow0 * (LDR * 2u) + (unsigned)(((lane & 15) ^ (krow0 & 15)) << 4), kdo1 = (unsigned)krow1 * (LDR * 2u) + (unsigned)(((lane & 15) ^ (krow1 & 15)) << 4);
    const unsigned vdo0 = (unsigned)vcl0 * 128u + (unsigned)(((lane & 7) ^ ((vcl0 >> 1) & 7)) << 4), vdo1 = (unsigned)vcl1 * 128u + (unsigned)(((lane & 7) ^ ((vcl1 >> 1) & 7)) << 4);
#define KDMA_(t, so) do { const unsigned s_ = sbase + (unsigned)(t) * (64u * LDR * 2u); \
        __builtin_amdgcn_raw_ptr_buffer_load_lds(rK, (lds_u*)(Kr + (so) + wid * 2048), 16, kdo0, s_, 0, 0); \
        __builtin_amdgcn_raw_ptr_buffer_load_lds(rK, (lds_u*)(Kr + (so) + wid * 2048 + 1024), 16, kdo1, s_, 0, 0); } while (0)
#define VDMA_(t, so) do { const unsigned s_ = vsb + (unsigned)(t) * 16384u; \
        __builtin_amdgcn_raw_ptr_buffer_load_lds(rV, (lds_u*)(V_lds + (so) + wid * 2048), 16, vdo0, s_, 0, 0); \
        __builtin_amdgcn_raw_ptr_buffer_load_lds(rV, (lds_u*)(V_lds + (so) + wid * 2048 + 1024), 16, vdo1, s_, 0, 0); } while (0)
#define DST_(t) do { if ((t) + 3 < NT) KDMA_((t) + 3, so_c); if ((t) + 2 < NT) VDMA_((t) + 2, so_p); } while (0)
#define WAITV_(t) do { if ((t) + 2 < NT) asm volatile("s_waitcnt vmcnt(4)" ::: "memory"); else asm volatile("s_waitcnt vmcnt(0)" ::: "memory"); } while (0)
#define ROT_() do { const int t_ = so_p; so_p = so_c; so_c = so_n; so_n = t_; } while (0)
#define MEET_() do { asm volatile("s_waitcnt lgkmcnt(0)" ::: "memory"); __builtin_amdgcn_s_barrier(); asm volatile("" ::: "memory"); } while (0)
#define LSEG(HAVE_K, KSO, KH, HAVE_V, VSO, VH, STG, WT) do { \
        if (HAVE_K) { const char* kb_ = Kr + (KSO); \
            _Pragma("unroll") for (int d0 = 0; d0 < 4; ++d0) kf[d0] = *reinterpret_cast<const bf16x8*>(kb_ + KSWZ(32 * (KH) + r32, (sub * 64 + d0 * 16 + hi * 8) * 2)); } \
        if (HAVE_V) { const char* vb_ = vtb + (VSO); \
            _Pragma("unroll") for (int d0 = 0; d0 < 4; ++d0) { vf[2 * d0] = *reinterpret_cast<const bf16x8*>(vb_ + d0 * 4096 + vko[2 * (VH)]); vf[2 * d0 + 1] = *reinterpret_cast<const bf16x8*>(vb_ + d0 * 4096 + vko[2 * (VH) + 1]); } } \
        STG; \
        if ((WT) >= 0 && grp == 1) WAITV_(WT); \
        MEET_(); } while (0)
#define MF_(acc, A_, B_) acc = __builtin_amdgcn_mfma_f32_32x32x16_bf16(A_, B_, acc, 0, 0, 0)
#define EX_(SC, i) SC[i] = __builtin_amdgcn_exp2f(SC[i])
#define PKH_(SC, B0, OUT) do { const unsigned a0_ = cvtpk(SC[B0 + 0], SC[B0 + 1]), a1_ = cvtpk(SC[B0 + 2], SC[B0 + 3]), b0_ = cvtpk(SC[B0 + 4], SC[B0 + 5]), b1_ = cvtpk(SC[B0 + 6], SC[B0 + 7]); \
        auto r0_ = __builtin_amdgcn_permlane32_swap(a0_, b0_, false, false); auto r1_ = __builtin_amdgcn_permlane32_swap(a1_, b1_, false, false); \
        u32x4 w_ = {r0_[0], r1_[0], r0_[1], r1_[1]}; OUT = *reinterpret_cast<bf16x8*>(&w_); } while (0)
#define GQ_(HAVE_QK, X) do { SBAR(); if (HAVE_QK) { X; } SBAR(); } while (0)
#define CSEG(HAVE_QK, HAVE_PV, HAVE_SM, FIRST, SC, SN, PRL, PRH, PWL, PWH, WT) do { \
        float s0_ = 0.f, s1_ = 0.f, s2_ = 0.f, s3_ = 0.f, pmax_ = pmx, dlt_ = 0.f, n0_ = 0.f, n1_ = 0.f, n2_ = 0.f, n3_ = 0.f; bool ok_ = true; \
        unsigned c0_ = 0, c1_ = 0, c2_ = 0, c3_ = 0, c4_ = 0, c5_ = 0, c6_ = 0, c7_ = 0; \
        __builtin_amdgcn_s_setprio(2); \
        GQ_(HAVE_QK, SN = __builtin_amdgcn_mfma_f32_32x32x16_bf16(kf[0], qr[0], negm, 0, 0, 0)); \
        if (HAVE_SM) { ok_ = (FIRST) ? false : (bool)__all(pmax_ <= THRL);        \
            if (__builtin_expect(!ok_, 0)) { { auto rr_ = __builtin_amdgcn_permlane32_swap(__float_as_uint(pmax_), __float_as_uint(pmax_), false, false); pmax_ = fmaxf(__uint_as_float(rr_[0]), __uint_as_float(rr_[1])); } \
                dlt_ = (FIRST) ? pmax_ : fmaxf(pmax_, 0.f); m_reg += dlt_; alpha = (FIRST) ? 1.f : __builtin_amdgcn_exp2f(-dlt_); l_reg *= alpha; \
                _Pragma("unroll") for (int r = 0; r < 16; ++r) SC[r] -= dlt_; } \
            EX_(SC, 0); EX_(SC, 1); } \
        GQ_(HAVE_QK, MF_(SN, kf[1], qr[1])); if (HAVE_SM) { EX_(SC, 2); EX_(SC, 3); EX_(SC, 4); } \
        GQ_(HAVE_QK, MF_(SN, kf[2], qr[2])); if (HAVE_SM) { EX_(SC, 5); EX_(SC, 6); EX_(SC, 7); } \
        GQ_(HAVE_QK, MF_(SN, kf[3], qr[3])); if (HAVE_SM) { EX_(SC, 8); EX_(SC, 9); EX_(SC, 10); } \
        GQ_(HAVE_PV, MF_(o[0], PRL, vf[0])); if (HAVE_SM) { EX_(SC, 11); EX_(SC, 12); EX_(SC, 13); } \
        GQ_(HAVE_PV, MF_(o[0], PRH, vf[1])); if (HAVE_SM) { EX_(SC, 14); EX_(SC, 15); c0_ = cvtpk(SC[0], SC[1]); c1_ = cvtpk(SC[2], SC[3]); } \
        GQ_(HAVE_PV, MF_(o[1], PRL, vf[2])); if (HAVE_SM) { c2_ = cvtpk(SC[4], SC[5]); c3_ = cvtpk(SC[6], SC[7]); \
            auto r0_ = __builtin_amdgcn_permlane32_swap(c0_, c2_, false, false); auto r1_ = __builtin_amdgcn_permlane32_swap(c1_, c3_, false, false); \
            u32x4 w_ = {r0_[0], r1_[0], r0_[1], r1_[1]}; PWL = *reinterpret_cast<bf16x8*>(&w_); } \
        if (HAVE_QK) { n0_ = fmaxf(fmaxf(SN[0], SN[1]), SN[2]); n1_ = fmaxf(fmaxf(SN[3], SN[4]), SN[5]); }        \
        GQ_(HAVE_PV, MF_(o[1], PRH, vf[3])); if (HAVE_SM) { c4_ = cvtpk(SC[8], SC[9]); c5_ = cvtpk(SC[10], SC[11]); c6_ = cvtpk(SC[12], SC[13]); c7_ = cvtpk(SC[14], SC[15]); } \
        if (HAVE_QK) { n2_ = fmaxf(fmaxf(SN[6], SN[7]), SN[8]); n3_ = fmaxf(fmaxf(SN[9], SN[10]), SN[11]); } \
        GQ_(HAVE_PV, MF_(o[2], PRL, vf[4])); if (HAVE_SM) { auto r0_ = __builtin_amdgcn_permlane32_swap(c4_, c6_, false, false); auto r1_ = __builtin_amdgcn_permlane32_swap(c5_, c7_, false, false); \
            u32x4 w_ = {r0_[0], r1_[0], r0_[1], r1_[1]}; PWH = *reinterpret_cast<bf16x8*>(&w_); } \
        if (HAVE_QK) { const float n4_ = fmaxf(fmaxf(SN[12], SN[13]), SN[14]); n0_ = fmaxf(fmaxf(n0_, n1_), n2_); n3_ = fmaxf(fmaxf(n3_, n4_), SN[15]); } \
        GQ_(HAVE_PV, MF_(o[2], PRH, vf[5])); if (HAVE_QK) pmx = fmaxf(n0_, n3_); \
        if (HAVE_SM) { s0_ = SC[0] + SC[1]; s1_ = SC[2] + SC[3]; s2_ = SC[4] + SC[5]; s3_ = SC[6] + SC[7]; s0_ += SC[8]; s1_ += SC[9]; s2_ += SC[10]; s3_ += SC[11]; \
            s0_ += SC[12]; s1_ += SC[13]; s2_ += SC[14]; s3_ += SC[15]; s0_ += s1_; s2_ += s3_; s0_ += s2_; l_reg += s0_; }    \
        GQ_(HAVE_PV, MF_(o[3], PRL, vf[6])); \
        GQ_(HAVE_PV, MF_(o[3], PRH, vf[7])); \
        SBAR(); \
        if (HAVE_SM) { if (__builtin_expect(!ok_, 0)) { if (!(FIRST)) RESC(alpha); \
            if (HAVE_QK) { _Pragma("unroll") for (int r = 0; r < 16; ++r) SN[r] -= dlt_; pmx -= dlt_; } \
            _Pragma("unroll") for (int r = 0; r < 16; ++r) negm[r] = -m_reg; } } \
        __builtin_amdgcn_s_setprio(0); if ((WT) >= 0 && grp == 0) WAITV_(WT); MEET_(); } while (0)
    float pmx = 0.f;
    f32x16 negm = {}; m_reg = 0.f;
    KDMA_(0, 0); VDMA_(0, 0); KDMA_(1, SHM_K); VDMA_(1, SHM_V); if (2 < NT) KDMA_(2, 2 * SHM_K);
    asm volatile("s_waitcnt vmcnt(0)" ::: "memory");
    MEET_();
    if (grp == 1) MEET_();
    LSEG(true, 0, 0, false, 0, 0, (void)0, -1);             CSEG(true, false, false, false, S1, S0, pbl, pbh, pl, ph_, -1);
    LSEG(true, so_c, 1, false, 0, 0, (void)0, 0);           CSEG(true, false, true, true, S0, S1, pbl, pbh, pl, ph_, 0);
    LSEG(true, so_n, 0, true, so_c, 0, DST_(0), -1);        CSEG(true, true, true, false, S1, S0, pl, ph_, pbl, pbh, -1);
    ROT_();
#pragma clang loop unroll(disable)
    for (int t = 1; t < NT - 1; ++t) {
        LSEG(true, so_c, 1, true, so_p, 1, (void)0, t);     CSEG(true, true, true, false, S0, S1, pbl, pbh, pl, ph_, t);
        LSEG(true, so_n, 0, true, so_c, 0, DST_(t), -1);    CSEG(true, true, true, false, S1, S0, pl, ph_, pbl, pbh, -1);
        ROT_();
    }
    if (rg < 2) {
        LSEG(false, 0, 0, true, so_p, 1, (void)0, NT - 1);  CSEG(false, true, false, false, S0, S1, pbl, pbh, pl, ph_, NT - 1);
        LSEG(false, 0, 0, false, 0, 0, (void)0, -1);        CSEG(false, false, false, false, S0, S1, pbl, pbh, pl, ph_, -1);
        LSEG(false, 0, 0, false, 0, 0, (void)0, -1);        CSEG(false, false, false, false, S0, S1, pbl, pbh, pl, ph_, -1);
    } else {
        LSEG(true, so_c, 1, true, so_p, 1, (void)0, NT - 1); CSEG(true, true, true, false, S0, S1, pbl, pbh, pl, ph_, NT - 1);
        LSEG(false, 0, 0, true, so_c, 0, (void)0, -1);       CSEG(false, true, true, false, S1, S0, pl, ph_, pbl, pbh, -1);
        LSEG(false, 0, 0, true, so_c, 1, (void)0, -1);       CSEG(false, true, false, false, S0, S1, pbl, pbh, pl, ph_, -1);
    }
    if (grp == 0) MEET_();
    { auto rr_ = __builtin_amdgcn_permlane32_swap(__float_as_uint(l_reg), __float_as_uint(l_reg), false, false); l_reg = __uint_as_float(rr_[0]) + __uint_as_float(rr_[1]); }
#undef KDMA_
#undef VDMA_
#undef DST_
#undef WAITV_
#undef ROT_
#undef MEET_
#undef GQ_
#undef MF_
#undef EX_
#undef PKH_
#undef LSEG
#undef CSEG
    }
#undef SLOAD
#undef SWRITE
#undef SWAIT
#undef RESC
#undef MASK
    if (hi == 0) li_l[r32] = l_reg;
    asm volatile("s_waitcnt lgkmcnt(0)" ::: "memory");
    __syncthreads();
    float* X = (float*)lds;
    if (sub == 1 && (!SAMPLE || rg == 0)) {
#pragma unroll
        for (int r = 0; r < 16; ++r) { const float rl = __builtin_amdgcn_rcpf(li_l[crow(r, hi)]);
#pragma unroll
            for (int d0 = 0; d0 < 4; ++d0) X[((rg * 4 + d0) * 16 + r) * 64 + lane] = o[d0][r] * rl; }
    }
    __syncthreads();
    if (sub == 0 && (!SAMPLE || rg == 0)) {
        float gs[4];
#pragma unroll
        for (int d0 = 0; d0 < 4; ++d0) gs[d0] = A.gsub[d0 * 32 + r32];
#pragma unroll
        for (int r = 0; r < 16; ++r) {
            const int cr = crow(r, hi);
            const float rl = __builtin_amdgcn_rcpf(li_l[cr]);
            float d[4]; float v = 0.f;
#pragma unroll
            for (int d0 = 0; d0 < 4; ++d0) { d[d0] = o[d0][r] * rl - lam * X[((rg * 4 + d0) * 16 + r) * 64 + lane]; v += d[d0] * d[d0]; }
            v += __shfl_xor(v, 1); v += __shfl_xor(v, 2); v += __shfl_xor(v, 4); v += __shfl_xor(v, 8); v += __shfl_xor(v, 16);
            const float sc_ = (1.0f - LAM_INIT) / sqrtf(v * (1.0f / 128.0f) + EPS);
            const bool ok = SAMPLE ? (cr < 16) : true;
            const int orow = SAMPLE ? (qi * 16 + cr) : (qi * 128 + rg * 32 + cr);
            if (ok) {
                unsigned short* op = (SAMPLE ? A.ATTs : A.ATT) + (size_t)orow * LDR + h * 128 + r32;
#pragma unroll
                for (int d0 = 0; d0 < 4; ++d0) op[d0 * 32] = (unsigned short)f2bf(d[d0] * sc_ * gs[d0]);
            }
        }
    }
    if constexpr (!SAMPLE) {
    {
        const int kr_ = tid >> 2, kc_ = (tid & 3) * 32;
        const unsigned short* ks_ = A.Kp + (size_t)(qi * 128 + kr_) * LDR + h * 128 + kc_;
        float* kd_ = A.kpo + (size_t)(qi * 128 + kr_) * LDR + h * 128 + kc_;
#pragma unroll
        for (int i = 0; i < 4; ++i) { const u32x4 w = *(const u32x4*)(ks_ + 8 * i);
            f32x4 a, b; a[0] = __uint_as_float(w[0] << 16); a[1] = __uint_as_float(w[0] & 0xffff0000u); a[2] = __uint_as_float(w[1] << 16); a[3] = __uint_as_float(w[1] & 0xffff0000u);
            b[0] = __uint_as_float(w[2] << 16); b[1] = __uint_as_float(w[2] & 0xffff0000u); b[2] = __uint_as_float(w[3] << 16); b[3] = __uint_as_float(w[3] & 0xffff0000u);
            *(f32x4*)(kd_ + 8 * i) = a; *(f32x4*)(kd_ + 8 * i + 4) = b; }
        const int vt_ = 2 * qi + (wid >> 2);
        const unsigned short* vs_ = A.Vp + ((size_t)(h * (SEQ / 64) + vt_) * 128) * 64;
        float* vd_ = A.vpo + (size_t)(vt_ * 64) * LDR + h * 128;
#pragma unroll
        for (int cc = 0; cc < 2; ++cc) {
            const int col = lane + 64 * cc;
#pragma unroll
            for (int ch = 0; ch < 2; ++ch) { const int k0 = (2 * (wid & 3) + ch) * 8;
                const u32x4 w = *(const u32x4*)(vs_ + (size_t)col * 64 + k0);
#pragma unroll
                for (int e = 0; e < 4; ++e) { vd_[(size_t)(k0 + 2 * e) * LDR + col] = __uint_as_float(w[e] << 16); vd_[(size_t)(k0 + 2 * e + 1) * LDR + col] = __uint_as_float(w[e] & 0xffff0000u); } }
        }
    }
    }
    __syncthreads();
}
#undef KSWZ

struct SpArgs { const unsigned short* Ub; const unsigned short* GVb; const float* SS; const float* gsgu; const float* wsp; const float* bsp; unsigned short* SGU; float* gsout;
                const unsigned short* Us; const unsigned short* GVs; const float* SSs; unsigned short* SGUs; };
__device__ __forceinline__ void spatial_unit(const SpArgs& A, bool sample, int c, int g, char* lds) {
    asm volatile("" : "+s"(c), "+s"(g));
    int tid = threadIdx.x; asm volatile("" : "+v"(tid));
    const int lane = tid & 63, r32 = lane & 31, hi = lane >> 5;
    const int wid = __builtin_amdgcn_readfirstlane(tid >> 6);
    const int R0 = sample ? (16 * c) : (128 * c), nrows = sample ? 16 : 128;
    const unsigned short* Ubp = sample ? A.Us : A.Ub; const unsigned short* GVp = sample ? A.GVs : A.GVb; const float* SSp = sample ? A.SSs : A.SS; unsigned short* SGUp = sample ? A.SGUs : A.SGU;
    float* rs_l = (float*)lds;
    if (tid < nrows) {
        const f32x4* sp = (const f32x4*)(SSp + (size_t)(R0 + tid) * 16);
        const f32x4 a = sp[0], b = sp[1], cc = sp[2], d = sp[3];
        const float s = ((a[0] + a[1]) + (a[2] + a[3])) + ((b[0] + b[1]) + (b[2] + b[3])) + ((cc[0] + cc[1]) + (cc[2] + cc[3])) + ((d[0] + d[1]) + (d[2] + d[3]));
        rs_l[tid] = 1.0f / sqrtf(s * (1.0f / 1024.0f) + EPS);
    }
    __syncthreads();
    const int ch = g * 256 + wid * 32 + r32;
    const float gch = A.gsgu[ch];
    const int nks = sample ? 1 : 8, nrb = sample ? 1 : 4;
    bf16x8 bfr[8];
#pragma unroll
    for (int ks = 0; ks < 8; ++ks) {
        if (ks < nks) {
            float vv[8];
#pragma unroll
            for (int jj = 0; jj < 8; ++jj) {
                const int j = 16 * ks + 8 * hi + jj;
                vv[jj] = bf2f(GVp[(size_t)(R0 + j) * LDR + ch]) * rs_l[j] * gch;
                if (sample) A.gsout[(size_t)(16 * c + j) * LDR + ch] = vv[jj];
            }
            u32x4 w = {cvtpk(vv[0], vv[1]), cvtpk(vv[2], vv[3]), cvtpk(vv[4], vv[5]), cvtpk(vv[6], vv[7])};
            bfr[ks] = *reinterpret_cast<bf16x8*>(&w);
        } else bfr[ks] = bf16x8{};
    }
    const float* Wg = A.wsp + (size_t)g * 128 * 128;
#pragma unroll 1
    for (int rb = 0; rb < nrb; ++rb) {
        {
            f32x16 acc = {};
            const int i = 32 * rb + r32;
#pragma unroll
            for (int ks = 0; ks < 8; ++ks) {
                if (ks < nks && 16 * ks <= 32 * rb + 31) {
                    const int j0 = 16 * ks + 8 * hi;
                    const f32x4 w0 = *(const f32x4*)(Wg + (size_t)i * 128 + j0), w1 = *(const f32x4*)(Wg + (size_t)i * 128 + j0 + 4);
                    float wv[8] = {w0[0], w0[1], w0[2], w0[3], w1[0], w1[1], w1[2], w1[3]};
#pragma unroll
                    for (int jj = 0; jj < 8; ++jj) if (j0 + jj > i) wv[jj] = 0.f;
                    u32x4 w = {cvtpk(wv[0], wv[1]), cvtpk(wv[2], wv[3]), cvtpk(wv[4], wv[5]), cvtpk(wv[6], wv[7])};
                    acc = __builtin_amdgcn_mfma_f32_32x32x16_bf16(*reinterpret_cast<bf16x8*>(&w), bfr[ks], acc, 0, 0, 0);
                }
            }
#pragma unroll
            for (int r = 0; r < 16; ++r) {
                const int io = 32 * rb + crow(r, hi);
                if (io < nrows) {
                    const float uv = bf2f(Ubp[(size_t)(R0 + io) * LDR + ch]);
                    SGUp[(size_t)(R0 + io) * LDR + ch] = (unsigned short)f2bf(uv * (acc[r] + A.bsp[g * 128 + io]));
                }
            }
        }
    }
    __syncthreads();
}
__device__ __forceinline__ void spatial_unit_prompt(const SpArgs& A, int c, int g, char* lds) {
    asm volatile("" : "+s"(c), "+s"(g));
    int tid = threadIdx.x; asm volatile("" : "+v"(tid));
    const int lane = tid & 63, r32 = lane & 31, hi = lane >> 5;
    const int wid = __builtin_amdgcn_readfirstlane(tid >> 6);
    constexpr int GST = 528, WST = 272;
    char* Gt = lds; char* Wt = lds + 128 * GST; float* rs_l = (float*)(lds + 128 * GST + 128 * WST);
    const int R0 = 128 * c;
    u32x4 gv[8];
#pragma unroll
    for (int i = 0; i < 8; ++i) { const int q = tid + 512 * i, row = q >> 5, cc = q & 31;
        gv[i] = *(const u32x4*)(A.GVb + (size_t)(R0 + row) * LDR + g * 256 + cc * 8); }
    const int wi = tid >> 2, wj = (tid & 3) * 32;
    f32x4 wv[8];
#pragma unroll
    for (int i = 0; i < 8; ++i) wv[i] = *(const f32x4*)(A.wsp + (size_t)g * 128 * 128 + (size_t)wi * 128 + wj + 4 * i);
    if (tid < 128) {
        const f32x4* sp = (const f32x4*)(A.SS + (size_t)(R0 + tid) * 16);
        const f32x4 a = sp[0], b = sp[1], cc = sp[2], d = sp[3];
        const float s = ((a[0] + a[1]) + (a[2] + a[3])) + ((b[0] + b[1]) + (b[2] + b[3])) + ((cc[0] + cc[1]) + (cc[2] + cc[3])) + ((d[0] + d[1]) + (d[2] + d[3]));
        rs_l[tid] = 1.0f / sqrtf(s * (1.0f / 1024.0f) + EPS);
    }
#pragma unroll
    for (int i = 0; i < 8; ++i) { const int q = tid + 512 * i, row = q >> 5, cc = q & 31; *(u32x4*)(Gt + row * GST + cc * 16) = gv[i]; }
    __syncthreads();
#pragma unroll
    for (int i = 0; i < 4; ++i) {
        const f32x4 r0 = *(const f32x4*)(rs_l + wj + 8 * i), r1 = *(const f32x4*)(rs_l + wj + 8 * i + 4);
        float t[8];
#pragma unroll
        for (int e = 0; e < 4; ++e) { t[e] = (wj + 8 * i + e <= wi) ? wv[2 * i][e] * r0[e] : 0.f; t[4 + e] = (wj + 8 * i + 4 + e <= wi) ? wv[2 * i + 1][e] * r1[e] : 0.f; }
        u32x4 w = {cvtpk(t[0], t[1]), cvtpk(t[2], t[3]), cvtpk(t[4], t[5]), cvtpk(t[6], t[7])};
        *(u32x4*)(Wt + wi * WST + (wj + 8 * i) * 2) = w;
    }
    __syncthreads();
    u32x4 uu[8];
#pragma unroll
    for (int i = 0; i < 8; ++i) { const int q = tid + 512 * i, row = q >> 5, cc = q & 31;
        uu[i] = *(const u32x4*)(A.Ub + (size_t)(R0 + row) * LDR + g * 256 + cc * 8); }
    const int ccol = wid * 32 + r32, ch = g * 256 + ccol;
    const float gch = A.gsgu[ch];
    bf16x8 bfr[8];
#pragma unroll
    for (int ks = 0; ks < 8; ++ks) {
        unsigned p[4];
#pragma unroll
        for (int e = 0; e < 4; ++e) { const int j = 16 * ks + 8 * hi + 2 * e;
            const unsigned lo = *(const unsigned short*)(Gt + j * GST + ccol * 2), hi16 = *(const unsigned short*)(Gt + (j + 1) * GST + ccol * 2);
            p[e] = lo | (hi16 << 16); }
        u32x4 w = {p[0], p[1], p[2], p[3]};
        bfr[ks] = *reinterpret_cast<bf16x8*>(&w);
    }
    asm volatile("s_waitcnt lgkmcnt(0)" ::: "memory");
#pragma unroll
    for (int rb = 0; rb < 4; ++rb) {
        f32x16 acc = {};
#pragma unroll
        for (int ks = 0; ks < 8; ++ks) {
            if (ks <= 2 * rb + 1) {
                const bf16x8 af = *(const bf16x8*)(Wt + (32 * rb + r32) * WST + (16 * ks + 8 * hi) * 2);
                acc = __builtin_amdgcn_mfma_f32_32x32x16_bf16(af, bfr[ks], acc, 0, 0, 0);
            }
        }
#pragma unroll
        for (int r = 0; r < 16; ++r) { const int io = 32 * rb + crow(r, hi);
            *(unsigned short*)(Gt + io * GST + ccol * 2) = (unsigned short)f2bf(acc[r] * gch + A.bsp[g * 128 + io]); }
    }
    __syncthreads();
#pragma unroll
    for (int i = 0; i < 8; ++i) { const int q = tid + 512 * i, row = q >> 5, cc = q & 31;
        const u32x4 rv = *(const u32x4*)(Gt + row * GST + cc * 16);
        u32x4 ov;
#pragma unroll
        for (int e = 0; e < 4; ++e) { const float a0 = __builtin_bit_cast(float, rv[e] << 16) * __builtin_bit_cast(float, uu[i][e] << 16), a1 = __builtin_bit_cast(float, rv[e] & 0xffff0000u) * __builtin_bit_cast(float, uu[i][e] & 0xffff0000u);
            ov[e] = cvtpk(a0, a1); }
        *(u32x4*)(A.SGU + (size_t)(R0 + row) * LDR + g * 256 + cc * 8) = ov; }
    __syncthreads();
}
#undef SBAR
}

struct KArgs {
    const float* in[26]; float* out; unsigned char* ws;
};

struct Frame {
    LAS unsigned char* lds; int tid, lane, wave, G, gw, NGW;
};

__device__ __forceinline__ void p0_transpose_item(const float* W, int K, int N, bf16* WT, int mode, LAS float* scr, int item, int lane, int ldw = 0) {
    if (ldw == 0) ldw = K;
    const int nblk = N / 32, kb = item / nblk, nb = item % nblk, k0 = 64 * kb, n0 = 32 * nb;
    int d0 = n0;
    if (mode == 1) { const int half = N / 2; const int nn = (n0 < half) ? n0 : n0 - half; d0 = (nn >> 7) * 256 + (nn & 127) + ((n0 < half) ? 0 : 128); }
#pragma unroll
    for (int i = 0; i < 32; ++i) { const int kk = 2 * i + (lane >> 5); scr[kk * 33 + (lane & 31)] = W[(size_t)(k0 + kk) * N + n0 + (lane & 31)]; }
    LDS_WAIT(); asm volatile("" ::: "memory");
    const int c = lane & 7;
#pragma unroll
    for (int j = 0; j < 4; ++j) { const int n = (lane >> 3) + 8 * j; const LAS float* s = scr + (8 * c) * 33 + n;
        v4u o; o.x = pk2(s[0 * 33], s[1 * 33]); o.y = pk2(s[2 * 33], s[3 * 33]); o.z = pk2(s[4 * 33], s[5 * 33]); o.w = pk2(s[6 * 33], s[7 * 33]);
        *(v4u*)(WT + (size_t)(d0 + n) * ldw + k0 + 8 * c) = o; }
    LDS_WAIT(); asm volatile("" ::: "memory");
}

__device__ __forceinline__ const float* xrow_ptr(const float* xp, const float* xs, int m) { return (m < SEQ) ? xp + (size_t)m * DM : xs + (size_t)(m - SEQ) * DM; }

template <bool BIN, bool BOUT>
__device__ __forceinline__ void row_phase(const Frame& F, int m0, int mstep, int mend, const bf16* Fb, const float* SS, const void* base0, float scale,
                                          const float* gpost, void* Hout, const float* gnext, bf16* XN) {
    for (int m = m0; m < mend; m += 2 * mstep) {
        const bool two = (m + mstep < mend); const int mb = two ? m + mstep : m;
        const v2u* fa_ = (const v2u*)(Fb + (size_t)m * DM) + F.lane; const v2u* fb_ = (const v2u*)(Fb + (size_t)mb * DM) + F.lane;
        const f32x4* gp = (const f32x4*)gpost + F.lane;
        v2u fwa[4], fwb[4]; f32x4 bva[4], bvb[4], g[4];
        float ssa = SS[(size_t)m * 16 + (F.lane & 15)], ssb = SS[(size_t)mb * 16 + (F.lane & 15)];
#pragma unroll
        for (int j = 0; j < 4; ++j) { fwa[j] = fa_[64 * j]; fwb[j] = fb_[64 * j]; g[j] = gp[64 * j];
            if constexpr (BIN) { const v2u wa = ((const v2u*)((const bf16*)base0 + (size_t)m * DM) + F.lane)[64 * j], wb = ((const v2u*)((const bf16*)base0 + (size_t)mb * DM) + F.lane)[64 * j];
                bva[j] = (f32x4){bflo(wa.x), bfhi(wa.x), bflo(wa.y), bfhi(wa.y)}; bvb[j] = (f32x4){bflo(wb.x), bfhi(wb.x), bflo(wb.y), bfhi(wb.y)}; }
            else { bva[j] = ((const f32x4*)((const float*)base0 + (size_t)m * DM) + F.lane)[64 * j]; bvb[j] = ((const f32x4*)((const float*)base0 + (size_t)mb * DM) + F.lane)[64 * j]; } }
#pragma unroll
        for (int half = 0; half < 2; ++half) {
            if (half == 1 && !two) break;
            const int mm = half ? mb : m;
            float ss = half ? ssb : ssa;
            ss += __shfl_xor(ss, 1); ss += __shfl_xor(ss, 2); ss += __shfl_xor(ss, 4); ss += __shfl_xor(ss, 8);
            const float rs = 1.0f / sqrtf(ss * (1.0f / DM) + EPS);
            f32x4 hv[4]; float s2 = 0.f;
#pragma unroll
            for (int j = 0; j < 4; ++j) { const v2u fw = half ? fwb[j] : fwa[j]; const f32x4 f = {bflo(fw.x), bfhi(fw.x), bflo(fw.y), bfhi(fw.y)}; const f32x4 b = half ? bvb[j] : bva[j];
                hv[j] = b + (f * g[j]) * (rs * scale);
                s2 += (hv[j][0] * hv[j][0] + hv[j][1] * hv[j][1]) + (hv[j][2] * hv[j][2] + hv[j][3] * hv[j][3]); }
            if (Hout) {
                if constexpr (BOUT) { v2u* ho = (v2u*)((bf16*)Hout + (size_t)mm * DM) + F.lane;
#pragma unroll
                    for (int j = 0; j < 4; ++j) ho[64 * j] = (v2u){pk2(hv[j][0], hv[j][1]), pk2(hv[j][2], hv[j][3])}; }
                else { f32x4* ho = (f32x4*)((float*)Hout + (size_t)mm * DM) + F.lane;
#pragma unroll
                    for (int j = 0; j < 4; ++j) ho[64 * j] = hv[j]; }
            }
            if (gnext) {
                const float rs2 = 1.0f / sqrtf(wave_sum(s2) * (1.0f / DM) + EPS);
                const f32x4* gn = (const f32x4*)gnext + F.lane;
                unsigned long long* o8 = (unsigned long long*)(XN + (size_t)mm * DM) + F.lane;
#pragma unroll
                for (int j = 0; j < 4; ++j) { const f32x4 gq = gn[64 * j]; const f32x4 v = hv[j] * gq * rs2;
                    o8[64 * j] = (unsigned long long)pk2(v[0], v[1]) | ((unsigned long long)pk2(v[2], v[3]) << 32); }
            }
        }
    }
}


#define XB_TMO      128
#define XB_XCNT(j)  (256  + 64 * (j))
#define XB_XSUB(j)  (1280 + 64 * (j))
#define XB_XGEN(j)  (2304 + 64 * (j))
#define XB_TOP      3328
#define XB_TOPGEN   3392
#define XCD_BAR_WORDS 3456
#define XB_SPIN_CAP (1u << 20)
__device__ __forceinline__ unsigned xb_ld(unsigned* p)              { return __hip_atomic_load(p, __ATOMIC_RELAXED, __HIP_MEMORY_SCOPE_AGENT); }
__device__ __forceinline__ unsigned xb_add(unsigned* p, unsigned v) { return __hip_atomic_fetch_add(p, v, __ATOMIC_RELAXED, __HIP_MEMORY_SCOPE_AGENT); }
__device__ __forceinline__ unsigned xb_xcc_id() { return (unsigned)__builtin_amdgcn_s_getreg((3 << 11) | 20) & 0xFu; }
#define XB_SPIN(cond, bar) do { unsigned _sp = 0; while (cond) { __builtin_amdgcn_s_sleep(1); \
    if ((++_sp & 255u) == 0u) { if (xb_ld(&(bar)[XB_TMO])) break; if (_sp > XB_SPIN_CAP) { atomicAdd(&(bar)[XB_TMO], 1u); break; } } } } while (0)
struct XcdBarrier { unsigned* bar; unsigned x; volatile LAS unsigned* st; };
__device__ __forceinline__ XcdBarrier xcd_barrier_post(unsigned* bar, volatile LAS unsigned* st) {
    XcdBarrier b; b.bar = bar; b.x = xb_xcc_id(); b.st = st;
    if (threadIdx.x == 0) (void)xb_add(&bar[XB_XCNT(b.x)], 1u);
    return b;
}
__device__ __forceinline__ void xcd_barrier_complete(unsigned* bar, unsigned x, unsigned& nloc, unsigned& nx) {
    const unsigned G = gridDim.x * gridDim.y * gridDim.z;
    unsigned sum, cnt, mine, sp = 0u;
    for (;;) {
        sum = 0u; cnt = 0u; mine = 0u;
#pragma unroll
        for (unsigned j = 0; j < 16; ++j) { const unsigned c = xb_ld(&bar[XB_XCNT(j)]); sum += c; cnt += (c > 0u) ? 1u : 0u; mine = (j == x) ? c : mine; }
        if (sum == G) break;
        __builtin_amdgcn_s_sleep(1);
        if ((++sp & 255u) == 0u) { if (xb_ld(&bar[XB_TMO])) break; if (sp > XB_SPIN_CAP) { atomicAdd(&bar[XB_TMO], 1u); break; } }
    }
    nloc = mine > 0u ? mine : 1u; nx = cnt > 0u ? cnt : 1u;
}
__device__ __forceinline__ void xcd_barrier(const XcdBarrier& b) {
    asm volatile("s_waitcnt vmcnt(0)" ::: "memory");
    __syncthreads();
    if (threadIdx.x == 0) {
        unsigned* bar = b.bar;
        __builtin_amdgcn_s_waitcnt(0);
        unsigned nloc = b.st[0], nx = b.st[1];
        if (nloc == 0u) { xcd_barrier_complete(bar, b.x, nloc, nx); b.st[0] = nloc; b.st[1] = nx; }
        const unsigned old = xb_add(&bar[XB_XSUB(b.x)], 1u);
        const unsigned gen = old / nloc;
        if (old + 1u == (gen + 1u) * nloc) {
            __builtin_amdgcn_fence(__ATOMIC_RELEASE, "agent");
            asm volatile("s_waitcnt vmcnt(0)" ::: "memory");
            const unsigned og = xb_add(&bar[XB_TOP], 1u);
            const unsigned tg = og / nx;
            if (og + 1u == (tg + 1u) * nx) xb_add(&bar[XB_TOPGEN], 1u);
            else XB_SPIN(xb_ld(&bar[XB_TOPGEN]) == tg, bar);
            __builtin_amdgcn_fence(__ATOMIC_ACQUIRE, "agent");
            xb_add(&bar[XB_XGEN(b.x)], 1u);
            asm volatile("s_waitcnt vmcnt(0)" ::: "memory");
        } else {
            XB_SPIN(xb_ld(&bar[XB_XGEN(b.x)]) == gen, bar);
            __builtin_amdgcn_fence(__ATOMIC_ACQUIRE, "agent");
            asm volatile("s_waitcnt vmcnt(0)" ::: "memory");
        }
    }
    __syncthreads();
}

__device__ __forceinline__ int queue_pop(unsigned* ctr, volatile LAS unsigned* slot) {
    if (threadIdx.x == 0) *slot = __hip_atomic_fetch_add(ctr, 1u, __ATOMIC_RELAXED, __HIP_MEMORY_SCOPE_AGENT);
    __syncthreads();
    const int v = __builtin_amdgcn_readfirstlane((int)*slot);
    __syncthreads();
    return v;
}

__global__ void __launch_bounds__(NWAVES * 64, 2) mk_fwd(KArgs args) {
    extern __shared__ __attribute__((aligned(16))) unsigned char lds[];
    cg::grid_group grid = cg::this_grid();
    Frame F;
    F.lds = (LAS unsigned char*)lds;
    F.tid = threadIdx.x; F.lane = F.tid & 63; F.wave = __builtin_amdgcn_readfirstlane(F.tid >> 6);
    F.G = gridDim.x; F.gw = blockIdx.x * NWAVES + F.wave; F.NGW = F.G * NWAVES;
    unsigned char* ws = args.ws;
    unsigned* ctl = (unsigned*)(ws + WS_CTL);
    const float* xp = args.in[0]; const float* xs = args.in[1];
    float* rope = (float*)(ws + WS_ROPE); float* SS = (float*)(ws + WS_SS);
    bf16 *W1IN = (bf16*)(ws + WS_W1IN), *W1OUT = (bf16*)(ws + WS_W1OUT), *WIN = (bf16*)(ws + WS_WIN), *WA = (bf16*)(ws + WS_WA), *WB = (bf16*)(ws + WS_WB), *WO = (bf16*)(ws + WS_WO),
         *W2IN = (bf16*)(ws + WS_W2IN), *W2OUT = (bf16*)(ws + WS_W2OUT);
    bf16 *XN = (bf16*)(ws + WS_XN), *ACT = (bf16*)(ws + WS_ACT), *UB = (bf16*)(ws + WS_UB), *GVB = (bf16*)(ws + WS_GVB), *ATT = (bf16*)(ws + WS_ATT), *SGU = (bf16*)(ws + WS_SGU),
         *QB = (bf16*)(ws + WS_QB), *KPB = (bf16*)(ws + WS_KPB), *VPB = (bf16*)(ws + WS_VPB), *SGA = (bf16*)(ws + WS_SGA), *SGB = (bf16*)(ws + WS_SGB);
    bf16* FB = (bf16*)(ws + WS_F); bf16* HB = (bf16*)(ws + WS_H); float* T1 = (float*)(ws + WS_T1);
    bf16 *XNs = (bf16*)(ws + SA_XN), *ACTs = (bf16*)(ws + SA_ACT), *Qs = (bf16*)(ws + SA_Q), *Us = (bf16*)(ws + SA_U), *GVs = (bf16*)(ws + SA_GV), *SGAs = (bf16*)(ws + SA_SGA),
         *SGBs = (bf16*)(ws + SA_SGB), *ATTs = (bf16*)(ws + SA_ATT), *SGUs = (bf16*)(ws + SA_SGU);
    bf16* Fs = (bf16*)(ws + SA_F); float *Hs = (float*)(ws + SA_H), *T1s = (float*)(ws + SA_T1), *SSs = (float*)(ws + SA_SS);
    float* out = args.out;
    volatile LAS unsigned* MISC = (volatile LAS unsigned*)(F.lds + MISC_OFF);
    if (F.tid < 32) MISC[F.tid] = 0u;
    __syncthreads();
    XcdBarrier bar = xcd_barrier_post(ctl + CW_BAR, MISC + 8);
#define GRID_BAR() xcd_barrier(bar)

#if (PHM >> 0) & 1
    {
        LAS float* scr = (LAS float*)(F.lds + F.wave * 16384);
        constexpr int I_FIN = (DM / 64) * (2 * DFF / 32), I_FOUT = (DFF / 64) * (DM / 32), I_IN = (DM / 64) * (INC / 32), I_SQ = (DM / 64) * (DM / 32);
        constexpr int NITEMS = 2 * I_FIN + 2 * I_FOUT + I_IN + 3 * I_SQ;
        for (int it = F.gw; it < NITEMS; it += F.NGW) {
            int r = it;
            if (r < I_FIN) { p0_transpose_item(args.in[5], DM, 2 * DFF, W1IN, 1, scr, r, F.lane); continue; } r -= I_FIN;
            if (r < I_FOUT) { p0_transpose_item(args.in[6], DFF, DM, W1OUT, 0, scr, r, F.lane, LDF); continue; } r -= I_FOUT;
            if (r < I_IN) { p0_transpose_item(args.in[9], DM, INC, WIN, 0, scr, r, F.lane); continue; } r -= I_IN;
            if (r < I_SQ) { p0_transpose_item(args.in[18], DM, DM, WA, 0, scr, r, F.lane); continue; } r -= I_SQ;
            if (r < I_SQ) { p0_transpose_item(args.in[19], DM, DM, WB, 0, scr, r, F.lane); continue; } r -= I_SQ;
            if (r < I_SQ) { p0_transpose_item(args.in[20], DM, DM, WO, 0, scr, r, F.lane); continue; } r -= I_SQ;
            if (r < I_FIN) { p0_transpose_item(args.in[23], DM, 2 * DFF, W2IN, 1, scr, r, F.lane); continue; } r -= I_FIN;
            p0_transpose_item(args.in[24], DFF, DM, W2OUT, 0, scr, r, F.lane, LDF);
        }
        for (int i = blockIdx.x * (NWAVES * 64) + F.tid; i < SEQ * 8; i += F.G * NWAVES * 64) {
            const int pos = i >> 3, d = i & 7;
            const double cf = (d == 0) ? 0.15915494309189535 : (d == 1) ? 0.03086376340470123 : (d == 2) ? 0.005985185712713705 : (d == 3) ? 0.001160663641240061 :
                              (d == 4) ? 0.00022507907903927653 : (d == 5) ? 4.364795279280289e-05 : (d == 6) ? 8.464330808241401e-06 : 1.6414262627950345e-06;
            const double rev = (double)pos * cf; double t = rev - __builtin_floor(rev);
            t = t - __builtin_rint(t);
            const double q = __builtin_rint(4.0 * t); const double a = (t - 0.25 * q) * 6.283185307179586476925;
            const double a2 = a * a;
            const double sn = a * (1.0 + a2 * (-1.0 / 6 + a2 * (1.0 / 120 + a2 * (-1.0 / 5040 + a2 * (1.0 / 362880 + a2 * (-1.0 / 39916800 + a2 * (1.0 / 6227020800.0)))))));
            const double cs = 1.0 + a2 * (-0.5 + a2 * (1.0 / 24 + a2 * (-1.0 / 720 + a2 * (1.0 / 40320 + a2 * (-1.0 / 3628800 + a2 * (1.0 / 479001600 + a2 * (-1.0 / 87178291200.0)))))));
            const int qi = ((int)q) & 3;
            const double s_ = (qi == 0) ? sn : (qi == 1) ? cs : (qi == 2) ? -sn : -cs;
            const double c_ = (qi == 0) ? cs : (qi == 1) ? -sn : (qi == 2) ? -cs : sn;
            rope[(size_t)pos * 16 + d] = (float)c_; rope[(size_t)pos * 16 + 8 + d] = (float)s_;
        }
        const float* g1 = args.in[4];
        for (int m = F.gw; m < MT; m += 2 * F.NGW) {
            const bool two = (m + F.NGW < MT); const int mb = two ? m + F.NGW : m;
            const f32x4* xa = (const f32x4*)xrow_ptr(xp, xs, m) + F.lane; const f32x4* xb = (const f32x4*)xrow_ptr(xp, xs, mb) + F.lane; const f32x4* gp = (const f32x4*)g1 + F.lane;
            f32x4 va[4], vb[4], g[4]; float sa = 0.f, sb = 0.f;
#pragma unroll
            for (int j = 0; j < 4; ++j) { va[j] = xa[64 * j]; vb[j] = xb[64 * j]; g[j] = gp[64 * j]; }
#pragma unroll
            for (int j = 0; j < 4; ++j) { sa += (va[j][0] * va[j][0] + va[j][1] * va[j][1]) + (va[j][2] * va[j][2] + va[j][3] * va[j][3]);
                                          sb += (vb[j][0] * vb[j][0] + vb[j][1] * vb[j][1]) + (vb[j][2] * vb[j][2] + vb[j][3] * vb[j][3]); }
            const float rsa = 1.0f / sqrtf(wave_sum(sa) * (1.0f / DM) + EPS), rsb = 1.0f / sqrtf(wave_sum(sb) * (1.0f / DM) + EPS);
            unsigned long long* oa = (unsigned long long*)(m < SEQ ? XN + (size_t)m * DM : XNs + (size_t)(m - SEQ) * DM) + F.lane;
            unsigned long long* ob = (unsigned long long*)(mb < SEQ ? XN + (size_t)mb * DM : XNs + (size_t)(mb - SEQ) * DM) + F.lane;
#pragma unroll
            for (int j = 0; j < 4; ++j) { const f32x4 w = va[j] * g[j] * rsa; oa[64 * j] = (unsigned long long)pk2(w[0], w[1]) | ((unsigned long long)pk2(w[2], w[3]) << 32); }
            if (two) {
#pragma unroll
                for (int j = 0; j < 4; ++j) { const f32x4 w = vb[j] * g[j] * rsb; ob[64 * j] = (unsigned long long)pk2(w[0], w[1]) | ((unsigned long long)pk2(w[2], w[3]) << 32); }
            }
        }
    }
    GRID_BAR();
    if (args.ws == nullptr) grid.sync();

#endif
#if (PHM >> 1) & 1
    { pg8::Gemm g{XN, W1IN, SEQ, 2 * DFF, DM}; pg8::StaticOrder S; S.init(SEQ, 2 * DFF, F.G, (int)blockIdx.x);
      pg8::EpiSwiglu E{ACT}; pg8::gemm_phase<pg8::EpiSwiglu, pg8::StaticOrder, true, true>(F.lds, g, S, E); }
    GRID_BAR();
#endif
#if (PHM >> 2) & 1
    { pg8::Gemm g{ACT, W1OUT, SEQ, DM, DFF, nullptr, nullptr, LDF}; pg8::StaticOrder S; S.init(SEQ, DM, F.G, (int)blockIdx.x);
      pg8::EpiF32Stats E{FB, SS}; pg8::gemm_phase<pg8::EpiF32Stats, pg8::StaticOrder, false, true>(F.lds, g, S, E); }
    GRID_BAR();
#endif
#if (PHM >> 3) & 1
    row_phase<false, true>(F, F.gw, F.NGW, SEQ, FB, SS, xp, 0.5f, args.in[7], HB, args.in[8], XN);
    GRID_BAR();
#endif
#if (PHM >> 4) & 1
    { pg8::Gemm g{XN, WIN, SEQ, INC, DM}; pg8::StaticOrder S; S.init(SEQ, INC, F.G, (int)blockIdx.x);
      pg8::EpiProj E{QB, KPB, VPB, UB, GVB, SGA, SGB, out + OFF_KP, out + OFF_VP, SS, rope, false}; pg8::gemm_phase<pg8::EpiProj, pg8::StaticOrder, true, true>(F.lds, g, S, E); }
    GRID_BAR();
#endif
#if (PHM >> 5) & 1
    {
        float lam;
        { const float a = args.in[10][F.lane] * args.in[11][F.lane], b = args.in[12][F.lane] * args.in[13][F.lane];
          lam = expf(wave_sum(a)) - expf(wave_sum(b)) + LAM_INIT;
          lam = __builtin_bit_cast(float, __builtin_amdgcn_readfirstlane(__builtin_bit_cast(int, lam))); }
        unsigned* ch = ctl + CW_CH;
        int ch_ready = 0;
#define CH_N(s) ((s) == 1 || (s) == 10 ? 22 : (s) == 4 ? 28 : (s) == 5 ? 192 : ((s) == 3 || (s) == 9 || (s) == 12) ? 1 : 4)
#define CH_DONE_NOW(s, RES) do { if ((s) <= ch_ready) RES = true; else { \
            if (F.tid == 0) MISC[1] = (__hip_atomic_load(ch + 128 * (s) + 64, __ATOMIC_RELAXED, __HIP_MEMORY_SCOPE_AGENT) >= (unsigned)CH_N(s)) ? 1u : 0u; \
            __syncthreads(); RES = __builtin_amdgcn_readfirstlane((int)MISC[1]) != 0; __syncthreads(); } } while (0)
#define CH_WAIT(s) do { if ((s) > ch_ready) { \
            if (F.tid == 0) { unsigned sp_ = 0; while (__hip_atomic_load(ch + 128 * (s) + 64, __ATOMIC_RELAXED, __HIP_MEMORY_SCOPE_AGENT) < (unsigned)CH_N(s)) { __builtin_amdgcn_s_sleep(8); if (++sp_ > (1u << 22)) break; } \
                if (!((s) == 4 && !starter)) { __builtin_amdgcn_fence(__ATOMIC_ACQUIRE, "agent"); asm volatile("s_waitcnt vmcnt(0)" ::: "memory"); } } \
            __syncthreads(); ch_ready = (s); } } while (0)
#define CH_SIGNAL(s) do { asm volatile("s_waitcnt vmcnt(0)" ::: "memory"); __syncthreads(); \
            if (F.tid == 0) { __builtin_amdgcn_fence(__ATOMIC_RELEASE, "agent"); asm volatile("s_waitcnt vmcnt(0)" ::: "memory"); \
                __hip_atomic_fetch_add(ch + 128 * (s) + 64, 1u, __ATOMIC_RELAXED, __HIP_MEMORY_SCOPE_AGENT); } } while (0)
#define WP(T, off) ((T*)(w_ + (off)))
#define CH_UNIT(s, u) do { \
            if ((s) == 1 || (s) == 10) { pg8::Gemm g{WP(bf16, SA_XN), (s) == 1 ? WP(bf16, WS_W1IN) : WP(bf16, WS_W2IN), 256, 2 * DFF, DM}; pg8::OneUnit S{0, (u)}; pg8::EpiSwiglu E{WP(bf16, SA_ACT)}; pg8::gemm_phase<pg8::EpiSwiglu, pg8::OneUnit, false, true>(F.lds, g, S, E); } \
            else if ((s) == 2 || (s) == 11) { pg8::Gemm g{WP(bf16, SA_ACT), (s) == 2 ? WP(bf16, WS_W1OUT) : WP(bf16, WS_W2OUT), 256, DM, DFF, nullptr, nullptr, LDF}; pg8::OneUnit S{0, (u)}; pg8::EpiF32Stats E{WP(bf16, SA_F), WP(float, SA_SS)}; pg8::gemm_phase<pg8::EpiF32Stats, pg8::OneUnit, false, true>(F.lds, g, S, E); } \
            else if ((s) == 8) { pg8::Gemm g{WP(bf16, SA_XN), WP(bf16, WS_WO), 256, DM, DM}; pg8::OneUnit S{0, (u)}; pg8::EpiF32Stats E{WP(bf16, SA_F), WP(float, SA_SS)}; pg8::gemm_phase<pg8::EpiF32Stats, pg8::OneUnit, false, true>(F.lds, g, S, E); } \
            else if ((s) == 4) { pg8::Gemm g{WP(bf16, SA_XN), WP(bf16, WS_WIN), 256, INC, DM}; pg8::OneUnit S{0, (u)}; \
                               pg8::EpiProj E{WP(bf16, SA_Q), nullptr, nullptr, WP(bf16, SA_U), WP(bf16, SA_GV), WP(bf16, SA_SGA), WP(bf16, SA_SGB), o_ + OFF_KS, o_ + OFF_VS, WP(float, SA_SS), WP(float, WS_ROPE), true}; \
                               pg8::gemm_phase<pg8::EpiProj, pg8::OneUnit, false, true>(F.lds, g, S, E); } \
            else if ((s) == 6) { pg8::Gemm g{WP(bf16, SA_ATT), WP(bf16, WS_WA), 256, DM, DM}; pg8::OneUnit S{0, (u)}; pg8::EpiGateA E{WP(float, SA_T1), WP(bf16, SA_SGA)}; pg8::gemm_phase<pg8::EpiGateA, pg8::OneUnit, false, true>(F.lds, g, S, E); } \
            else if ((s) == 7) { pg8::Gemm g{WP(bf16, SA_SGU), WP(bf16, WS_WB), 256, DM, DM}; pg8::OneUnit S{0, (u)}; pg8::EpiGateB E{WP(float, SA_T1), WP(bf16, SA_SGB), WP(bf16, SA_XN)}; pg8::gemm_phase<pg8::EpiGateB, pg8::OneUnit, false, true>(F.lds, g, S, E); } \
            else if ((s) == 3) row_phase<false, false>(F, F.wave, NWAVES, 256, WP(bf16, SA_F), WP(float, SA_SS), KIN(1), 0.5f, KIN(7), WP(float, SA_H), KIN(8), WP(bf16, SA_XN)); \
            else if ((s) == 9) row_phase<false, false>(F, F.wave, NWAVES, 256, WP(bf16, SA_F), WP(float, SA_SS), WP(float, SA_H), 1.0f, KIN(21), WP(float, SA_H), KIN(22), WP(bf16, SA_XN)); \
            else if ((s) == 12) row_phase<false, false>(F, F.wave, NWAVES, 256, WP(bf16, SA_F), WP(float, SA_SS), WP(float, SA_H), 0.5f, KIN(25), o_ + OFF_Y + (size_t)SEQ * DM, nullptr, nullptr); \
            else {} } while (0)
#ifndef P5_REPS
#define P5_REPS 1
#endif
#ifndef NDED
#define NDED 16
#endif
        const int h8 = blockIdx.x & 7;
#pragma unroll 1
        for (int rep = 0; rep < P5_REPS; ++rep) {
        unsigned* qb_ = ctl + CW_Q + rep * 1024;
        const bool starter = (int)blockIdx.x >= (int)F.G - NDED;
        int st = starter ? 0 : 1, cs = starter ? 1 : 5, hh = 0; bool s5_open = true, try5 = false;
        for (;;) {
            int kind = 0, a0 = 0, a1 = 0, dep = 0, sig = 0;
            if (st == 0 || st == 3) {
                while (cs <= 12) { const int u = queue_pop(ch + 128 * cs, MISC); if (u < CH_N(cs)) { kind = 3; a0 = cs; a1 = u; dep = cs - 1; sig = cs; break; } ++cs; }
                if (kind == 0) { if (st == 0) { st = 1; cs = 5; continue; } break; }
            } else if (st == 1) {
                if (try5) { try5 = false; bool rdy_; CH_DONE_NOW(4, rdy_);
                    if (rdy_) { const int u = queue_pop(ch + 128 * 5, MISC); if (u < CH_N(5)) { kind = 3; a0 = 5; a1 = u; dep = 4; sig = 5; } else s5_open = false; } }
                if (kind == 0) {
                    while (hh < 8) { const int hq = (h8 + hh) & 7; const int idx = queue_pop(qb_ + 64 * hq, MISC); if (idx < 128) { kind = 1; a0 = hq; a1 = 127 - idx; try5 = s5_open; break; }
                        if (F.tid < 8) MISC[32 + F.tid] = __hip_atomic_load(qb_ + 64 * F.tid, __ATOMIC_RELAXED, __HIP_MEMORY_SCOPE_AGENT);
                        __syncthreads();
                        ++hh; while (hh < 8 && MISC[32 + ((h8 + hh) & 7)] >= 128u) ++hh;
                        __syncthreads(); }
                    if (kind == 0) { st = 2; continue; }
                }
            } else {
                const int idx = queue_pop(qb_ + 64 * 8, MISC);
                if (idx < 512) { kind = 2; a0 = idx >> 2; a1 = idx & 3; } else { bool fin_; CH_DONE_NOW(12, fin_); if (fin_) break; st = 3; cs = 5; continue; }
            }
            if (dep) CH_WAIT(dep);
            typedef __attribute__((address_space(4))) const unsigned long long* kptr_t;
            kptr_t kq_ = (kptr_t)__builtin_amdgcn_kernarg_segment_ptr(); asm volatile("" : "+s"(kq_));
#define KIN(k) ((const float*)(const GAS float*)kq_[k])
            unsigned char* w_ = (unsigned char*)(GAS unsigned char*)kq_[27]; float* o_ = (float*)(GAS float*)kq_[26];
            if (kind == 1 || (kind == 3 && a0 == 5 && a1 < 128)) {
                att::Args AA{WP(bf16, WS_QB), WP(bf16, WS_KPB), WP(bf16, WS_VPB), KIN(2), KIN(3), o_ + OFF_KS, o_ + OFF_VS, WP(bf16, WS_ATT), KIN(14), WP(bf16, SA_Q), WP(bf16, SA_ATT), o_ + OFF_KP, o_ + OFF_VP};
                if (kind == 1) att::attn_unit<false>(AA, a0, a1, (char*)lds, lam); else att::attn_unit<true>(AA, a1 & 7, a1 >> 3, (char*)lds, lam);
            } else if (kind == 2 || (kind == 3 && a0 == 5)) { const bool smp = (kind == 3);
                att::SpArgs SA{WP(bf16, WS_UB), WP(bf16, WS_GVB), WP(float, WS_SS), KIN(15), KIN(16), KIN(17), WP(bf16, WS_SGU), o_ + OFF_GS, WP(bf16, SA_U), WP(bf16, SA_GV), WP(float, SA_SS), WP(bf16, SA_SGU)};
                if (smp) att::spatial_unit(SA, true, (a1 - 128) >> 2, (a1 - 128) & 3, (char*)lds); else att::spatial_unit_prompt(SA, a0, a1, (char*)lds); }
            else CH_UNIT(a0, a1);
            if (sig) CH_SIGNAL(sig);
        }
        if (rep + 1 < P5_REPS) GRID_BAR();
        }
    }
    GRID_BAR();
#endif
#if (PHM >> 6) & 1
    { pg8::Gemm g{ATT, WA, SEQ, DM, DM, SGU, WB}; pg8::DualOrder S; S.init(SEQ, DM, F.G, (int)blockIdx.x);
      pg8::EpiGateAB E{SGA, SGB, XN}; pg8::gemm_phase<pg8::EpiGateAB, pg8::DualOrder, true, true>(F.lds, g, S, E); }
    GRID_BAR();
#endif
#if (PHM >> 8) & 1
    { pg8::Gemm g{XN, WO, SEQ, DM, DM}; pg8::StaticOrder S; S.init(SEQ, DM, F.G, (int)blockIdx.x);
      pg8::EpiF32Stats E{FB, SS}; pg8::gemm_phase<pg8::EpiF32Stats, pg8::StaticOrder, false, true>(F.lds, g, S, E); }
    GRID_BAR();
#endif
#if (PHM >> 9) & 1
    row_phase<true, true>(F, F.gw, F.NGW, SEQ, FB, SS, HB, 1.0f, args.in[21], HB, args.in[22], XN);
    GRID_BAR();
#endif
#if (PHM >> 10) & 1
    { pg8::Gemm g{XN, W2IN, SEQ, 2 * DFF, DM}; pg8::StaticOrder S; S.init(SEQ, 2 * DFF, F.G, (int)blockIdx.x);
      pg8::EpiSwiglu E{ACT}; pg8::gemm_phase<pg8::EpiSwiglu, pg8::StaticOrder, true, true>(F.lds, g, S, E); }
    GRID_BAR();
    { pg8::Gemm g{ACT, W2OUT, SEQ, DM, DFF, nullptr, nullptr, LDF}; pg8::StaticOrder S; S.init(SEQ, DM, F.G, (int)blockIdx.x);
      pg8::EpiF32Stats E{FB, SS}; pg8::gemm_phase<pg8::EpiF32Stats, pg8::StaticOrder, false, true>(F.lds, g, S, E); }
    GRID_BAR();
#endif
#if (PHM >> 11) & 1
        row_phase<true, false>(F, F.gw, F.NGW, SEQ, FB, SS, HB, 0.5f, args.in[25], out + OFF_Y, nullptr, nullptr);
#endif
#ifdef PROBE_BF16
    for (size_t i = (size_t)blockIdx.x * 512 + F.tid; i < (size_t)MT * DM; i += (size_t)F.G * 512) out[OFF_Y + i] = bf2f(((const bf16*)PROBE_BF16)[i]);
#elif !((PHM >> 11) & 1)
    for (size_t i = (size_t)blockIdx.x * 512 + F.tid; i < (size_t)MT * DM / 4; i += (size_t)F.G * 512) ((f32x4*)(out + OFF_Y))[i] = (f32x4){0.f, 0.f, 0.f, 0.f};
#endif
#if !((PHM >> 5) & 1)
    for (size_t i = (size_t)blockIdx.x * 512 + F.tid; i < (size_t)256 * DM / 4; i += (size_t)F.G * 512) ((f32x4*)(out + OFF_GS))[i] = (f32x4){0.f, 0.f, 0.f, 0.f};
#endif
}

extern "C" void kernel_launch(void* const* d_in, const int* in_sizes, int n_in, void* d_out, int out_size, void* d_ws, size_t ws_size, hipStream_t stream) {
    static int grid = 0;
    if (grid == 0) {
        if (n_in != 26 || ws_size < WS_END) { fprintf(stderr, "kernel_launch: unexpected n_in %d / ws %zu\n", n_in, ws_size); grid = -1; return; }
        int dev = 0, cus = 0, per_cu = 0;
        if (hipGetDevice(&dev) != hipSuccess || hipDeviceGetAttribute(&cus, hipDeviceAttributeMultiprocessorCount, dev) != hipSuccess) { grid = -1; return; }
        if (hipFuncSetAttribute((const void*)mk_fwd, hipFuncAttributeMaxDynamicSharedMemorySize, LDS_BYTES) != hipSuccess) { fprintf(stderr, "kernel_launch: hipFuncSetAttribute failed\n"); grid = -1; return; }
        if (hipOccupancyMaxActiveBlocksPerMultiprocessor(&per_cu, (const void*)mk_fwd, NWAVES * 64, LDS_BYTES) != hipSuccess || per_cu < 1) { fprintf(stderr, "kernel_launch: occupancy query says %d\n", per_cu); per_cu = 1; }
        (void)hipGetLastError();
        grid = cus;
    }
    if (grid < 0) return;
    (void)hipMemsetAsync((char*)d_ws + WS_CTL, 0, CTL_ZERO_BYTES, stream);
    KArgs a{};
    for (int i = 0; i < 26; ++i) a.in[i] = (const float*)d_in[i];
    a.out = (float*)d_out; a.ws = (unsigned char*)d_ws;
    void* kargs[] = {&a};
    hipError_t e = hipLaunchCooperativeKernel((const void*)mk_fwd, dim3(grid), dim3(NWAVES * 64), kargs, LDS_BYTES, stream);
    if (e != hipSuccess) fprintf(stderr, "kernel_launch: cooperative launch failed: %s (grid %d)\n", hipGetErrorString(e), grid);
}
```

```cpp
#include <hip/hip_runtime.h>
#include <hip/hip_cooperative_groups.h>
#include <cstdio>
#include <cstdint>
namespace cg = cooperative_groups;
#ifndef P5M
#define P5M 7
#endif
#ifndef PHM
#define PHM 0xFFF
#endif

namespace pg8 {
#define PG8_LAS __attribute__((address_space(3)))
typedef unsigned short bf16_t;
typedef short bf16x8 __attribute__((ext_vector_type(8)));
typedef float f32x4 __attribute__((ext_vector_type(4)));
typedef float f32x2 __attribute__((ext_vector_type(2)));
typedef unsigned u32x4 __attribute__((ext_vector_type(4)));
typedef unsigned u32x2 __attribute__((ext_vector_type(2)));
constexpr int BM = 256, BK = 64, HALF = 128, HTB = HALF * BK * 2, STAGE_BYTES = 8 * HTB, NXCD = 8, WGM = 4;

__host__ __device__ __forceinline__ int lds_byte(int r, int c) { const int st = (r >> 4) * 2 + (c >> 5), rr = r & 15, cc = c & 31, ob = rr * 64 + cc * 2; return st * 1024 + (ob ^ (((ob >> 9) & 1) << 5)); }
__host__ __device__ __forceinline__ void stage_rc(int b, int& R, int& C) { const int st = b / 1024, sb = b % 1024, swz = sb ^ (((sb >> 9) & 1) << 5); R = (st >> 1) * 16 + swz / 64; C = (st & 1) * 32 + (swz % 64) / 2; }
__host__ __device__ __forceinline__ int perm32(int rho) { const int n = rho >> 4, i = rho & 15; return 8 * (i >> 2) + 4 * n + (i & 3); }

struct Unit { int pm, pn, w; };
struct Gemm { const bf16_t* A; const bf16_t* Bt; int M, N, K; const bf16_t* A2 = nullptr; const bf16_t* Bt2 = nullptr; int ld = 0; };

struct StaticOrder {
    int nM, nN, nwg, G, c;
    __host__ __device__ void init(int M, int N, int G_, int c_) { nM = M / BM; nN = N / BM; nwg = nM * nN; G = G_; c = c_; }
    __host__ __device__ bool next(int i, Unit& u) const {
        const long L = (long)i * G + c; if (L >= nwg) return false;
        int wgid = (int)L; { const int q = nwg / NXCD, r = nwg % NXCD, xcd = wgid % NXCD, off = wgid / NXCD; wgid = (xcd < r ? xcd * (q + 1) : r * (q + 1) + (xcd - r) * q) + off; }
        const int nig = WGM * nN, gid = wgid / nig, fm = gid * WGM, gsz = (nM - fm) < WGM ? (nM - fm) : WGM;
        u.pm = fm + ((wgid % nig) % gsz); u.pn = (wgid % nig) / gsz; u.w = 0; return true;
    }
    __device__ __forceinline__ void a_ready(const Unit&) const {}
    __device__ __forceinline__ void done(const Unit&) const {}
};
struct DualOrder {
    StaticOrder so;
    __host__ __device__ void init(int M, int N, int G_, int c_) { so.init(M, N, G_, c_); }
    __host__ __device__ bool next(int i, Unit& u) const { if (!so.next(i >> 1, u)) return false; u.w = i & 1; return true; }
    __device__ __forceinline__ void a_ready(const Unit&) const {}
    __device__ __forceinline__ void done(const Unit&) const {}
};

typedef float f32x2_cv __attribute__((ext_vector_type(2))); typedef __bf16 bf16x2_cv __attribute__((ext_vector_type(2)));
struct OneUnit {
    int pm, pn;
    __device__ __forceinline__ bool next(int i, Unit& u) const { if (i > 0) return false; u.pm = pm; u.pn = pn; u.w = 0; return true; }
    __device__ __forceinline__ void a_ready(const Unit&) const {}
    __device__ __forceinline__ void done(const Unit&) const {}
};
__device__ __forceinline__ unsigned cvt_pk_bf16(float lo, float hi) { f32x2_cv v = {lo, hi}; bf16x2_cv b = __builtin_convertvector(v, bf16x2_cv); return __builtin_bit_cast(unsigned, b); }

template <class Epi, class Sched, bool ALIGN_EPI = false, bool SP2 = false>
__device__ __forceinline__ void gemm_phase(PG8_LAS unsigned char* lds, const Gemm g, const Sched& S, const Epi& E) {
    int tid = threadIdx.x; asm volatile("" : "+v"(tid));
    const int wid = __builtin_amdgcn_readfirstlane(tid >> 6), lane = tid & 63, wr = wid >> 2, wc = wid & 3, fr = lane & 15, fq = lane >> 4;
    const int K = g.K, nt = K / BK, LD = g.ld ? g.ld : g.K;
    unsigned voffA[2], voffB[2];
#pragma unroll
    for (int i = 0; i < 2; ++i) { int R, C; stage_rc(tid * 16 + i * 8192, R, C); const int Rb = Epi::PERM ? ((R & ~31) + perm32(R & 31)) : R;
        voffA[i] = (unsigned)(R * LD + C) * 2u; voffB[i] = (unsigned)(Rb * LD + C) * 2u; }
    const size_t kstep = (size_t)(BK * 2);
    const size_t hstep = (size_t)HALF * LD * 2;
    const size_t tstep = 2 * hstep;
    const unsigned ldsw = (unsigned)wid * 1024u;
    const int aoff = lds_byte(wr * 64 + fr, fq * 8), boff = lds_byte(wc * 32 + fr, fq * 8);
#define PG8_SA(b, h) (((b) * 2 + (h)) * HTB)
#define PG8_SB(b, h) ((4 + (b) * 2 + (h)) * HTB)
#define PG8_STAGE(bufoff, gbase, voff) do { _Pragma("unroll") for (int _i = 0; _i < 2; ++_i) \
        __builtin_amdgcn_global_load_lds((const unsigned*)((const char*)(gbase) + (voff)[_i]), (PG8_LAS unsigned*)(lds + (bufoff) + ldsw + _i * 8192), 16, 0, 0); } while (0)
#define PG8_LDA(dst, b, h) do { _Pragma("unroll") for (int m = 0; m < 4; ++m) _Pragma("unroll") for (int k = 0; k < 2; ++k) dst[m][k] = *(const PG8_LAS bf16x8*)(lds + PG8_SA(b, h) + aoff + m * 2048 + k * 1024); } while (0)
#define PG8_LDB(dst, b, h) do { _Pragma("unroll") for (int n = 0; n < 2; ++n) _Pragma("unroll") for (int k = 0; k < 2; ++k) dst[n][k] = *(const PG8_LAS bf16x8*)(lds + PG8_SB(b, h) + boff + n * 2048 + k * 1024); } while (0)
#define PG8_MMA(ai, bj, At, Bt) do { __builtin_amdgcn_s_setprio(1); _Pragma("unroll") for (int m = 0; m < 4; ++m) _Pragma("unroll") for (int n = 0; n < 2; ++n) _Pragma("unroll") for (int k = 0; k < 2; ++k) \
        acc[ai][bj][m][n] = __builtin_amdgcn_mfma_f32_16x16x32_bf16(Bt[n][k], At[m][k], acc[ai][bj][m][n], 0, 0, 0); __builtin_amdgcn_s_setprio(0); } while (0)
#define PG8_WAIT_V(n) asm volatile("s_waitcnt vmcnt(" #n ")" ::: "memory")
#define PG8_WAIT_L(n) asm volatile("s_waitcnt lgkmcnt(" #n ")" ::: "memory")
#define PG8_BAR __builtin_amdgcn_s_barrier()
#define PG8_SCHED __builtin_amdgcn_sched_barrier(0)
    Unit cur, nxt; int ui = 0;
    if (!S.next(0, cur)) return;
    f32x4 acc[2][2][4][2];
#pragma unroll
    for (int a = 0; a < 2; ++a)
#pragma unroll
        for (int b = 0; b < 2; ++b)
#pragma unroll
            for (int m = 0; m < 4; ++m)
#pragma unroll
                for (int n = 0; n < 2; ++n) acc[a][b][m][n] = (f32x4){0.f, 0.f, 0.f, 0.f};
    bf16x8 At[4][2], B0[2][2], B1[2][2];
    const char* cA = (const char*)(cur.w ? g.A2 : g.A) + (size_t)cur.pm * tstep; const char* cB = (const char*)(cur.w ? g.Bt2 : g.Bt) + (size_t)cur.pn * tstep;
    S.a_ready(cur);
    if constexpr (SP2) {
        PG8_STAGE(PG8_SB(0, 0), cB, voffB); PG8_STAGE(PG8_SB(0, 1), cB + hstep, voffB); PG8_STAGE(PG8_SA(0, 0), cA, voffA); PG8_STAGE(PG8_SA(0, 1), cA + hstep, voffA);
        if (wr == 1) PG8_BAR;
        PG8_WAIT_V(2); PG8_BAR;
        PG8_STAGE(PG8_SB(1, 0), cB + kstep, voffB); PG8_STAGE(PG8_SA(1, 0), cA + kstep, voffA); PG8_STAGE(PG8_SB(1, 1), cB + hstep + kstep, voffB);
        PG8_WAIT_V(6); PG8_BAR;
    } else {
        PG8_STAGE(PG8_SB(0, 0), cB, voffB); PG8_STAGE(PG8_SA(0, 0), cA, voffA); PG8_STAGE(PG8_SB(0, 1), cB + hstep, voffB); PG8_STAGE(PG8_SA(0, 1), cA + hstep, voffA);
        if (wr == 1) PG8_BAR;
        PG8_WAIT_V(4); PG8_BAR;
        PG8_STAGE(PG8_SB(1, 0), cB + kstep, voffB); PG8_STAGE(PG8_SA(1, 0), cA + kstep, voffA); PG8_STAGE(PG8_SB(1, 1), cB + hstep + kstep, voffB);
        PG8_WAIT_V(6); PG8_BAR;
    }
    for (;;) {
        const bool has_next = S.next(ui + 1, nxt);
        const char* nA = has_next ? (const char*)(nxt.w ? g.A2 : g.A) + (size_t)nxt.pm * tstep : cA; const char* nB = has_next ? (const char*)(nxt.w ? g.Bt2 : g.Bt) + (size_t)nxt.pn * tstep : cB;
        for (int t = 0; t < nt; t += 2) {
            const bool last = (t == nt - 2);
            const char* a1 = cA + (size_t)(t + 1) * kstep;
            const char* a2 = last ? nA : cA + (size_t)(t + 2) * kstep; const char* b2 = last ? nB : cB + (size_t)(t + 2) * kstep;
            const char* a3 = a2 + kstep; const char* b3 = b2 + kstep;
            if (last && has_next) S.a_ready(nxt);
            if constexpr (SP2) {
            PG8_LDB(B0, 0, 0); PG8_LDB(B1, 0, 1); PG8_SCHED; PG8_LDA(At, 0, 0); PG8_STAGE(PG8_SA(1, 1), a1 + hstep, voffA);
            PG8_WAIT_V(8); PG8_WAIT_L(0); PG8_BAR; PG8_MMA(0, 0, At, B0); PG8_MMA(0, 1, At, B1); PG8_BAR; PG8_SCHED;
            PG8_LDA(At, 0, 1); PG8_STAGE(PG8_SB(0, 0), b2, voffB); PG8_STAGE(PG8_SB(0, 1), b2 + hstep, voffB); PG8_STAGE(PG8_SA(0, 0), a2, voffA);
            PG8_WAIT_V(8); PG8_WAIT_L(0); PG8_BAR; PG8_MMA(1, 0, At, B0); PG8_MMA(1, 1, At, B1); PG8_BAR; PG8_SCHED;
            PG8_LDB(B0, 1, 0); PG8_LDB(B1, 1, 1); PG8_SCHED; PG8_LDA(At, 1, 0); PG8_STAGE(PG8_SA(0, 1), a2 + hstep, voffA);
            PG8_WAIT_V(8); PG8_WAIT_L(0); PG8_BAR; PG8_MMA(0, 0, At, B0); PG8_MMA(0, 1, At, B1); PG8_BAR; PG8_SCHED;
            PG8_LDA(At, 1, 1); PG8_STAGE(PG8_SB(1, 0), b3, voffB); PG8_STAGE(PG8_SB(1, 1), b3 + hstep, voffB); PG8_STAGE(PG8_SA(1, 0), a3, voffA);
            PG8_WAIT_V(8); PG8_WAIT_L(0); PG8_BAR; PG8_MMA(1, 0, At, B0); PG8_MMA(1, 1, At, B1); PG8_BAR; PG8_SCHED;
            } else {
            PG8_LDB(B0, 0, 0); PG8_SCHED; PG8_LDA(At, 0, 0); PG8_STAGE(PG8_SA(1, 1), a1 + hstep, voffA);
            PG8_WAIT_L(8); PG8_BAR; PG8_WAIT_L(0); PG8_MMA(0, 0, At, B0); PG8_BAR; PG8_SCHED;
            PG8_LDB(B1, 0, 1); PG8_STAGE(PG8_SB(0, 0), b2, voffB);
            PG8_BAR; PG8_WAIT_L(0); PG8_MMA(0, 1, At, B1); PG8_BAR;
            PG8_LDA(At, 0, 1); PG8_STAGE(PG8_SA(0, 0), a2, voffA);
            PG8_BAR; PG8_WAIT_L(0); PG8_MMA(1, 0, At, B0); PG8_BAR; PG8_SCHED;
            PG8_STAGE(PG8_SB(0, 1), b2 + hstep, voffB);
            PG8_WAIT_V(6); PG8_BAR; PG8_MMA(1, 1, At, B1); PG8_BAR;
            PG8_LDB(B0, 1, 0); PG8_SCHED; PG8_LDA(At, 1, 0); PG8_STAGE(PG8_SA(0, 1), a2 + hstep, voffA);
            PG8_WAIT_L(8); PG8_BAR; PG8_WAIT_L(0); PG8_MMA(0, 0, At, B0); PG8_BAR; PG8_SCHED;
            PG8_LDB(B1, 1, 1); PG8_STAGE(PG8_SB(1, 0), b3, voffB);
            PG8_BAR; PG8_WAIT_L(0); PG8_MMA(0, 1, At, B1); PG8_BAR;
            PG8_LDA(At, 1, 1); PG8_STAGE(PG8_SA(1, 0), a3, voffA);
            PG8_BAR; PG8_WAIT_L(0); PG8_MMA(1, 0, At, B0); PG8_BAR; PG8_SCHED;
            PG8_STAGE(PG8_SB(1, 1), b3 + hstep, voffB);
            PG8_WAIT_V(6); PG8_BAR; PG8_MMA(1, 1, At, B1); PG8_BAR;
            }
        }
        if constexpr (ALIGN_EPI) { if (wr == 0) PG8_BAR; }
        E(acc, cur, wr, wc, fr, fq); S.done(cur);
        if (!has_next) break;
        if (!(Epi::DUAL && cur.w == 0)) {
#pragma unroll
        for (int a = 0; a < 2; ++a)
#pragma unroll
            for (int b = 0; b < 2; ++b)
#pragma unroll
                for (int m = 0; m < 4; ++m)
#pragma unroll
                    for (int n = 0; n < 2; ++n) acc[a][b][m][n] = (f32x4){0.f, 0.f, 0.f, 0.f};
        }
        cur = nxt; cA = nA; cB = nB; ++ui;
        if constexpr (ALIGN_EPI) { if (wr == 1) PG8_BAR; }
    }
    PG8_WAIT_V(0);
    if constexpr (!ALIGN_EPI) { if (wr == 0) PG8_BAR; }
    PG8_BAR;
#undef PG8_SA
#undef PG8_SB
#undef PG8_STAGE
#undef PG8_LDA
#undef PG8_LDB
#undef PG8_MMA
#undef PG8_WAIT_V
#undef PG8_WAIT_L
#undef PG8_BAR
#undef PG8_SCHED
}
}

constexpr int DM = 1024, SEQ = 16384, DECB = 16, DECS = 16, PAST = 2048, NH = 8, DFF = 2816, INC = 7168;
constexpr int MT = SEQ + DECB * DECS;
constexpr int LDF = 2880;
constexpr float EPS = 1e-6f;
constexpr float C2 = 0.18033688011112042f;
constexpr float LAM_INIT = 0.2f;

constexpr size_t OFF_Y = 0, OFF_KP = (size_t)MT * DM, OFF_VP = OFF_KP + (size_t)SEQ * DM, OFF_KS = OFF_VP + (size_t)SEQ * DM,
                 OFF_VS = OFF_KS + (size_t)256 * DM, OFF_GS = OFF_VS + (size_t)256 * DM;

constexpr size_t MiB = 1u << 20;
constexpr size_t WS_CTL = 0, CTL_ZERO_BYTES = 64 * 1024;
constexpr size_t WS_ROPE = 1 * MiB;
constexpr size_t WS_SS = 2 * MiB;
constexpr size_t WS_W1IN = 4 * MiB;
constexpr size_t WS_W1OUT = 15 * MiB;
constexpr size_t WS_WIN = 21 * MiB;
constexpr size_t WS_WA = 35 * MiB, WS_WB = 37 * MiB, WS_WO = 39 * MiB;
constexpr size_t WS_W2IN = 41 * MiB, WS_W2OUT = 52 * MiB;
constexpr size_t WS_XN = 58 * MiB;
constexpr size_t WS_ACT = 91 * MiB;
constexpr size_t WS_UB = WS_ACT, WS_GVB = WS_ACT + 33 * MiB;
constexpr size_t WS_F = 184 * MiB;
constexpr size_t WS_ATT = WS_F, WS_SGU = WS_F + 33 * MiB;
constexpr size_t WS_H = 250 * MiB;
constexpr size_t WS_QB = 316 * MiB, WS_KPB = 349 * MiB, WS_VPB = 382 * MiB;
constexpr size_t WS_T1 = WS_QB;
constexpr size_t WS_SGA = 415 * MiB, WS_SGB = 448 * MiB;
constexpr size_t WS_SA = 481 * MiB;
constexpr size_t SA_XN = WS_SA, SA_ACT = WS_SA + 1 * MiB, SA_F = WS_SA + 3 * MiB, SA_H = WS_SA + 4 * MiB, SA_T1 = WS_SA + 5 * MiB, SA_Q = WS_SA + 6 * MiB,
                 SA_U = SA_Q + 512 * 1024, SA_GV = SA_U + 512 * 1024, SA_SGA = SA_GV + 512 * 1024, SA_SGB = SA_SGA + 512 * 1024, SA_ATT = SA_SGB + 512 * 1024,
                 SA_SGU = SA_ATT + 512 * 1024, SA_SS = SA_SGU + 512 * 1024;
constexpr size_t WS_END = 493 * MiB;
static_assert(WS_SS + (size_t)MT * 16 * 4 <= WS_W1IN && WS_XN + (size_t)MT * DM * 2 <= WS_ACT && WS_ACT + (size_t)MT * LDF * 2 <= WS_F &&
              WS_F + (size_t)MT * DM * 4 <= WS_H && WS_H + (size_t)MT * DM * 4 <= WS_QB &&
              WS_GVB + (size_t)MT * DM * 2 <= WS_F && WS_SGU + (size_t)MT * DM * 2 <= WS_H && true &&
              WS_W2OUT + (size_t)DM * LDF * 2 <= WS_XN && WS_W1IN + (size_t)2 * DFF * DM * 2 <= WS_W1OUT && WS_W1OUT + (size_t)DM * LDF * 2 <= WS_WIN &&
              WS_WIN + (size_t)INC * DM * 2 <= WS_WA && WS_W2IN + (size_t)2 * DFF * DM * 2 <= WS_W2OUT, "d_ws map");
constexpr int CW_BAR = 4096;
constexpr int CW_CH = 2048;
constexpr int CW_Q = 1024;

constexpr int RING_BYTES = 131072, MISC_OFF = RING_BYTES + 320, LDS_BYTES = 147456;
constexpr int NWAVES = 8;

#define GAS __attribute__((address_space(1)))
#define LAS __attribute__((address_space(3)))
typedef unsigned short bf16;
typedef unsigned v4u __attribute__((ext_vector_type(4)));
typedef unsigned v2u __attribute__((ext_vector_type(2)));
typedef float f32x4 __attribute__((ext_vector_type(4)));
#define LDS_WAIT() asm volatile("s_waitcnt lgkmcnt(0)" ::: "memory")
__device__ __forceinline__ unsigned f2bf(float f) { unsigned u = __builtin_bit_cast(unsigned, f); return (u + 0x7fffu + ((u >> 16) & 1u)) >> 16; }
__device__ __forceinline__ unsigned pk2(float lo, float hi) { return f2bf(lo) | (f2bf(hi) << 16); }
__device__ __forceinline__ float bf2f(unsigned short b) { return __builtin_bit_cast(float, (unsigned)b << 16); }
__device__ __forceinline__ float bflo(unsigned w) { return __builtin_bit_cast(float, w << 16); }
__device__ __forceinline__ float bfhi(unsigned w) { return __builtin_bit_cast(float, w & 0xffff0000u); }
__device__ __forceinline__ float wave_sum(float v) {
#pragma unroll
    for (int o = 1; o < 64; o <<= 1) v += __shfl_xor(v, o);
    return v;
}
__device__ __forceinline__ float fast_rcp(float x) { return __builtin_amdgcn_rcpf(x); }
__device__ __forceinline__ float sigmoidf_(float x) { return fast_rcp(1.0f + __builtin_amdgcn_exp2f(-1.4426950408889634f * x)); }
__device__ __forceinline__ float siluf_(float x) { return x * sigmoidf_(x); }
__device__ __forceinline__ float geluf_(float x) { const float z = 1.5957691216057308f * (x + 0.044715f * x * x * x); return x * sigmoidf_(z); }

namespace pg8 {
struct EpiSwiglu {
    static constexpr bool PERM = true, DUAL = false;
    bf16_t* O;
    __device__ __forceinline__ void operator()(const f32x4 (&acc)[2][2][4][2], const Unit& u, int wr, int wc, int fr, int fq) const {
        const int row0 = u.pm * BM + wr * 64 + fr, col0 = u.pn * 128 + wc * 32 + 8 * fq;
#pragma unroll
        for (int ai = 0; ai < 2; ++ai)
#pragma unroll
            for (int m = 0; m < 4; ++m) {
                const f32x4 a0 = acc[ai][0][m][0], a1 = acc[ai][0][m][1], b0 = acc[ai][1][m][0], b1 = acc[ai][1][m][1];
                u32x4 w;
                w.x = cvt_pk_bf16(siluf_(a0[0]) * b0[0], siluf_(a0[1]) * b0[1]); w.y = cvt_pk_bf16(siluf_(a0[2]) * b0[2], siluf_(a0[3]) * b0[3]);
                w.z = cvt_pk_bf16(siluf_(a1[0]) * b1[0], siluf_(a1[1]) * b1[1]); w.w = cvt_pk_bf16(siluf_(a1[2]) * b1[2], siluf_(a1[3]) * b1[3]);
                *(u32x4*)(O + (size_t)(row0 + ai * HALF + m * 16) * LDF + col0) = w;
            }
    }
};
struct EpiF32Stats {
    static constexpr bool PERM = true, DUAL = false;
    bf16_t* O; float* SS;
    __device__ __forceinline__ void operator()(const f32x4 (&acc)[2][2][4][2], const Unit& u, int wr, int wc, int fr, int fq) const {
        const int row0 = u.pm * BM + wr * 64 + fr, col0 = u.pn * BM + wc * 32 + 8 * fq;
#pragma unroll
        for (int ai = 0; ai < 2; ++ai)
#pragma unroll
            for (int m = 0; m < 4; ++m) {
                const int row = row0 + ai * HALF + m * 16; float s = 0.f;
#pragma unroll
                for (int bj = 0; bj < 2; ++bj) { const f32x4 v0 = acc[ai][bj][m][0], v1 = acc[ai][bj][m][1];
                    u32x4 w; w.x = cvt_pk_bf16(v0[0], v0[1]); w.y = cvt_pk_bf16(v0[2], v0[3]); w.z = cvt_pk_bf16(v1[0], v1[1]); w.w = cvt_pk_bf16(v1[2], v1[3]);
                    *(u32x4*)(O + (size_t)row * DM + col0 + bj * HALF) = w;
                    s += (v0[0] * v0[0] + v0[1] * v0[1]) + (v0[2] * v0[2] + v0[3] * v0[3]) + (v1[0] * v1[0] + v1[1] * v1[1]) + (v1[2] * v1[2] + v1[3] * v1[3]); }
                s += __shfl_xor(s, 16); s += __shfl_xor(s, 32);
                if (fq == 0) SS[(size_t)row * 16 + u.pn * 4 + wc] = s;
            }
    }
};
struct EpiProj {
    static constexpr bool PERM = true, DUAL = false;
    bf16_t *Qb, *Kp, *Vp, *Ub, *GVb, *SGA, *SGB; float* kout; float* vout; float* SS; const float* rope; bool samp;
    __device__ __forceinline__ void operator()(const f32x4 (&acc)[2][2][4][2], const Unit& u, int wr, int wc, int fr, int fq) const {
        const int type = u.pn >> 2, cb = (u.pn & 3) * 256;
        const int row0 = u.pm * BM + wr * 64 + fr, col0 = cb + wc * 32 + 8 * fq;
        if (type <= 1) {
            const bool ropew = ((wc & 1) == 0);
#pragma unroll
            for (int ai = 0; ai < 2; ++ai)
#pragma unroll
                for (int m = 0; m < 4; ++m) {
                    const int row = row0 + ai * HALF + m * 16;
                    f32x4 v[2][2];
#pragma unroll
                    for (int bj = 0; bj < 2; ++bj)
#pragma unroll
                        for (int n = 0; n < 2; ++n) v[bj][n] = acc[ai][bj][m][n];
                    if (ropew) {
                        const int pos = samp ? (PAST + (row & 15)) : row;
                        const f32x4* cp = (const f32x4*)(rope + (size_t)pos * 16);
                        const f32x4 cs[2] = {cp[0], cp[1]}, sn[2] = {cp[2], cp[3]};
#pragma unroll
                        for (int bj = 0; bj < 2; ++bj)
#pragma unroll
                            for (int n = 0; n < 2; ++n)
#pragma unroll
                                for (int e = 0; e < 4; ++e) {
                                    const float x = v[bj][n][e], p = __shfl_xor(x, 16);
                                    const float sgn = (fq == 0) ? -sn[n][e] : sn[n][e];
                                    const float rot = x * cs[n][e] + p * sgn;
                                    v[bj][n][e] = (fq < 2) ? rot : x;
                                }
                    }
                    if (type == 0) {
#pragma unroll
                        for (int bj = 0; bj < 2; ++bj) {
                            u32x4 w; w.x = cvt_pk_bf16(v[bj][0][0] * C2, v[bj][0][1] * C2); w.y = cvt_pk_bf16(v[bj][0][2] * C2, v[bj][0][3] * C2);
                            w.z = cvt_pk_bf16(v[bj][1][0] * C2, v[bj][1][1] * C2); w.w = cvt_pk_bf16(v[bj][1][2] * C2, v[bj][1][3] * C2);
                            *(u32x4*)(Qb + (size_t)row * DM + col0 + bj * HALF) = w;
                        }
                    } else {
                        float* kp = kout + (size_t)row * DM;
#pragma unroll
                        for (int bj = 0; bj < 2; ++bj) {
                            if (samp) { *(f32x4*)(kp + col0 + bj * HALF) = v[bj][0]; *(f32x4*)(kp + col0 + bj * HALF + 4) = v[bj][1]; }
                            if (!samp) {
                                u32x4 w; w.x = cvt_pk_bf16(v[bj][0][0], v[bj][0][1]); w.y = cvt_pk_bf16(v[bj][0][2], v[bj][0][3]);
                                w.z = cvt_pk_bf16(v[bj][1][0], v[bj][1][1]); w.w = cvt_pk_bf16(v[bj][1][2], v[bj][1][3]);
                                *(u32x4*)(Kp + (size_t)row * DM + col0 + bj * HALF) = w;
                            }
                        }
                    }
                }
        } else if (type == 2) {
#pragma unroll
            for (int ai = 0; ai < 2; ++ai)
#pragma unroll
                for (int m = 0; m < 4; ++m) {
                    const int row = row0 + ai * HALF + m * 16;
                    float* vp = vout + (size_t)row * DM;
#pragma unroll
                    for (int bj = 0; bj < 2; ++bj) {
                        const f32x4 v0 = acc[ai][bj][m][0], v1 = acc[ai][bj][m][1];
                        if (samp) { *(f32x4*)(vp + col0 + bj * HALF) = v0; *(f32x4*)(vp + col0 + bj * HALF + 4) = v1; }
                        if (!samp) {
                            const int c8 = col0 + bj * HALF, hh = c8 >> 7, cc = c8 & 127;
                            bf16_t* vt = Vp + (((size_t)(hh * (SEQ / 64) + (row >> 6)) * 128 + cc) << 6) + (row & 63);
                            vt[0 * 64] = (bf16_t)(cvt_pk_bf16(v0[0], 0.f) & 0xffffu); vt[1 * 64] = (bf16_t)(cvt_pk_bf16(v0[1], 0.f) & 0xffffu);
                            vt[2 * 64] = (bf16_t)(cvt_pk_bf16(v0[2], 0.f) & 0xffffu); vt[3 * 64] = (bf16_t)(cvt_pk_bf16(v0[3], 0.f) & 0xffffu);
                            vt[4 * 64] = (bf16_t)(cvt_pk_bf16(v1[0], 0.f) & 0xffffu); vt[5 * 64] = (bf16_t)(cvt_pk_bf16(v1[1], 0.f) & 0xffffu);
                            vt[6 * 64] = (bf16_t)(cvt_pk_bf16(v1[2], 0.f) & 0xffffu); vt[7 * 64] = (bf16_t)(cvt_pk_bf16(v1[3], 0.f) & 0xffffu);
                        }
                    }
                }
        } else if (type <= 4) {
            bf16_t* O = (type == 3) ? Ub : GVb;
#pragma unroll
            for (int ai = 0; ai < 2; ++ai)
#pragma unroll
                for (int m = 0; m < 4; ++m) {
                    const int row = row0 + ai * HALF + m * 16; float s = 0.f;
#pragma unroll
                    for (int bj = 0; bj < 2; ++bj) {
                        f32x4 v0 = acc[ai][bj][m][0], v1 = acc[ai][bj][m][1];
#pragma unroll
                        for (int e = 0; e < 4; ++e) { v0[e] = geluf_(v0[e]); v1[e] = geluf_(v1[e]); }
                        s += (v0[0] * v0[0] + v0[1] * v0[1]) + (v0[2] * v0[2] + v0[3] * v0[3]) + (v1[0] * v1[0] + v1[1] * v1[1]) + (v1[2] * v1[2] + v1[3] * v1[3]);
                        u32x4 w; w.x = cvt_pk_bf16(v0[0], v0[1]); w.y = cvt_pk_bf16(v0[2], v0[3]); w.z = cvt_pk_bf16(v1[0], v1[1]); w.w = cvt_pk_bf16(v1[2], v1[3]);
                        *(u32x4*)(O + (size_t)row * DM + col0 + bj * HALF) = w;
                    }
                    if (type == 4) { s += __shfl_xor(s, 16); s += __shfl_xor(s, 32); if (fq == 0) SS[(size_t)row * 16 + (u.pn & 3) * 4 + wc] = s; }
                }
        } else {
            bf16_t* O = (type == 5) ? SGA : SGB;
#pragma unroll
            for (int ai = 0; ai < 2; ++ai)
#pragma unroll
                for (int m = 0; m < 4; ++m) {
                    const int row = row0 + ai * HALF + m * 16;
#pragma unroll
                    for (int bj = 0; bj < 2; ++bj) {
                        const f32x4 v0 = acc[ai][bj][m][0], v1 = acc[ai][bj][m][1];
#ifdef EXP_CONST
                        u32x4 w; w.x = 0x3f803f80u; w.y = 0x3f803f80u; w.z = 0x3f803f80u; w.w = 0x3f803f80u; (void)v0; (void)v1;
#else
                        u32x4 w; w.x = cvt_pk_bf16(sigmoidf_(v0[0]), sigmoidf_(v0[1])); w.y = cvt_pk_bf16(sigmoidf_(v0[2]), sigmoidf_(v0[3]));
                        w.z = cvt_pk_bf16(sigmoidf_(v1[0]), sigmoidf_(v1[1])); w.w = cvt_pk_bf16(sigmoidf_(v1[2]), sigmoidf_(v1[3]));
#endif
                        *(u32x4*)(O + (size_t)row * DM + col0 + bj * HALF) = w;
                    }
                }
        }
    }
};
struct EpiGateA {
    static constexpr bool PERM = false, DUAL = false;
    float* T1; const bf16_t* SG;
    __device__ __forceinline__ void operator()(const f32x4 (&acc)[2][2][4][2], const Unit& u, int wr, int wc, int fr, int fq) const {
        const int row0 = u.pm * BM + wr * 64 + fr, col0 = u.pn * BM + wc * 32 + 4 * fq;
#pragma unroll
        for (int ai = 0; ai < 2; ++ai)
#pragma unroll
            for (int m = 0; m < 4; ++m) {
                const size_t ro = (size_t)(row0 + ai * HALF + m * 16) * DM + col0;
#pragma unroll
                for (int bj = 0; bj < 2; ++bj)
#pragma unroll
                    for (int n = 0; n < 2; ++n) {
                        const u32x2 g = *(const u32x2*)(SG + ro + bj * HALF + n * 16); const f32x4 v = acc[ai][bj][m][n];
                        f32x4 o; o[0] = v[0] * bflo(g.x); o[1] = v[1] * bfhi(g.x); o[2] = v[2] * bflo(g.y); o[3] = v[3] * bfhi(g.y);
                        *(f32x4*)(T1 + ro + bj * HALF + n * 16) = o;
                    }
            }
    }
};
struct EpiGateB {
    static constexpr bool PERM = true, DUAL = false;
    const float* T1; const bf16_t* SG; bf16_t* O;
    __device__ __forceinline__ void operator()(const f32x4 (&acc)[2][2][4][2], const Unit& u, int wr, int wc, int fr, int fq) const {
        const int row0 = u.pm * BM + wr * 64 + fr, col0 = u.pn * BM + wc * 32 + 8 * fq;
#pragma unroll
        for (int ai = 0; ai < 2; ++ai)
#pragma unroll
            for (int m = 0; m < 4; ++m) {
                const size_t ro = (size_t)(row0 + ai * HALF + m * 16) * DM + col0;
#pragma unroll
                for (int bj = 0; bj < 2; ++bj) {
                    const u32x4 g = *(const u32x4*)(SG + ro + bj * HALF);
                    const f32x4 t0 = *(const f32x4*)(T1 + ro + bj * HALF), t1 = *(const f32x4*)(T1 + ro + bj * HALF + 4);
                    const f32x4 v0 = acc[ai][bj][m][0], v1 = acc[ai][bj][m][1];
                    u32x4 w;
#ifndef GATEB_MODE
#define GATEB_MODE 0
#endif
                    const float ka = (GATEB_MODE == 2) ? 0.f : 1.f, kb = (GATEB_MODE == 1) ? 0.f : 1.f;
                    w.x = cvt_pk_bf16(ka * t0[0] + kb * v0[0] * bflo(g.x), ka * t0[1] + kb * v0[1] * bfhi(g.x)); w.y = cvt_pk_bf16(ka * t0[2] + kb * v0[2] * bflo(g.y), ka * t0[3] + kb * v0[3] * bfhi(g.y));
                    w.z = cvt_pk_bf16(ka * t1[0] + kb * v1[0] * bflo(g.z), ka * t1[1] + kb * v1[1] * bfhi(g.z)); w.w = cvt_pk_bf16(ka * t1[2] + kb * v1[2] * bflo(g.w), ka * t1[3] + kb * v1[3] * bfhi(g.w));
                    *(u32x4*)(O + ro + bj * HALF) = w;
                }
            }
    }
};
struct EpiGateAB {
    static constexpr bool PERM = true, DUAL = true;
    const bf16_t* SGa; const bf16_t* SGb; bf16_t* O;
    __device__ __forceinline__ void operator()(f32x4 (&acc)[2][2][4][2], const Unit& u, int wr, int wc, int fr, int fq) const {
        const int row0 = u.pm * BM + wr * 64 + fr, col0 = u.pn * BM + wc * 32 + 8 * fq;
#pragma unroll
        for (int ai = 0; ai < 2; ++ai)
#pragma unroll
            for (int m = 0; m < 4; ++m) {
                const size_t ro = (size_t)(row0 + ai * HALF + m * 16) * DM + col0;
#pragma unroll
                for (int bj = 0; bj < 2; ++bj) {
                    const u32x4 gb = *(const u32x4*)(SGb + ro + bj * HALF);
                    f32x4& v0 = acc[ai][bj][m][0]; f32x4& v1 = acc[ai][bj][m][1];
                    if (u.w == 0) {
                        const u32x4 ga = *(const u32x4*)(SGa + ro + bj * HALF);
                        v0[0] *= bflo(ga.x) * __builtin_amdgcn_rcpf(bflo(gb.x)); v0[1] *= bfhi(ga.x) * __builtin_amdgcn_rcpf(bfhi(gb.x));
                        v0[2] *= bflo(ga.y) * __builtin_amdgcn_rcpf(bflo(gb.y)); v0[3] *= bfhi(ga.y) * __builtin_amdgcn_rcpf(bfhi(gb.y));
                        v1[0] *= bflo(ga.z) * __builtin_amdgcn_rcpf(bflo(gb.z)); v1[1] *= bfhi(ga.z) * __builtin_amdgcn_rcpf(bfhi(gb.z));
                        v1[2] *= bflo(ga.w) * __builtin_amdgcn_rcpf(bflo(gb.w)); v1[3] *= bfhi(ga.w) * __builtin_amdgcn_rcpf(bfhi(gb.w));
                    } else {
                        u32x4 w;
                        w.x = cvt_pk_bf16(v0[0] * bflo(gb.x), v0[1] * bfhi(gb.x)); w.y = cvt_pk_bf16(v0[2] * bflo(gb.y), v0[3] * bfhi(gb.y));
                        w.z = cvt_pk_bf16(v1[0] * bflo(gb.z), v1[1] * bfhi(gb.z)); w.w = cvt_pk_bf16(v1[2] * bflo(gb.w), v1[3] * bfhi(gb.w));
                        *(u32x4*)(O + ro + bj * HALF) = w;
                    }
                }
            }
    }
};
}

namespace att {
using bf16x8 = __attribute__((ext_vector_type(8))) short;
using s16x4 = __attribute__((ext_vector_type(4))) short;
using f32x16 = __attribute__((ext_vector_type(16))) float;
using f32x8 = __attribute__((ext_vector_type(8))) float;
using u32x4 = __attribute__((ext_vector_type(4))) unsigned;
constexpr int KVBLK = 64, LDR = 1024;
constexpr int SHM_V = KVBLK * 128 * 2, SHM_K = KVBLK * 128 * 2, SHM_ATTN = 3 * SHM_V + 3 * SHM_K + 8 * 64 * 4;
constexpr float THRL = 8.f;
#define KSWZ(row, colB) ((row) * 256 + ((colB) ^ (((row) & 15) << 4)))
#define SBAR() __builtin_amdgcn_sched_barrier(0)
__device__ __forceinline__ int crow(int r, int hi) { return (r & 3) + 8 * (r >> 2) + 4 * hi; }
__device__ __forceinline__ unsigned cvtpk(float lo, float hi) { return pg8::cvt_pk_bf16(lo, hi); }
__device__ __forceinline__ bf16x8 tobf(f32x8 x) { u32x4 w = {cvtpk(x[0], x[1]), cvtpk(x[2], x[3]), cvtpk(x[4], x[5]), cvtpk(x[6], x[7])}; return *reinterpret_cast<bf16x8*>(&w); }

__device__ __forceinline__ void partialSM(f32x16& p0, f32x16& p1, float& m_reg, float& alpha) {
    float m0 = fmaxf(fmaxf(p0[0], p0[1]), p0[2]), m1 = fmaxf(fmaxf(p0[3], p0[4]), p0[5]), m2 = fmaxf(fmaxf(p1[0], p1[1]), p1[2]), m3 = fmaxf(fmaxf(p1[3], p1[4]), p1[5]);
    m0 = fmaxf(fmaxf(m0, p0[6]), p0[7]); m1 = fmaxf(fmaxf(m1, p0[8]), p0[9]); m2 = fmaxf(fmaxf(m2, p1[6]), p1[7]); m3 = fmaxf(fmaxf(m3, p1[8]), p1[9]);
    m0 = fmaxf(fmaxf(m0, p0[10]), p0[11]); m1 = fmaxf(fmaxf(m1, p0[12]), p0[13]); m2 = fmaxf(fmaxf(m2, p1[10]), p1[11]); m3 = fmaxf(fmaxf(m3, p1[12]), p1[13]);
    m0 = fmaxf(fmaxf(m0, p0[14]), p0[15]); m2 = fmaxf(fmaxf(m2, p1[14]), p1[15]);
    float pmax = fmaxf(fmaxf(m0, m1), fmaxf(m2, m3));
    { auto rr = __builtin_amdgcn_permlane32_swap(__float_as_uint(pmax), __float_as_uint(pmax), false, false);
      pmax = fmaxf(__uint_as_float(rr[0]), __uint_as_float(rr[1])); }
    float mn;
    if (__builtin_expect(__all(pmax - m_reg <= THRL), 1)) { mn = m_reg; alpha = 1.f; }
    else { mn = fmaxf(m_reg, pmax); alpha = __builtin_amdgcn_exp2f(m_reg - mn); m_reg = mn; }
#pragma unroll
    for (int r = 0; r < 16; ++r) p0[r] = p0[r] - mn;
#pragma unroll
    for (int r = 0; r < 16; ++r) p1[r] = p1[r] - mn;
#pragma unroll
    for (int r = 0; r < 16; ++r) p0[r] = __builtin_amdgcn_exp2f(p0[r]);
}
__device__ __forceinline__ void finishSM(f32x16& p0, f32x16& p1, float alpha, float& l_reg, bf16x8& pa0, bf16x8& pa1, bf16x8& pa2, bf16x8& pa3) {
#pragma unroll
    for (int r = 0; r < 16; ++r) p1[r] = __builtin_amdgcn_exp2f(p1[r]);
    float s0 = p0[0] + p0[1], s1 = p0[2] + p0[3], s2 = p1[0] + p1[1], s3 = p1[2] + p1[3];
#pragma unroll
    for (int r = 4; r < 16; r += 2) { if (r & 2) { s1 += p0[r] + p0[r + 1]; s3 += p1[r] + p1[r + 1]; } else { s0 += p0[r] + p0[r + 1]; s2 += p1[r] + p1[r + 1]; } }
    float ps = (s0 + s1) + (s2 + s3);
    { auto rr = __builtin_amdgcn_permlane32_swap(__float_as_uint(ps), __float_as_uint(ps), false, false);
      ps = __uint_as_float(rr[0]) + __uint_as_float(rr[1]); }
    l_reg = l_reg * alpha + ps;
#define PK4(P, BASE, OUT) do { unsigned a0 = cvtpk(P[BASE + 0], P[BASE + 1]), a1 = cvtpk(P[BASE + 2], P[BASE + 3]);   \
    unsigned b0 = cvtpk(P[BASE + 4], P[BASE + 5]), b1 = cvtpk(P[BASE + 6], P[BASE + 7]);                              \
    auto r0 = __builtin_amdgcn_permlane32_swap(a0, b0, false, false); auto r1 = __builtin_amdgcn_permlane32_swap(a1, b1, false, false); \
    u32x4 w = {r0[0], r1[0], r0[1], r1[1]}; OUT = *reinterpret_cast<bf16x8*>(&w); } while (0)
    PK4(p0, 0, pa0); PK4(p0, 8, pa1); PK4(p1, 0, pa2); PK4(p1, 8, pa3);
#undef PK4
}
__device__ __forceinline__ void qkt(f32x16& p0, f32x16& p1, const char* Ks, const bf16x8* qr, int r32, int hi, int sub) {
    p0 = f32x16{}; p1 = f32x16{};
#pragma unroll
    for (int d0 = 0; d0 < 4; ++d0) { const int cb = (sub * 64 + d0 * 16 + hi * 8) * 2;
        const bf16x8 b0 = *reinterpret_cast<const bf16x8*>(Ks + KSWZ(r32, cb));
        const bf16x8 b1 = *reinterpret_cast<const bf16x8*>(Ks + KSWZ(32 + r32, cb));
        p0 = __builtin_amdgcn_mfma_f32_32x32x16_bf16(b0, qr[d0], p0, 0, 0, 0);
        p1 = __builtin_amdgcn_mfma_f32_32x32x16_bf16(b1, qr[d0], p1, 0, 0, 0); }
}
__device__ __forceinline__ int v_st(int k, int c) { const int kk = (k & ~0xC) | ((k & 4) << 1) | ((k & 8) >> 1); return ((kk >> 3) * 4 + (c >> 5)) * 512 + ((kk & 7) * 32 + (c & 31)) * 2; }
__device__ __forceinline__ int v_rd_base(int lane) { return ((lane & 3) << 3) | (((lane >> 2) & 3) << 6) | (((lane >> 4) & 1) << 5) | (((lane >> 5) & 1) << 8); }
constexpr int v_rd_off(int d0, int ks, int half) { return d0 * 512 + ks * 4096 + half * 2048; }
typedef short v4i16_t __attribute__((ext_vector_type(4)));
typedef __attribute__((address_space(3))) const char* lds_cptr;
template <int OFF> __device__ __forceinline__ s16x4 tr_read(lds_cptr vp) {
    return __builtin_bit_cast(s16x4, __builtin_amdgcn_ds_read_tr16_b64_v4i16((__attribute__((address_space(3))) v4i16_t*)(vp + OFF)));
}
template <int D0> __device__ __forceinline__ void pv_one(f32x16& od, lds_cptr vb, bf16x8 pa0, bf16x8 pa1, bf16x8 pa2, bf16x8 pa3) {
    const s16x4 l0 = tr_read<v_rd_off(D0, 0, 0)>(vb), h0 = tr_read<v_rd_off(D0, 0, 1)>(vb), l1 = tr_read<v_rd_off(D0, 1, 0)>(vb), h1 = tr_read<v_rd_off(D0, 1, 1)>(vb);
    const s16x4 l2 = tr_read<v_rd_off(D0, 2, 0)>(vb), h2 = tr_read<v_rd_off(D0, 2, 1)>(vb), l3 = tr_read<v_rd_off(D0, 3, 0)>(vb), h3 = tr_read<v_rd_off(D0, 3, 1)>(vb);
#define PK(L, H) (bf16x8){L[0], L[1], L[2], L[3], H[0], H[1], H[2], H[3]}
    od = __builtin_amdgcn_mfma_f32_32x32x16_bf16(pa0, PK(l0, h0), od, 0, 0, 0);
    od = __builtin_amdgcn_mfma_f32_32x32x16_bf16(pa1, PK(l1, h1), od, 0, 0, 0);
    od = __builtin_amdgcn_mfma_f32_32x32x16_bf16(pa2, PK(l2, h2), od, 0, 0, 0);
    od = __builtin_amdgcn_mfma_f32_32x32x16_bf16(pa3, PK(l3, h3), od, 0, 0, 0);
#undef PK
}
__device__ __forceinline__ void pv_t(f32x16* o, const char* vt, const int* ko, bf16x8 pa0, bf16x8 pa1, bf16x8 pa2, bf16x8 pa3) {
#pragma unroll
    for (int d0 = 0; d0 < 4; ++d0) {
        const bf16x8 b0 = *reinterpret_cast<const bf16x8*>(vt + d0 * 4096 + ko[0]), b1 = *reinterpret_cast<const bf16x8*>(vt + d0 * 4096 + ko[1]);
        const bf16x8 b2 = *reinterpret_cast<const bf16x8*>(vt + d0 * 4096 + ko[2]), b3 = *reinterpret_cast<const bf16x8*>(vt + d0 * 4096 + ko[3]);
        o[d0] = __builtin_amdgcn_mfma_f32_32x32x16_bf16(pa0, b0, o[d0], 0, 0, 0);
        o[d0] = __builtin_amdgcn_mfma_f32_32x32x16_bf16(pa1, b1, o[d0], 0, 0, 0);
        o[d0] = __builtin_amdgcn_mfma_f32_32x32x16_bf16(pa2, b2, o[d0], 0, 0, 0);
        o[d0] = __builtin_amdgcn_mfma_f32_32x32x16_bf16(pa3, b3, o[d0], 0, 0, 0);
    }
}
__device__ __forceinline__ void pv_d0(f32x16* o, lds_cptr vb, bf16x8 pa0, bf16x8 pa1, bf16x8 pa2, bf16x8 pa3) {
    pv_one<0>(o[0], vb, pa0, pa1, pa2, pa3); pv_one<1>(o[1], vb, pa0, pa1, pa2, pa3); pv_one<2>(o[2], vb, pa0, pa1, pa2, pa3); pv_one<3>(o[3], vb, pa0, pa1, pa2, pa3);
}

struct Args {
    const unsigned short* Qb; const unsigned short* Kp; const unsigned short* Vp;
    const float* cK; const float* cV;
    const float* nK; const float* nV;
    unsigned short* ATT; const float* gsub;
    const unsigned short* Qs; unsigned short* ATTs;
    float* kpo; float* vpo;
};

template <bool SAMPLE>
__device__ __forceinline__ void attn_unit(const Args& A, int h, int qi, char* lds, float lam) {
    asm volatile("" : "+s"(h), "+s"(qi));
    int tid = threadIdx.x; asm volatile("" : "+v"(tid));
    const int lane = tid & 63, r32 = lane & 31, hi = lane >> 5;
    const int wid = __builtin_amdgcn_readfirstlane(tid >> 6), sub = wid >> 2, rg = wid & 3;
    char* V_lds = lds; char* K_lds = lds + 2 * SHM_V;
    float* ws = (float*)(lds + 3 * SHM_V + 3 * SHM_K) + wid * 64; float* li_l = ws; float* al_l = ws + 32;
    const int NT = SAMPLE ? 33 : 2 * qi + 2;
    float m_reg = -1e30f, l_reg = 0; f32x16 o[4] = {}; bf16x8 qr[4];
    {
        const int qrow = SAMPLE ? (qi * 16 + (r32 & 15)) : (qi * 128 + rg * 32 + r32);
        const unsigned short* Qw = (SAMPLE ? A.Qs : A.Qb) + (size_t)qrow * LDR + h * 128 + sub * 64 + hi * 8;
#pragma unroll
        for (int d0 = 0; d0 < 4; ++d0) qr[d0] = *reinterpret_cast<const bf16x8*>(Qw + d0 * 16);
    }
    const int sr = tid >> 4, sc = (tid & 15) * 8;
    const int vcol0 = tid >> 3, vcol1 = 64 + (tid >> 3), vch = tid & 7;
    const int vst0 = SAMPLE ? v_st(sr, sc) : vcol0 * 128 + ((vch ^ ((vcol0 >> 1) & 7)) << 4), vst1 = SAMPLE ? v_st(32 + sr, sc) : vcol1 * 128 + ((vch ^ ((vcol1 >> 1) & 7)) << 4);
    const lds_cptr vb0 = (lds_cptr)V_lds + v_rd_base(lane);
    const char* vtb = V_lds + r32 * 128; int vko[4];
#pragma unroll
    for (int ks = 0; ks < 4; ++ks) vko[ks] = ((2 * ks + hi) ^ ((r32 >> 1) & 7)) << 4;
    constexpr int SDEPTH = SAMPLE ? 2 : 1;
    using ST = typename std::conditional<SAMPLE, f32x8, bf16x8>::type;
    struct { ST vs0, vs1, ks0, ks1; } sr_[SDEPTH];
    constexpr unsigned ESZ = SAMPLE ? 4u : 2u;
    const unsigned lo0 = (unsigned)(sr * LDR + sc) * ESZ, lo1 = lo0 + 32u * LDR * ESZ, lon = (unsigned)((sr & 15) * LDR + sc) * 4u;
    const __amdgpu_buffer_rsrc_t rK = __builtin_amdgcn_make_buffer_rsrc((void*)(SAMPLE ? (const void*)A.cK : (const void*)A.Kp), 0, SAMPLE ? 16 * PAST * LDR * 4 : SEQ * LDR * 2, 0x00020000);
    const __amdgpu_buffer_rsrc_t rV = __builtin_amdgcn_make_buffer_rsrc((void*)(SAMPLE ? (const void*)A.cV : (const void*)A.Vp), 0, SAMPLE ? 16 * PAST * LDR * 4 : SEQ * LDR * 2, 0x00020000);
    const __amdgpu_buffer_rsrc_t rKn = __builtin_amdgcn_make_buffer_rsrc((void*)A.nK, 0, 256 * LDR * 4, 0x00020000);
    const __amdgpu_buffer_rsrc_t rVn = __builtin_amdgcn_make_buffer_rsrc((void*)A.nV, 0, 256 * LDR * 4, 0x00020000);
    const unsigned sbase = SAMPLE ? (unsigned)((qi * PAST * LDR + h * 128) * 4) : (unsigned)(h * 256), sbn = (unsigned)((qi * 16 * LDR + h * 128) * 4);
    const unsigned vl0 = (unsigned)tid * 16u, vl1 = vl0 + 8192u, vsb = (unsigned)h * (unsigned)(SEQ / 64) * 16384u;
    auto cv = [](ST x) -> bf16x8 { if constexpr (SAMPLE) return tobf(x); else return x; };
    auto bld = [](__amdgpu_buffer_rsrc_t r, unsigned vo, unsigned so) -> ST {
        if constexpr (SAMPLE) { const u32x4 a = __builtin_amdgcn_raw_buffer_load_b128(r, vo, so, 0), b = __builtin_amdgcn_raw_buffer_load_b128(r, vo + 16u, so, 0);
            f32x8 o; o[0] = __uint_as_float(a[0]); o[1] = __uint_as_float(a[1]); o[2] = __uint_as_float(a[2]); o[3] = __uint_as_float(a[3]);
            o[4] = __uint_as_float(b[0]); o[5] = __uint_as_float(b[1]); o[6] = __uint_as_float(b[2]); o[7] = __uint_as_float(b[3]); return o; }
        else { const u32x4 a = __builtin_amdgcn_raw_buffer_load_b128(r, vo, so, 0); return __builtin_bit_cast(bf16x8, a); }
    };
#define SLOAD(i, t) do { if (SAMPLE && (t) >= 32) { \
        sr_[i].vs0 = bld(rVn, lon, sbn); sr_[i].vs1 = sr_[i].vs0; sr_[i].ks0 = bld(rKn, lon, sbn); sr_[i].ks1 = sr_[i].ks0; \
    } else { const unsigned so_ = sbase + (unsigned)(t) * (64u * LDR * ESZ); \
        if constexpr (SAMPLE) { sr_[i].vs0 = bld(rV, lo0, so_); sr_[i].vs1 = bld(rV, lo1, so_); } else { const unsigned sv_ = vsb + (unsigned)(t) * 16384u; sr_[i].vs0 = bld(rV, vl0, sv_); sr_[i].vs1 = bld(rV, vl1, sv_); } \
        sr_[i].ks0 = bld(rK, lo0, so_); sr_[i].ks1 = bld(rK, lo1, so_); } } while (0)
#define SWRITE(b, i) do { *(bf16x8*)(V_lds + (b) * SHM_V + vst0) = cv(sr_[i].vs0);          \
    *(bf16x8*)(V_lds + (b) * SHM_V + vst1) = cv(sr_[i].vs1); const int kc = sc * 2;               \
    *(bf16x8*)(K_lds + (b) * SHM_K + KSWZ(sr, kc)) = cv(sr_[i].ks0);                       \
    *(bf16x8*)(K_lds + (b) * SHM_K + KSWZ(32 + sr, kc)) = cv(sr_[i].ks1); } while (0)
#define SWAIT() do { if constexpr (SDEPTH == 2) asm volatile("s_waitcnt vmcnt(4)" ::: "memory"); else asm volatile("s_waitcnt vmcnt(0)" ::: "memory"); } while (0)
#define RESC(a) do { if (__any((a) < 1.f)) { if (hi == 0) al_l[r32] = (a); asm volatile("s_waitcnt lgkmcnt(0)" ::: "memory"); \
    _Pragma("unroll") for (int d = 0; d < 4; ++d) _Pragma("unroll") for (int r = 0; r < 16; ++r) o[d][r] *= al_l[crow(r, hi)]; } } while (0)
#define MASK(P0, P1, t) do { if constexpr (SAMPLE) { if ((t) >= 32) { _Pragma("unroll") for (int r = 0; r < 16; ++r) { if (crow(r, hi) >= 16) P0[r] = -INFINITY; P1[r] = -INFINITY; } } } \
    else { if ((t) == NT - 1 && rg < 2) { _Pragma("unroll") for (int r = 0; r < 16; ++r) { P0[r] = -INFINITY; P1[r] = -INFINITY; } } } } while (0)
    bf16x8 pa0, pa1, pa2, pa3;
    if constexpr (SAMPLE) {
        f32x16 pA0, pA1; float alA = 1.f;
        SLOAD(0, 0); SLOAD(1, 1);
#define STILE(t, SL) do { SWRITE(SL, SL); if ((t) + 2 < NT) SLOAD(SL, (t) + 2); __syncthreads(); \
            if (rg == 0) { SBAR(); qkt(pA0, pA1, K_lds + (SL) * SHM_K, qr, r32, hi, sub); MASK(pA0, pA1, t); partialSM(pA0, pA1, m_reg, alA); RESC(alA); \
                finishSM(pA0, pA1, alA, l_reg, pa0, pa1, pa2, pa3); SBAR(); pv_d0(o, vb0 + (SL) * SHM_V, pa0, pa1, pa2, pa3); } } while (0)
        for (int t = 0; t + 1 < NT; t += 2) { STILE(t, 0); STILE(t + 1, 1); }
        STILE(NT - 1, 0);
#undef STILE
        __syncthreads();
    } else {
    f32x16 S0, S1; float alpha = 1.f; bf16x8 kf[4], vf[8], pl, ph_, pbl, pbh;
    const int grp = sub;
    typedef __attribute__((address_space(3))) unsigned lds_u;
    char* Kr = lds + 3 * SHM_V;
    int so_p = 2 * SHM_K, so_c = 0, so_n = SHM_K;
    const int krow0 = 8 * wid + (lane >> 4), krow1 = krow0 + 4, vcl0 = 16 * wid + (lane >> 3), vcl1 = vcl0 + 8;
    const unsigned kdo0 = (unsigned)krow0 * (LDR * 2u) + (unsigned)(((lane & 15) ^ (krow0 & 15)) << 4), kdo1 = (unsigned)krow1 * (LDR * 2u) + (unsigned)(((lane & 15) ^ (krow1 & 15)) << 4);
    const unsigned vdo0 = (unsigned)vcl0 * 128u + (unsigned)(((lane & 7) ^ ((vcl0 >> 1) & 7)) << 4), vdo1 = (unsigned)vcl1 * 128u + (unsigned)(((lane & 7) ^ ((vcl1 >> 1) & 7)) << 4);
#define KDMA_(t, so) do { const unsigned s_ = sbase + (unsigned)(t) * (64u * LDR * 2u); \
        __builtin_amdgcn_raw_ptr_buffer_load_lds(rK, (lds_u*)(Kr + (so) + wid * 2048), 16, kdo0, s_, 0, 0); \
        __builtin_amdgcn_raw_ptr_buffer_load_lds(rK, (lds_u*)(Kr + (so) + wid * 2048 + 1024), 16, kdo1, s_, 0, 0); } while (0)
#define VDMA_(t, so) do { const unsigned s_ = vsb + (unsigned)(t) * 16384u; \
        __builtin_amdgcn_raw_ptr_buffer_load_lds(rV, (lds_u*)(V_lds + (so) + wid * 2048), 16, vdo0, s_, 0, 0); \
        __builtin_amdgcn_raw_ptr_buffer_load_lds(rV, (lds_u*)(V_lds + (so) + wid * 2048 + 1024), 16, vdo1, s_, 0, 0); } while (0)
#define DST_(t) do { if ((t) + 3 < NT) KDMA_((t) + 3, so_c); if ((t) + 2 < NT) VDMA_((t) + 2, so_p); } while (0)
#define WAITV_(t) do { if ((t) + 2 < NT) asm volatile("s_waitcnt vmcnt(4)" ::: "memory"); else asm volatile("s_waitcnt vmcnt(0)" ::: "memory"); } while (0)
#define ROT_() do { const int t_ = so_p; so_p = so_c; so_c = so_n; so_n = t_; } while (0)
#define MEET_() do { asm volatile("s_waitcnt lgkmcnt(0)" ::: "memory"); __builtin_amdgcn_s_barrier(); asm volatile("" ::: "memory"); } while (0)
#define LSEG(HAVE_K, KSO, KH, HAVE_V, VSO, VH, STG, WT) do { \
        if (HAVE_K) { const char* kb_ = Kr + (KSO); \
            _Pragma("unroll") for (int d0 = 0; d0 < 4; ++d0) kf[d0] = *reinterpret_cast<const bf16x8*>(kb_ + KSWZ(32 * (KH) + r32, (sub * 64 + d0 * 16 + hi * 8) * 2)); } \
        if (HAVE_V) { const char* vb_ = vtb + (VSO); \
            _Pragma("unroll") for (int d0 = 0; d0 < 4; ++d0) { vf[2 * d0] = *reinterpret_cast<const bf16x8*>(vb_ + d0 * 4096 + vko[2 * (VH)]); vf[2 * d0 + 1] = *reinterpret_cast<const bf16x8*>(vb_ + d0 * 4096 + vko[2 * (VH) + 1]); } } \
        STG; \
        if ((WT) >= 0 && grp == 1) WAITV_(WT); \
        MEET_(); } while (0)
#define MF_(acc, A_, B_) acc = __builtin_amdgcn_mfma_f32_32x32x16_bf16(A_, B_, acc, 0, 0, 0)
#define EX_(SC, i) SC[i] = __builtin_amdgcn_exp2f(SC[i])
#define PKH_(SC, B0, OUT) do { const unsigned a0_ = cvtpk(SC[B0 + 0], SC[B0 + 1]), a1_ = cvtpk(SC[B0 + 2], SC[B0 + 3]), b0_ = cvtpk(SC[B0 + 4], SC[B0 + 5]), b1_ = cvtpk(SC[B0 + 6], SC[B0 + 7]); \
        auto r0_ = __builtin_amdgcn_permlane32_swap(a0_, b0_, false, false); auto r1_ = __builtin_amdgcn_permlane32_swap(a1_, b1_, false, false); \
        u32x4 w_ = {r0_[0], r1_[0], r0_[1], r1_[1]}; OUT = *reinterpret_cast<bf16x8*>(&w_); } while (0)
#define GQ_(HAVE_QK, X) do { SBAR(); if (HAVE_QK) { X; } SBAR(); } while (0)
#define CSEG(HAVE_QK, HAVE_PV, HAVE_SM, FIRST, SC, SN, PRL, PRH, PWL, PWH, WT) do { \
        float s0_ = 0.f, s1_ = 0.f, s2_ = 0.f, s3_ = 0.f, pmax_ = pmx, dlt_ = 0.f, n0_ = 0.f, n1_ = 0.f, n2_ = 0.f, n3_ = 0.f; bool ok_ = true; \
        unsigned c0_ = 0, c1_ = 0, c2_ = 0, c3_ = 0, c4_ = 0, c5_ = 0, c6_ = 0, c7_ = 0; \
        __builtin_amdgcn_s_setprio(2); \
        GQ_(HAVE_QK, SN = __builtin_amdgcn_mfma_f32_32x32x16_bf16(kf[0], qr[0], negm, 0, 0, 0)); \
        if (HAVE_SM) { ok_ = (FIRST) ? false : (bool)__all(pmax_ <= THRL);        \
            if (__builtin_expect(!ok_, 0)) { { auto rr_ = __builtin_amdgcn_permlane32_swap(__float_as_uint(pmax_), __float_as_uint(pmax_), false, false); pmax_ = fmaxf(__uint_as_float(rr_[0]), __uint_as_float(rr_[1])); } \
                dlt_ = (FIRST) ? pmax_ : fmaxf(pmax_, 0.f); m_reg += dlt_; alpha = (FIRST) ? 1.f : __builtin_amdgcn_exp2f(-dlt_); l_reg *= alpha; \
                _Pragma("unroll") for (int r = 0; r < 16; ++r) SC[r] -= dlt_; } \
            EX_(SC, 0); EX_(SC, 1); } \
        GQ_(HAVE_QK, MF_(SN, kf[1], qr[1])); if (HAVE_SM) { EX_(SC, 2); EX_(SC, 3); EX_(SC, 4); } \
        GQ_(HAVE_QK, MF_(SN, kf[2], qr[2])); if (HAVE_SM) { EX_(SC, 5); EX_(SC, 6); EX_(SC, 7); } \
        GQ_(HAVE_QK, MF_(SN, kf[3], qr[3])); if (HAVE_SM) { EX_(SC, 8); EX_(SC, 9); EX_(SC, 10); } \
        GQ_(HAVE_PV, MF_(o[0], PRL, vf[0])); if (HAVE_SM) { EX_(SC, 11); EX_(SC, 12); EX_(SC, 13); } \
        GQ_(HAVE_PV, MF_(o[0], PRH, vf[1])); if (HAVE_SM) { EX_(SC, 14); EX_(SC, 15); c0_ = cvtpk(SC[0], SC[1]); c1_ = cvtpk(SC[2], SC[3]); } \
        GQ_(HAVE_PV, MF_(o[1], PRL, vf[2])); if (HAVE_SM) { c2_ = cvtpk(SC[4], SC[5]); c3_ = cvtpk(SC[6], SC[7]); \
            auto r0_ = __builtin_amdgcn_permlane32_swap(c0_, c2_, false, false); auto r1_ = __builtin_amdgcn_permlane32_swap(c1_, c3_, false, false); \
            u32x4 w_ = {r0_[0], r1_[0], r0_[1], r1_[1]}; PWL = *reinterpret_cast<bf16x8*>(&w_); } \
        if (HAVE_QK) { n0_ = fmaxf(fmaxf(SN[0], SN[1]), SN[2]); n1_ = fmaxf(fmaxf(SN[3], SN[4]), SN[5]); }        \
        GQ_(HAVE_PV, MF_(o[1], PRH, vf[3])); if (HAVE_SM) { c4_ = cvtpk(SC[8], SC[9]); c5_ = cvtpk(SC[10], SC[11]); c6_ = cvtpk(SC[12], SC[13]); c7_ = cvtpk(SC[14], SC[15]); } \
        if (HAVE_QK) { n2_ = fmaxf(fmaxf(SN[6], SN[7]), SN[8]); n3_ = fmaxf(fmaxf(SN[9], SN[10]), SN[11]); } \
        GQ_(HAVE_PV, MF_(o[2], PRL, vf[4])); if (HAVE_SM) { auto r0_ = __builtin_amdgcn_permlane32_swap(c4_, c6_, false, false); auto r1_ = __builtin_amdgcn_permlane32_swap(c5_, c7_, false, false); \
            u32x4 w_ = {r0_[0], r1_[0], r0_[1], r1_[1]}; PWH = *reinterpret_cast<bf16x8*>(&w_); } \
        if (HAVE_QK) { const float n4_ = fmaxf(fmaxf(SN[12], SN[13]), SN[14]); n0_ = fmaxf(fmaxf(n0_, n1_), n2_); n3_ = fmaxf(fmaxf(n3_, n4_), SN[15]); } \
        GQ_(HAVE_PV, MF_(o[2], PRH, vf[5])); if (HAVE_QK) pmx = fmaxf(n0_, n3_); \
        if (HAVE_SM) { s0_ = SC[0] + SC[1]; s1_ = SC[2] + SC[3]; s2_ = SC[4] + SC[5]; s3_ = SC[6] + SC[7]; s0_ += SC[8]; s1_ += SC[9]; s2_ += SC[10]; s3_ += SC[11]; \
            s0_ += SC[12]; s1_ += SC[13]; s2_ += SC[14]; s3_ += SC[15]; s0_ += s1_; s2_ += s3_; s0_ += s2_; l_reg += s0_; }    \
        GQ_(HAVE_PV, MF_(o[3], PRL, vf[6])); \
        GQ_(HAVE_PV, MF_(o[3], PRH, vf[7])); \
        SBAR(); \
        if (HAVE_SM) { if (__builtin_expect(!ok_, 0)) { if (!(FIRST)) RESC(alpha); \
            if (HAVE_QK) { _Pragma("unroll") for (int r = 0; r < 16; ++r) SN[r] -= dlt_; pmx -= dlt_; } \
            _Pragma("unroll") for (int r = 0; r < 16; ++r) negm[r] = -m_reg; } } \
        __builtin_amdgcn_s_setprio(0); if ((WT) >= 0 && grp == 0) WAITV_(WT); MEET_(); } while (0)
    float pmx = 0.f;
    f32x16 negm = {}; m_reg = 0.f;
    KDMA_(0, 0); VDMA_(0, 0); KDMA_(1, SHM_K); VDMA_(1, SHM_V); if (2 < NT) KDMA_(2, 2 * SHM_K);
    asm volatile("s_waitcnt vmcnt(0)" ::: "memory");
    MEET_();
    if (grp == 1) MEET_();
    LSEG(true, 0, 0, false, 0, 0, (void)0, -1);             CSEG(true, false, false, false, S1, S0, pbl, pbh, pl, ph_, -1);
    LSEG(true, so_c, 1, false, 0, 0, (void)0, 0);           CSEG(true, false, true, true, S0, S1, pbl, pbh, pl, ph_, 0);
    LSEG(true, so_n, 0, true, so_c, 0, DST_(0), -1);        CSEG(true, true, true, false, S1, S0, pl, ph_, pbl, pbh, -1);
    ROT_();
#pragma clang loop unroll(disable)
    for (int t = 1; t < NT - 1; ++t) {
        LSEG(true, so_c, 1, true, so_p, 1, (void)0, t);     CSEG(true, true, true, false, S0, S1, pbl, pbh, pl, ph_, t);
        LSEG(true, so_n, 0, true, so_c, 0, DST_(t), -1);    CSEG(true, true, true, false, S1, S0, pl, ph_, pbl, pbh, -1);
        ROT_();
    }
    if (rg < 2) {
        LSEG(false, 0, 0, true, so_p, 1, (void)0, NT - 1);  CSEG(false, true, false, false, S0, S1, pbl, pbh, pl, ph_, NT - 1);
        LSEG(false, 0, 0, false, 0, 0, (void)0, -1);        CSEG(false, false, false, false, S0, S1, pbl, pbh, pl, ph_, -1);
        LSEG(false, 0, 0, false, 0, 0, (void)0, -1);        CSEG(false, false, false, false, S0, S1, pbl, pbh, pl, ph_, -1);
    } else {
        LSEG(true, so_c, 1, true, so_p, 1, (void)0, NT - 1); CSEG(true, true, true, false, S0, S1, pbl, pbh, pl, ph_, NT - 1);
        LSEG(false, 0, 0, true, so_c, 0, (void)0, -1);       CSEG(false, true, true, false, S1, S0, pl, ph_, pbl, pbh, -1);
        LSEG(false, 0, 0, true, so_c, 1, (void)0, -1);       CSEG(false, true, false, false, S0, S1, pbl, pbh, pl, ph_, -1);
    }
    if (grp == 0) MEET_();
    { auto rr_ = __builtin_amdgcn_permlane32_swap(__float_as_uint(l_reg), __float_as_uint(l_reg), false, false); l_reg = __uint_as_float(rr_[0]) + __uint_as_float(rr_[1]); }
#undef KDMA_
#undef VDMA_
#undef DST_
#undef WAITV_
#undef ROT_
#undef MEET_
#undef GQ_
#undef MF_
#undef EX_
#undef PKH_
#undef LSEG
#undef CSEG
    }
#undef SLOAD
#undef SWRITE
#undef SWAIT
#undef RESC
#undef MASK
    if (hi == 0) li_l[r32] = l_reg;
    asm volatile("s_waitcnt lgkmcnt(0)" ::: "memory");
    __syncthreads();
    float* X = (float*)lds;
    if (sub == 1 && (!SAMPLE || rg == 0)) {
#pragma unroll
        for (int r = 0; r < 16; ++r) { const float rl = __builtin_amdgcn_rcpf(li_l[crow(r, hi)]);
#pragma unroll
            for (int d0 = 0; d0 < 4; ++d0) X[((rg * 4 + d0) * 16 + r) * 64 + lane] = o[d0][r] * rl; }
    }
    __syncthreads();
    if (sub == 0 && (!SAMPLE || rg == 0)) {
        float gs[4];
#pragma unroll
        for (int d0 = 0; d0 < 4; ++d0) gs[d0] = A.gsub[d0 * 32 + r32];
#pragma unroll
        for (int r = 0; r < 16; ++r) {
            const int cr = crow(r, hi);
            const float rl = __builtin_amdgcn_rcpf(li_l[cr]);
            float d[4]; float v = 0.f;
#pragma unroll
            for (int d0 = 0; d0 < 4; ++d0) { d[d0] = o[d0][r] * rl - lam * X[((rg * 4 + d0) * 16 + r) * 64 + lane]; v += d[d0] * d[d0]; }
            v += __shfl_xor(v, 1); v += __shfl_xor(v, 2); v += __shfl_xor(v, 4); v += __shfl_xor(v, 8); v += __shfl_xor(v, 16);
            const float sc_ = (1.0f - LAM_INIT) / sqrtf(v * (1.0f / 128.0f) + EPS);
            const bool ok = SAMPLE ? (cr < 16) : true;
            const int orow = SAMPLE ? (qi * 16 + cr) : (qi * 128 + rg * 32 + cr);
            if (ok) {
                unsigned short* op = (SAMPLE ? A.ATTs : A.ATT) + (size_t)orow * LDR + h * 128 + r32;
#pragma unroll
                for (int d0 = 0; d0 < 4; ++d0) op[d0 * 32] = (unsigned short)f2bf(d[d0] * sc_ * gs[d0]);
            }
        }
    }
    if constexpr (!SAMPLE) {
    {
        const int kr_ = tid >> 2, kc_ = (tid & 3) * 32;
        const unsigned short* ks_ = A.Kp + (size_t)(qi * 128 + kr_) * LDR + h * 128 + kc_;
        float* kd_ = A.kpo + (size_t)(qi * 128 + kr_) * LDR + h * 128 + kc_;
#pragma unroll
        for (int i = 0; i < 4; ++i) { const u32x4 w = *(const u32x4*)(ks_ + 8 * i);
            f32x4 a, b; a[0] = __uint_as_float(w[0] << 16); a[1] = __uint_as_float(w[0] & 0xffff0000u); a[2] = __uint_as_float(w[1] << 16); a[3] = __uint_as_float(w[1] & 0xffff0000u);
            b[0] = __uint_as_float(w[2] << 16); b[1] = __uint_as_float(w[2] & 0xffff0000u); b[2] = __uint_as_float(w[3] << 16); b[3] = __uint_as_float(w[3] & 0xffff0000u);
            *(f32x4*)(kd_ + 8 * i) = a; *(f32x4*)(kd_ + 8 * i + 4) = b; }
        const int vt_ = 2 * qi + (wid >> 2);
        const unsigned short* vs_ = A.Vp + ((size_t)(h * (SEQ / 64) + vt_) * 128) * 64;
        float* vd_ = A.vpo + (size_t)(vt_ * 64) * LDR + h * 128;
#pragma unroll
        for (int cc = 0; cc < 2; ++cc) {
            const int col = lane + 64 * cc;
#pragma unroll
            for (int ch = 0; ch < 2; ++ch) { const int k0 = (2 * (wid & 3) + ch) * 8;
                const u32x4 w = *(const u32x4*)(vs_ + (size_t)col * 64 + k0);
#pragma unroll
                for (int e = 0; e < 4; ++e) { vd_[(size_t)(k0 + 2 * e) * LDR + col] = __uint_as_float(w[e] << 16); vd_[(size_t)(k0 + 2 * e + 1) * LDR + col] = __uint_as_float(w[e] & 0xffff0000u); } }
        }
    }
    }
    __syncthreads();
}
#undef KSWZ

struct SpArgs { const unsigned short* Ub; const unsigned short* GVb; const float* SS; const float* gsgu; const float* wsp; const float* bsp; unsigned short* SGU; float* gsout;
                const unsigned short* Us; const unsigned short* GVs; const float* SSs; unsigned short* SGUs; };
__device__ __forceinline__ void spatial_unit(const SpArgs& A, bool sample, int c, int g, char* lds) {
    asm volatile("" : "+s"(c), "+s"(g));
    int tid = threadIdx.x; asm volatile("" : "+v"(tid));
    const int lane = tid & 63, r32 = lane & 31, hi = lane >> 5;
    const int wid = __builtin_amdgcn_readfirstlane(tid >> 6);
    const int R0 = sample ? (16 * c) : (128 * c), nrows = sample ? 16 : 128;
    const unsigned short* Ubp = sample ? A.Us : A.Ub; const unsigned short* GVp = sample ? A.GVs : A.GVb; const float* SSp = sample ? A.SSs : A.SS; unsigned short* SGUp = sample ? A.SGUs : A.SGU;
    float* rs_l = (float*)lds;
    if (tid < nrows) {
        const f32x4* sp = (const f32x4*)(SSp + (size_t)(R0 + tid) * 16);
        const f32x4 a = sp[0], b = sp[1], cc = sp[2], d = sp[3];
        const float s = ((a[0] + a[1]) + (a[2] + a[3])) + ((b[0] + b[1]) + (b[2] + b[3])) + ((cc[0] + cc[1]) + (cc[2] + cc[3])) + ((d[0] + d[1]) + (d[2] + d[3]));
        rs_l[tid] = 1.0f / sqrtf(s * (1.0f / 1024.0f) + EPS);
    }
    __syncthreads();
    const int ch = g * 256 + wid * 32 + r32;
    const float gch = A.gsgu[ch];
    const int nks = sample ? 1 : 8, nrb = sample ? 1 : 4;
    bf16x8 bfr[8];
#pragma unroll
    for (int ks = 0; ks < 8; ++ks) {
        if (ks < nks) {
            float vv[8];
#pragma unroll
            for (int jj = 0; jj < 8; ++jj) {
                const int j = 16 * ks + 8 * hi + jj;
                vv[jj] = bf2f(GVp[(size_t)(R0 + j) * LDR + ch]) * rs_l[j] * gch;
                if (sample) A.gsout[(size_t)(16 * c + j) * LDR + ch] = vv[jj];
            }
            u32x4 w = {cvtpk(vv[0], vv[1]), cvtpk(vv[2], vv[3]), cvtpk(vv[4], vv[5]), cvtpk(vv[6], vv[7])};
            bfr[ks] = *reinterpret_cast<bf16x8*>(&w);
        } else bfr[ks] = bf16x8{};
    }
    const float* Wg = A.wsp + (size_t)g * 128 * 128;
#pragma unroll 1
    for (int rb = 0; rb < nrb; ++rb) {
        {
            f32x16 acc = {};
            const int i = 32 * rb + r32;
#pragma unroll
            for (int ks = 0; ks < 8; ++ks) {
                if (ks < nks && 16 * ks <= 32 * rb + 31) {
                    const int j0 = 16 * ks + 8 * hi;
                    const f32x4 w0 = *(const f32x4*)(Wg + (size_t)i * 128 + j0), w1 = *(const f32x4*)(Wg + (size_t)i * 128 + j0 + 4);
                    float wv[8] = {w0[0], w0[1], w0[2], w0[3], w1[0], w1[1], w1[2], w1[3]};
#pragma unroll
                    for (int jj = 0; jj < 8; ++jj) if (j0 + jj > i) wv[jj] = 0.f;
                    u32x4 w = {cvtpk(wv[0], wv[1]), cvtpk(wv[2], wv[3]), cvtpk(wv[4], wv[5]), cvtpk(wv[6], wv[7])};
                    acc = __builtin_amdgcn_mfma_f32_32x32x16_bf16(*reinterpret_cast<bf16x8*>(&w), bfr[ks], acc, 0, 0, 0);
                }
            }
#pragma unroll
            for (int r = 0; r < 16; ++r) {
                const int io = 32 * rb + crow(r, hi);
                if (io < nrows) {
                    const float uv = bf2f(Ubp[(size_t)(R0 + io) * LDR + ch]);
                    SGUp[(size_t)(R0 + io) * LDR + ch] = (unsigned short)f2bf(uv * (acc[r] + A.bsp[g * 128 + io]));
                }
            }
        }
    }
    __syncthreads();
}
__device__ __forceinline__ void spatial_unit_prompt(const SpArgs& A, int c, int g, char* lds) {
    asm volatile("" : "+s"(c), "+s"(g));
    int tid = threadIdx.x; asm volatile("" : "+v"(tid));
    const int lane = tid & 63, r32 = lane & 31, hi = lane >> 5;
    const int wid = __builtin_amdgcn_readfirstlane(tid >> 6);
    constexpr int GST = 528, WST = 272;
    char* Gt = lds; char* Wt = lds + 128 * GST; float* rs_l = (float*)(lds + 128 * GST + 128 * WST);
    const int R0 = 128 * c;
    u32x4 gv[8];
#pragma unroll
    for (int i = 0; i < 8; ++i) { const int q = tid + 512 * i, row = q >> 5, cc = q & 31;
        gv[i] = *(const u32x4*)(A.GVb + (size_t)(R0 + row) * LDR + g * 256 + cc * 8); }
    const int wi = tid >> 2, wj = (tid & 3) * 32;
    f32x4 wv[8];
#pragma unroll
    for (int i = 0; i < 8; ++i) wv[i] = *(const f32x4*)(A.wsp + (size_t)g * 128 * 128 + (size_t)wi * 128 + wj + 4 * i);
    if (tid < 128) {
        const f32x4* sp = (const f32x4*)(A.SS + (size_t)(R0 + tid) * 16);
        const f32x4 a = sp[0], b = sp[1], cc = sp[2], d = sp[3];
        const float s = ((a[0] + a[1]) + (a[2] + a[3])) + ((b[0] + b[1]) + (b[2] + b[3])) + ((cc[0] + cc[1]) + (cc[2] + cc[3])) + ((d[0] + d[1]) + (d[2] + d[3]));
        rs_l[tid] = 1.0f / sqrtf(s * (1.0f / 1024.0f) + EPS);
    }
#pragma unroll
    for (int i = 0; i < 8; ++i) { const int q = tid + 512 * i, row = q >> 5, cc = q & 31; *(u32x4*)(Gt + row * GST + cc * 16) = gv[i]; }
    __syncthreads();
#pragma unroll
    for (int i = 0; i < 4; ++i) {
        const f32x4 r0 = *(const f32x4*)(rs_l + wj + 8 * i), r1 = *(const f32x4*)(rs_l + wj + 8 * i + 4);
        float t[8];
#pragma unroll
        for (int e = 0; e < 4; ++e) { t[e] = (wj + 8 * i + e <= wi) ? wv[2 * i][e] * r0[e] : 0.f; t[4 + e] = (wj + 8 * i + 4 + e <= wi) ? wv[2 * i + 1][e] * r1[e] : 0.f; }
        u32x4 w = {cvtpk(t[0], t[1]), cvtpk(t[2], t[3]), cvtpk(t[4], t[5]), cvtpk(t[6], t[7])};
        *(u32x4*)(Wt + wi * WST + (wj + 8 * i) * 2) = w;
    }
    __syncthreads();
    u32x4 uu[8];
#pragma unroll
    for (int i = 0; i < 8; ++i) { const int q = tid + 512 * i, row = q >> 5, cc = q & 31;
        uu[i] = *(const u32x4*)(A.Ub + (size_t)(R0 + row) * LDR + g * 256 + cc * 8); }
    const int ccol = wid * 32 + r32, ch = g * 256 + ccol;
    const float gch = A.gsgu[ch];
    bf16x8 bfr[8];
#pragma unroll
    for (int ks = 0; ks < 8; ++ks) {
        unsigned p[4];
#pragma unroll
        for (int e = 0; e < 4; ++e) { const int j = 16 * ks + 8 * hi + 2 * e;
            const unsigned lo = *(const unsigned short*)(Gt + j * GST + ccol * 2), hi16 = *(const unsigned short*)(Gt + (j + 1) * GST + ccol * 2);
            p[e] = lo | (hi16 << 16); }
        u32x4 w = {p[0], p[1], p[2], p[3]};
        bfr[ks] = *reinterpret_cast<bf16x8*>(&w);
    }
    asm volatile("s_waitcnt lgkmcnt(0)" ::: "memory");
#pragma unroll
    for (int rb = 0; rb < 4; ++rb) {
        f32x16 acc = {};
#pragma unroll
        for (int ks = 0; ks < 8; ++ks) {
            if (ks <= 2 * rb + 1) {
                const bf16x8 af = *(const bf16x8*)(Wt + (32 * rb + r32) * WST + (16 * ks + 8 * hi) * 2);
                acc = __builtin_amdgcn_mfma_f32_32x32x16_bf16(af, bfr[ks], acc, 0, 0, 0);
            }
        }
#pragma unroll
        for (int r = 0; r < 16; ++r) { const int io = 32 * rb + crow(r, hi);
            *(unsigned short*)(Gt + io * GST + ccol * 2) = (unsigned short)f2bf(acc[r] * gch + A.bsp[g * 128 + io]); }
    }
    __syncthreads();
#pragma unroll
    for (int i = 0; i < 8; ++i) { const int q = tid + 512 * i, row = q >> 5, cc = q & 31;
        const u32x4 rv = *(const u32x4*)(Gt + row * GST + cc * 16);
        u32x4 ov;
#pragma unroll
        for (int e = 0; e < 4; ++e) { const float a0 = __builtin_bit_cast(float, rv[e] << 16) * __builtin_bit_cast(float, uu[i][e] << 16), a1 = __builtin_bit_cast(float, rv[e] & 0xffff0000u) * __builtin_bit_cast(float, uu[i][e] & 0xffff0000u);
            ov[e] = cvtpk(a0, a1); }
        *(u32x4*)(A.SGU + (size_t)(R0 + row) * LDR + g * 256 + cc * 8) = ov; }
    __syncthreads();
}
#undef SBAR
}

struct KArgs {
    const float* in[26]; float* out; unsigned char* ws;
};

struct Frame {
    LAS unsigned char* lds; int tid, lane, wave, G, gw, NGW;
};

__device__ __forceinline__ void p0_transpose_item(const float* W, int K, int N, bf16* WT, int mode, LAS float* scr, int item, int lane, int ldw = 0) {
    if (ldw == 0) ldw = K;
    const int nblk = N / 32, kb = item / nblk, nb = item % nblk, k0 = 64 * kb, n0 = 32 * nb;
    int d0 = n0;
    if (mode == 1) { const int half = N / 2; const int nn = (n0 < half) ? n0 : n0 - half; d0 = (nn >> 7) * 256 + (nn & 127) + ((n0 < half) ? 0 : 128); }
#pragma unroll
    for (int i = 0; i < 32; ++i) { const int kk = 2 * i + (lane >> 5); scr[kk * 33 + (lane & 31)] = W[(size_t)(k0 + kk) * N + n0 + (lane & 31)]; }
    LDS_WAIT(); asm volatile("" ::: "memory");
    const int c = lane & 7;
#pragma unroll
    for (int j = 0; j < 4; ++j) { const int n = (lane >> 3) + 8 * j; const LAS float* s = scr + (8 * c) * 33 + n;
        v4u o; o.x = pk2(s[0 * 33], s[1 * 33]); o.y = pk2(s[2 * 33], s[3 * 33]); o.z = pk2(s[4 * 33], s[5 * 33]); o.w = pk2(s[6 * 33], s[7 * 33]);
        *(v4u*)(WT + (size_t)(d0 + n) * ldw + k0 + 8 * c) = o; }
    LDS_WAIT(); asm volatile("" ::: "memory");
}

__device__ __forceinline__ const float* xrow_ptr(const float* xp, const float* xs, int m) { return (m < SEQ) ? xp + (size_t)m * DM : xs + (size_t)(m - SEQ) * DM; }

template <bool BIN, bool BOUT>
__device__ __forceinline__ void row_phase(const Frame& F, int m0, int mstep, int mend, const bf16* Fb, const float* SS, const void* base0, float scale,
                                          const float* gpost, void* Hout, const float* gnext, bf16* XN) {
    for (int m = m0; m < mend; m += 2 * mstep) {
        const bool two = (m + mstep < mend); const int mb = two ? m + mstep : m;
        const v2u* fa_ = (const v2u*)(Fb + (size_t)m * DM) + F.lane; const v2u* fb_ = (const v2u*)(Fb + (size_t)mb * DM) + F.lane;
        const f32x4* gp = (const f32x4*)gpost + F.lane;
        v2u fwa[4], fwb[4]; f32x4 bva[4], bvb[4], g[4];
        float ssa = SS[(size_t)m * 16 + (F.lane & 15)], ssb = SS[(size_t)mb * 16 + (F.lane & 15)];
#pragma unroll
        for (int j = 0; j < 4; ++j) { fwa[j] = fa_[64 * j]; fwb[j] = fb_[64 * j]; g[j] = gp[64 * j];
            if constexpr (BIN) { const v2u wa = ((const v2u*)((const bf16*)base0 + (size_t)m * DM) + F.lane)[64 * j], wb = ((const v2u*)((const bf16*)base0 + (size_t)mb * DM) + F.lane)[64 * j];
                bva[j] = (f32x4){bflo(wa.x), bfhi(wa.x), bflo(wa.y), bfhi(wa.y)}; bvb[j] = (f32x4){bflo(wb.x), bfhi(wb.x), bflo(wb.y), bfhi(wb.y)}; }
            else { bva[j] = ((const f32x4*)((const float*)base0 + (size_t)m * DM) + F.lane)[64 * j]; bvb[j] = ((const f32x4*)((const float*)base0 + (size_t)mb * DM) + F.lane)[64 * j]; } }
#pragma unroll
        for (int half = 0; half < 2; ++half) {
            if (half == 1 && !two) break;
            const int mm = half ? mb : m;
            float ss = half ? ssb : ssa;
            ss += __shfl_xor(ss, 1); ss += __shfl_xor(ss, 2); ss += __shfl_xor(ss, 4); ss += __shfl_xor(ss, 8);
            const float rs = 1.0f / sqrtf(ss * (1.0f / DM) + EPS);
            f32x4 hv[4]; float s2 = 0.f;
#pragma unroll
            for (int j = 0; j < 4; ++j) { const v2u fw = half ? fwb[j] : fwa[j]; const f32x4 f = {bflo(fw.x), bfhi(fw.x), bflo(fw.y), bfhi(fw.y)}; const f32x4 b = half ? bvb[j] : bva[j];
                hv[j] = b + (f * g[j]) * (rs * scale);
                s2 += (hv[j][0] * hv[j][0] + hv[j][1] * hv[j][1]) + (hv[j][2] * hv[j][2] + hv[j][3] * hv[j][3]); }
            if (Hout) {
                if constexpr (BOUT) { v2u* ho = (v2u*)((bf16*)Hout + (size_t)mm * DM) + F.lane;
#pragma unroll
                    for (int j = 0; j < 4; ++j) ho[64 * j] = (v2u){pk2(hv[j][0], hv[j][1]), pk2(hv[j][2], hv[j][3])}; }
                else { f32x4* ho = (f32x4*)((float*)Hout + (size_t)mm * DM) + F.lane;
#pragma unroll
                    for (int j = 0; j < 4; ++j) { if (gnext) ho[64 * j] = hv[j]; else __builtin_nontemporal_store(hv[j], &ho[64 * j]); } }
            }
            if (gnext) {
                const float rs2 = 1.0f / sqrtf(wave_sum(s2) * (1.0f / DM) + EPS);
                const f32x4* gn = (const f32x4*)gnext + F.lane;
                unsigned long long* o8 = (unsigned long long*)(XN + (size_t)mm * DM) + F.lane;
#pragma unroll
                for (int j = 0; j < 4; ++j) { const f32x4 gq = gn[64 * j]; const f32x4 v = hv[j] * gq * rs2;
                    o8[64 * j] = (unsigned long long)pk2(v[0], v[1]) | ((unsigned long long)pk2(v[2], v[3]) << 32); }
            }
        }
    }
}


#define XB_TMO      128
#define XB_XCNT(j)  (256  + 64 * (j))
#define XB_XSUB(j)  (1280 + 64 * (j))
#define XB_XGEN(j)  (2304 + 64 * (j))
#define XB_TOP      3328
#define XB_TOPGEN   3392
#define XCD_BAR_WORDS 3456
#define XB_SPIN_CAP (1u << 20)
__device__ __forceinline__ unsigned xb_ld(unsigned* p)              { return __hip_atomic_load(p, __ATOMIC_RELAXED, __HIP_MEMORY_SCOPE_AGENT); }
__device__ __forceinline__ unsigned xb_add(unsigned* p, unsigned v) { return __hip_atomic_fetch_add(p, v, __ATOMIC_RELAXED, __HIP_MEMORY_SCOPE_AGENT); }
__device__ __forceinline__ unsigned xb_xcc_id() { return (unsigned)__builtin_amdgcn_s_getreg((3 << 11) | 20) & 0xFu; }
#define XB_SPIN(cond, bar) do { unsigned _sp = 0; while (cond) { __builtin_amdgcn_s_sleep(1); \
    if ((++_sp & 255u) == 0u) { if (xb_ld(&(bar)[XB_TMO])) break; if (_sp > XB_SPIN_CAP) { atomicAdd(&(bar)[XB_TMO], 1u); break; } } } } while (0)
struct XcdBarrier { unsigned* bar; unsigned x; volatile LAS unsigned* st; };
__device__ __forceinline__ XcdBarrier xcd_barrier_post(unsigned* bar, volatile LAS unsigned* st) {
    XcdBarrier b; b.bar = bar; b.x = xb_xcc_id(); b.st = st;
    if (threadIdx.x == 0) (void)xb_add(&bar[XB_XCNT(b.x)], 1u);
    return b;
}
__device__ __forceinline__ void xcd_barrier_complete(unsigned* bar, unsigned x, unsigned& nloc, unsigned& nx) {
    const unsigned G = gridDim.x * gridDim.y * gridDim.z;
    unsigned sum, cnt, mine, sp = 0u;
    for (;;) {
        sum = 0u; cnt = 0u; mine = 0u;
#pragma unroll
        for (unsigned j = 0; j < 16; ++j) { const unsigned c = xb_ld(&bar[XB_XCNT(j)]); sum += c; cnt += (c > 0u) ? 1u : 0u; mine = (j == x) ? c : mine; }
        if (sum == G) break;
        __builtin_amdgcn_s_sleep(1);
        if ((++sp & 255u) == 0u) { if (xb_ld(&bar[XB_TMO])) break; if (sp > XB_SPIN_CAP) { atomicAdd(&bar[XB_TMO], 1u); break; } }
    }
    nloc = mine > 0u ? mine : 1u; nx = cnt > 0u ? cnt : 1u;
}
__device__ __forceinline__ void xcd_barrier(const XcdBarrier& b) {
    asm volatile("s_waitcnt vmcnt(0)" ::: "memory");
    __syncthreads();
    if (threadIdx.x == 0) {
        unsigned* bar = b.bar;
        __builtin_amdgcn_s_waitcnt(0);
        unsigned nloc = b.st[0], nx = b.st[1];
        if (nloc == 0u) { xcd_barrier_complete(bar, b.x, nloc, nx); b.st[0] = nloc; b.st[1] = nx; }
        const unsigned old = xb_add(&bar[XB_XSUB(b.x)], 1u);
        const unsigned gen = old / nloc;
        if (old + 1u == (gen + 1u) * nloc) {
            __builtin_amdgcn_fence(__ATOMIC_RELEASE, "agent");
            asm volatile("s_waitcnt vmcnt(0)" ::: "memory");
            const unsigned og = xb_add(&bar[XB_TOP], 1u);
            const unsigned tg = og / nx;
            if (og + 1u == (tg + 1u) * nx) xb_add(&bar[XB_TOPGEN], 1u);
            else XB_SPIN(xb_ld(&bar[XB_TOPGEN]) == tg, bar);
            __builtin_amdgcn_fence(__ATOMIC_ACQUIRE, "agent");
            xb_add(&bar[XB_XGEN(b.x)], 1u);
            asm volatile("s_waitcnt vmcnt(0)" ::: "memory");
        } else {
            XB_SPIN(xb_ld(&bar[XB_XGEN(b.x)]) == gen, bar);
            __builtin_amdgcn_fence(__ATOMIC_ACQUIRE, "agent");
            asm volatile("s_waitcnt vmcnt(0)" ::: "memory");
        }
    }
    __syncthreads();
}

__device__ __forceinline__ int queue_pop(unsigned* ctr, volatile LAS unsigned* slot) {
    if (threadIdx.x == 0) *slot = __hip_atomic_fetch_add(ctr, 1u, __ATOMIC_RELAXED, __HIP_MEMORY_SCOPE_AGENT);
    __syncthreads();
    const int v = __builtin_amdgcn_readfirstlane((int)*slot);
    __syncthreads();
    return v;
}

__global__ void __launch_bounds__(NWAVES * 64, 2) mk_fwd(KArgs args) {
    extern __shared__ __attribute__((aligned(16))) unsigned char lds[];
    cg::grid_group grid = cg::this_grid();
    Frame F;
    F.lds = (LAS unsigned char*)lds;
    F.tid = threadIdx.x; F.lane = F.tid & 63; F.wave = __builtin_amdgcn_readfirstlane(F.tid >> 6);
    F.G = gridDim.x; F.gw = blockIdx.x * NWAVES + F.wave; F.NGW = F.G * NWAVES;
    unsigned char* ws = args.ws;
    unsigned* ctl = (unsigned*)(ws + WS_CTL);
    const float* xp = args.in[0]; const float* xs = args.in[1];
    float* rope = (float*)(ws + WS_ROPE); float* SS = (float*)(ws + WS_SS);
    bf16 *W1IN = (bf16*)(ws + WS_W1IN), *W1OUT = (bf16*)(ws + WS_W1OUT), *WIN = (bf16*)(ws + WS_WIN), *WA = (bf16*)(ws + WS_WA), *WB = (bf16*)(ws + WS_WB), *WO = (bf16*)(ws + WS_WO),
         *W2IN = (bf16*)(ws + WS_W2IN), *W2OUT = (bf16*)(ws + WS_W2OUT);
    bf16 *XN = (bf16*)(ws + WS_XN), *ACT = (bf16*)(ws + WS_ACT), *UB = (bf16*)(ws + WS_UB), *GVB = (bf16*)(ws + WS_GVB), *ATT = (bf16*)(ws + WS_ATT), *SGU = (bf16*)(ws + WS_SGU),
         *QB = (bf16*)(ws + WS_QB), *KPB = (bf16*)(ws + WS_KPB), *VPB = (bf16*)(ws + WS_VPB), *SGA = (bf16*)(ws + WS_SGA), *SGB = (bf16*)(ws + WS_SGB);
    bf16* FB = (bf16*)(ws + WS_F); bf16* HB = (bf16*)(ws + WS_H); float* T1 = (float*)(ws + WS_T1);
    bf16 *XNs = (bf16*)(ws + SA_XN), *ACTs = (bf16*)(ws + SA_ACT), *Qs = (bf16*)(ws + SA_Q), *Us = (bf16*)(ws + SA_U), *GVs = (bf16*)(ws + SA_GV), *SGAs = (bf16*)(ws + SA_SGA),
         *SGBs = (bf16*)(ws + SA_SGB), *ATTs = (bf16*)(ws + SA_ATT), *SGUs = (bf16*)(ws + SA_SGU);
    bf16* Fs = (bf16*)(ws + SA_F); float *Hs = (float*)(ws + SA_H), *T1s = (float*)(ws + SA_T1), *SSs = (float*)(ws + SA_SS);
    float* out = args.out;
    volatile LAS unsigned* MISC = (volatile LAS unsigned*)(F.lds + MISC_OFF);
    if (F.tid < 32) MISC[F.tid] = 0u;
    __syncthreads();
    XcdBarrier bar = xcd_barrier_post(ctl + CW_BAR, MISC + 8);
#define GRID_BAR() xcd_barrier(bar)

#if (PHM >> 0) & 1
    {
        LAS float* scr = (LAS float*)(F.lds + F.wave * 16384);
        constexpr int I_FIN = (DM / 64) * (2 * DFF / 32), I_FOUT = (DFF / 64) * (DM / 32), I_IN = (DM / 64) * (INC / 32), I_SQ = (DM / 64) * (DM / 32);
        constexpr int NITEMS = 2 * I_FIN + 2 * I_FOUT + I_IN + 3 * I_SQ;
        for (int it = F.gw; it < NITEMS; it += F.NGW) {
            int r = it;
            if (r < I_FIN) { p0_transpose_item(args.in[5], DM, 2 * DFF, W1IN, 1, scr, r, F.lane); continue; } r -= I_FIN;
            if (r < I_FOUT) { p0_transpose_item(args.in[6], DFF, DM, W1OUT, 0, scr, r, F.lane, LDF); continue; } r -= I_FOUT;
            if (r < I_IN) { p0_transpose_item(args.in[9], DM, INC, WIN, 0, scr, r, F.lane); continue; } r -= I_IN;
            if (r < I_SQ) { p0_transpose_item(args.in[18], DM, DM, WA, 0, scr, r, F.lane); continue; } r -= I_SQ;
            if (r < I_SQ) { p0_transpose_item(args.in[19], DM, DM, WB, 0, scr, r, F.lane); continue; } r -= I_SQ;
            if (r < I_SQ) { p0_transpose_item(args.in[20], DM, DM, WO, 0, scr, r, F.lane); continue; } r -= I_SQ;
            if (r < I_FIN) { p0_transpose_item(args.in[23], DM, 2 * DFF, W2IN, 1, scr, r, F.lane); continue; } r -= I_FIN;
            p0_transpose_item(args.in[24], DFF, DM, W2OUT, 0, scr, r, F.lane, LDF);
        }
        for (int i = blockIdx.x * (NWAVES * 64) + F.tid; i < SEQ * 8; i += F.G * NWAVES * 64) {
            const int pos = i >> 3, d = i & 7;
            const double cf = (d == 0) ? 0.15915494309189535 : (d == 1) ? 0.03086376340470123 : (d == 2) ? 0.005985185712713705 : (d == 3) ? 0.001160663641240061 :
                              (d == 4) ? 0.00022507907903927653 : (d == 5) ? 4.364795279280289e-05 : (d == 6) ? 8.464330808241401e-06 : 1.6414262627950345e-06;
            const double rev = (double)pos * cf; double t = rev - __builtin_floor(rev);
            t = t - __builtin_rint(t);
            const double q = __builtin_rint(4.0 * t); const double a = (t - 0.25 * q) * 6.283185307179586476925;
            const double a2 = a * a;
            const double sn = a * (1.0 + a2 * (-1.0 / 6 + a2 * (1.0 / 120 + a2 * (-1.0 / 5040 + a2 * (1.0 / 362880 + a2 * (-1.0 / 39916800 + a2 * (1.0 / 6227020800.0)))))));
            const double cs = 1.0 + a2 * (-0.5 + a2 * (1.0 / 24 + a2 * (-1.0 / 720 + a2 * (1.0 / 40320 + a2 * (-1.0 / 3628800 + a2 * (1.0 / 479001600 + a2 * (-1.0 / 87178291200.0)))))));
            const int qi = ((int)q) & 3;
            const double s_ = (qi == 0) ? sn : (qi == 1) ? cs : (qi == 2) ? -sn : -cs;
            const double c_ = (qi == 0) ? cs : (qi == 1) ? -sn : (qi == 2) ? -cs : sn;
            rope[(size_t)pos * 16 + d] = (float)c_; rope[(size_t)pos * 16 + 8 + d] = (float)s_;
        }
        const float* g1 = args.in[4];
        for (int m = F.gw; m < MT; m += 2 * F.NGW) {
            const bool two = (m + F.NGW < MT); const int mb = two ? m + F.NGW : m;
            const f32x4* xa = (const f32x4*)xrow_ptr(xp, xs, m) + F.lane; const f32x4* xb = (const f32x4*)xrow_ptr(xp, xs, mb) + F.lane; const f32x4* gp = (const f32x4*)g1 + F.lane;
            f32x4 va[4], vb[4], g[4]; float sa = 0.f, sb = 0.f;
#pragma unroll
            for (int j = 0; j < 4; ++j) { va[j] = xa[64 * j]; vb[j] = xb[64 * j]; g[j] = gp[64 * j]; }
#pragma unroll
            for (int j = 0; j < 4; ++j) { sa += (va[j][0] * va[j][0] + va[j][1] * va[j][1]) + (va[j][2] * va[j][2] + va[j][3] * va[j][3]);
                                          sb += (vb[j][0] * vb[j][0] + vb[j][1] * vb[j][1]) + (vb[j][2] * vb[j][2] + vb[j][3] * vb[j][3]); }
            const float rsa = 1.0f / sqrtf(wave_sum(sa) * (1.0f / DM) + EPS), rsb = 1.0f / sqrtf(wave_sum(sb) * (1.0f / DM) + EPS);
            unsigned long long* oa = (unsigned long long*)(m < SEQ ? XN + (size_t)m * DM : XNs + (size_t)(m - SEQ) * DM) + F.lane;
            unsigned long long* ob = (unsigned long long*)(mb < SEQ ? XN + (size_t)mb * DM : XNs + (size_t)(mb - SEQ) * DM) + F.lane;
#pragma unroll
            for (int j = 0; j < 4; ++j) { const f32x4 w = va[j] * g[j] * rsa; oa[64 * j] = (unsigned long long)pk2(w[0], w[1]) | ((unsigned long long)pk2(w[2], w[3]) << 32); }
            if (two) {
#pragma unroll
                for (int j = 0; j < 4; ++j) { const f32x4 w = vb[j] * g[j] * rsb; ob[64 * j] = (unsigned long long)pk2(w[0], w[1]) | ((unsigned long long)pk2(w[2], w[3]) << 32); }
            }
        }
    }
    GRID_BAR();
    if (args.ws == nullptr) grid.sync();

#endif
#if (PHM >> 1) & 1
    { pg8::Gemm g{XN, W1IN, SEQ, 2 * DFF, DM}; pg8::StaticOrder S; S.init(SEQ, 2 * DFF, F.G, (int)blockIdx.x);
      pg8::EpiSwiglu E{ACT}; pg8::gemm_phase<pg8::EpiSwiglu, pg8::StaticOrder, true, true>(F.lds, g, S, E); }
    GRID_BAR();
#endif
#if (PHM >> 2) & 1
    { pg8::Gemm g{ACT, W1OUT, SEQ, DM, DFF, nullptr, nullptr, LDF}; pg8::StaticOrder S; S.init(SEQ, DM, F.G, (int)blockIdx.x);
      pg8::EpiF32Stats E{FB, SS}; pg8::gemm_phase<pg8::EpiF32Stats, pg8::StaticOrder, false, true>(F.lds, g, S, E); }
    GRID_BAR();
#endif
#if (PHM >> 3) & 1
    row_phase<false, true>(F, F.gw, F.NGW, SEQ, FB, SS, xp, 0.5f, args.in[7], HB, args.in[8], XN);
    GRID_BAR();
#endif
#if (PHM >> 4) & 1
    { pg8::Gemm g{XN, WIN, SEQ, INC, DM}; pg8::StaticOrder S; S.init(SEQ, INC, F.G, (int)blockIdx.x);
      pg8::EpiProj E{QB, KPB, VPB, UB, GVB, SGA, SGB, out + OFF_KP, out + OFF_VP, SS, rope, false}; pg8::gemm_phase<pg8::EpiProj, pg8::StaticOrder, true, true>(F.lds, g, S, E); }
    GRID_BAR();
#endif
#if (PHM >> 5) & 1
    {
        float lam;
        { const float a = args.in[10][F.lane] * args.in[11][F.lane], b = args.in[12][F.lane] * args.in[13][F.lane];
          lam = expf(wave_sum(a)) - expf(wave_sum(b)) + LAM_INIT;
          lam = __builtin_bit_cast(float, __builtin_amdgcn_readfirstlane(__builtin_bit_cast(int, lam))); }
        unsigned* ch = ctl + CW_CH;
        int ch_ready = 0;
#define CH_N(s) ((s) == 1 || (s) == 10 ? 22 : (s) == 4 ? 28 : (s) == 5 ? 192 : ((s) == 3 || (s) == 9 || (s) == 12) ? 1 : 4)
#define CH_DONE_NOW(s, RES) do { if ((s) <= ch_ready) RES = true; else { \
            if (F.tid == 0) MISC[1] = (__hip_atomic_load(ch + 128 * (s) + 64, __ATOMIC_RELAXED, __HIP_MEMORY_SCOPE_AGENT) >= (unsigned)CH_N(s)) ? 1u : 0u; \
            __syncthreads(); RES = __builtin_amdgcn_readfirstlane((int)MISC[1]) != 0; __syncthreads(); } } while (0)
#define CH_WAIT(s) do { if ((s) > ch_ready) { \
            if (F.tid == 0) { unsigned sp_ = 0; while (__hip_atomic_load(ch + 128 * (s) + 64, __ATOMIC_RELAXED, __HIP_MEMORY_SCOPE_AGENT) < (unsigned)CH_N(s)) { __builtin_amdgcn_s_sleep(8); if (++sp_ > (1u << 22)) break; } \
                if (!((s) == 4 && !starter)) { __builtin_amdgcn_fence(__ATOMIC_ACQUIRE, "agent"); asm volatile("s_waitcnt vmcnt(0)" ::: "memory"); } } \
            __syncthreads(); ch_ready = (s); } } while (0)
#define CH_SIGNAL(s) do { asm volatile("s_waitcnt vmcnt(0)" ::: "memory"); __syncthreads(); \
            if (F.tid == 0) { __builtin_amdgcn_fence(__ATOMIC_RELEASE, "agent"); asm volatile("s_waitcnt vmcnt(0)" ::: "memory"); \
                __hip_atomic_fetch_add(ch + 128 * (s) + 64, 1u, __ATOMIC_RELAXED, __HIP_MEMORY_SCOPE_AGENT); } } while (0)
#define WP(T, off) ((T*)(w_ + (off)))
#define CH_UNIT(s, u) do { \
            if ((s) == 1 || (s) == 10) { pg8::Gemm g{WP(bf16, SA_XN), (s) == 1 ? WP(bf16, WS_W1IN) : WP(bf16, WS_W2IN), 256, 2 * DFF, DM}; pg8::OneUnit S{0, (u)}; pg8::EpiSwiglu E{WP(bf16, SA_ACT)}; pg8::gemm_phase<pg8::EpiSwiglu, pg8::OneUnit, false, true>(F.lds, g, S, E); } \
            else if ((s) == 2 || (s) == 11) { pg8::Gemm g{WP(bf16, SA_ACT), (s) == 2 ? WP(bf16, WS_W1OUT) : WP(bf16, WS_W2OUT), 256, DM, DFF, nullptr, nullptr, LDF}; pg8::OneUnit S{0, (u)}; pg8::EpiF32Stats E{WP(bf16, SA_F), WP(float, SA_SS)}; pg8::gemm_phase<pg8::EpiF32Stats, pg8::OneUnit, false, true>(F.lds, g, S, E); } \
            else if ((s) == 8) { pg8::Gemm g{WP(bf16, SA_XN), WP(bf16, WS_WO), 256, DM, DM}; pg8::OneUnit S{0, (u)}; pg8::EpiF32Stats E{WP(bf16, SA_F), WP(float, SA_SS)}; pg8::gemm_phase<pg8::EpiF32Stats, pg8::OneUnit, false, true>(F.lds, g, S, E); } \
            else if ((s) == 4) { pg8::Gemm g{WP(bf16, SA_XN), WP(bf16, WS_WIN), 256, INC, DM}; pg8::OneUnit S{0, (u)}; \
                               pg8::EpiProj E{WP(bf16, SA_Q), nullptr, nullptr, WP(bf16, SA_U), WP(bf16, SA_GV), WP(bf16, SA_SGA), WP(bf16, SA_SGB), o_ + OFF_KS, o_ + OFF_VS, WP(float, SA_SS), WP(float, WS_ROPE), true}; \
                               pg8::gemm_phase<pg8::EpiProj, pg8::OneUnit, false, true>(F.lds, g, S, E); } \
            else if ((s) == 6) { pg8::Gemm g{WP(bf16, SA_ATT), WP(bf16, WS_WA), 256, DM, DM}; pg8::OneUnit S{0, (u)}; pg8::EpiGateA E{WP(float, SA_T1), WP(bf16, SA_SGA)}; pg8::gemm_phase<pg8::EpiGateA, pg8::OneUnit, false, true>(F.lds, g, S, E); } \
            else if ((s) == 7) { pg8::Gemm g{WP(bf16, SA_SGU), WP(bf16, WS_WB), 256, DM, DM}; pg8::OneUnit S{0, (u)}; pg8::EpiGateB E{WP(float, SA_T1), WP(bf16, SA_SGB), WP(bf16, SA_XN)}; pg8::gemm_phase<pg8::EpiGateB, pg8::OneUnit, false, true>(F.lds, g, S, E); } \
            else if ((s) == 3) row_phase<false, false>(F, F.wave, NWAVES, 256, WP(bf16, SA_F), WP(float, SA_SS), KIN(1), 0.5f, KIN(7), WP(float, SA_H), KIN(8), WP(bf16, SA_XN)); \
            else if ((s) == 9) row_phase<false, false>(F, F.wave, NWAVES, 256, WP(bf16, SA_F), WP(float, SA_SS), WP(float, SA_H), 1.0f, KIN(21), WP(float, SA_H), KIN(22), WP(bf16, SA_XN)); \
            else if ((s) == 12) row_phase<false, false>(F, F.wave, NWAVES, 256, WP(bf16, SA_F), WP(float, SA_SS), WP(float, SA_H), 0.5f, KIN(25), o_ + OFF_Y + (size_t)SEQ * DM, nullptr, nullptr); \
            else {} } while (0)
#ifndef P5_REPS
#define P5_REPS 1
#endif
#ifndef NDED
#define NDED 16
#endif
        const int h8 = blockIdx.x & 7;
#pragma unroll 1
        for (int rep = 0; rep < P5_REPS; ++rep) {
        unsigned* qb_ = ctl + CW_Q + rep * 1024;
        const bool starter = (int)blockIdx.x >= (int)F.G - NDED;
        int st = starter ? 0 : 1, cs = starter ? 1 : 5, hh = 0; bool s5_open = true, try5 = false;
        for (;;) {
            int kind = 0, a0 = 0, a1 = 0, dep = 0, sig = 0;
            if (st == 0 || st == 3) {
                while (cs <= 12) { const int u = queue_pop(ch + 128 * cs, MISC); if (u < CH_N(cs)) { kind = 3; a0 = cs; a1 = u; dep = cs - 1; sig = cs; break; } ++cs; }
                if (kind == 0) { if (st == 0) { st = 1; cs = 5; continue; } break; }
            } else if (st == 1) {
                if (try5) { try5 = false; bool rdy_; CH_DONE_NOW(4, rdy_);
                    if (rdy_) { const int u = queue_pop(ch + 128 * 5, MISC); if (u < CH_N(5)) { kind = 3; a0 = 5; a1 = u; dep = 4; sig = 5; } else s5_open = false; } }
                if (kind == 0) {
                    while (hh < 8) { const int hq = (h8 + hh) & 7; const int idx = queue_pop(qb_ + 64 * hq, MISC); if (idx < 128) { kind = 1; a0 = hq; a1 = 127 - idx; try5 = s5_open; break; }
                        if (F.tid < 8) MISC[32 + F.tid] = __hip_atomic_load(qb_ + 64 * F.tid, __ATOMIC_RELAXED, __HIP_MEMORY_SCOPE_AGENT);
                        __syncthreads();
                        ++hh; while (hh < 8 && MISC[32 + ((h8 + hh) & 7)] >= 128u) ++hh;
                        __syncthreads(); }
                    if (kind == 0) { st = 2; continue; }
                }
            } else {
                const int idx = queue_pop(qb_ + 64 * 8, MISC);
                if (idx < 512) { kind = 2; a0 = idx >> 2; a1 = idx & 3; } else { bool fin_; CH_DONE_NOW(12, fin_); if (fin_) break; st = 3; cs = 5; continue; }
            }
            if (dep) CH_WAIT(dep);
            typedef __attribute__((address_space(4))) const unsigned long long* kptr_t;
            kptr_t kq_ = (kptr_t)__builtin_amdgcn_kernarg_segment_ptr(); asm volatile("" : "+s"(kq_));
#define KIN(k) ((const float*)(const GAS float*)kq_[k])
            unsigned char* w_ = (unsigned char*)(GAS unsigned char*)kq_[27]; float* o_ = (float*)(GAS float*)kq_[26];
            if (kind == 1 || (kind == 3 && a0 == 5 && a1 < 128)) {
                att::Args AA{WP(bf16, WS_QB), WP(bf16, WS_KPB), WP(bf16, WS_VPB), KIN(2), KIN(3), o_ + OFF_KS, o_ + OFF_VS, WP(bf16, WS_ATT), KIN(14), WP(bf16, SA_Q), WP(bf16, SA_ATT), o_ + OFF_KP, o_ + OFF_VP};
                if (kind == 1) att::attn_unit<false>(AA, a0, a1, (char*)lds, lam); else att::attn_unit<true>(AA, a1 & 7, a1 >> 3, (char*)lds, lam);
            } else if (kind == 2 || (kind == 3 && a0 == 5)) { const bool smp = (kind == 3);
                att::SpArgs SA{WP(bf16, WS_UB), WP(bf16, WS_GVB), WP(float, WS_SS), KIN(15), KIN(16), KIN(17), WP(bf16, WS_SGU), o_ + OFF_GS, WP(bf16, SA_U), WP(bf16, SA_GV), WP(float, SA_SS), WP(bf16, SA_SGU)};
                if (smp) att::spatial_unit(SA, true, (a1 - 128) >> 2, (a1 - 128) & 3, (char*)lds); else att::spatial_unit_prompt(SA, a0, a1, (char*)lds); }
            else CH_UNIT(a0, a1);
            if (sig) CH_SIGNAL(sig);
        }
        if (rep + 1 < P5_REPS) GRID_BAR();
        }
    }
    GRID_BAR();
#endif
#if (PHM >> 6) & 1
    { pg8::Gemm g{ATT, WA, SEQ, DM, DM, SGU, WB}; pg8::DualOrder S; S.init(SEQ, DM, F.G, (int)blockIdx.x);
      pg8::EpiGateAB E{SGA, SGB, XN}; pg8::gemm_phase<pg8::EpiGateAB, pg8::DualOrder, true, true>(F.lds, g, S, E); }
    GRID_BAR();
#endif
#if (PHM >> 8) & 1
    { pg8::Gemm g{XN, WO, SEQ, DM, DM}; pg8::StaticOrder S; S.init(SEQ, DM, F.G, (int)blockIdx.x);
      pg8::EpiF32Stats E{FB, SS}; pg8::gemm_phase<pg8::EpiF32Stats, pg8::StaticOrder, false, true>(F.lds, g, S, E); }
    GRID_BAR();
#endif
#if (PHM >> 9) & 1
    row_phase<true, true>(F, F.gw, F.NGW, SEQ, FB, SS, HB, 1.0f, args.in[21], HB, args.in[22], XN);
    GRID_BAR();
#endif
#if (PHM >> 10) & 1
    { pg8::Gemm g{XN, W2IN, SEQ, 2 * DFF, DM}; pg8::StaticOrder S; S.init(SEQ, 2 * DFF, F.G, (int)blockIdx.x);
      pg8::EpiSwiglu E{ACT}; pg8::gemm_phase<pg8::EpiSwiglu, pg8::StaticOrder, true, true>(F.lds, g, S, E); }
    GRID_BAR();
    { pg8::Gemm g{ACT, W2OUT, SEQ, DM, DFF, nullptr, nullptr, LDF}; pg8::StaticOrder S; S.init(SEQ, DM, F.G, (int)blockIdx.x);
      pg8::EpiF32Stats E{FB, SS}; pg8::gemm_phase<pg8::EpiF32Stats, pg8::StaticOrder, false, true>(F.lds, g, S, E); }
    GRID_BAR();
#endif
#if (PHM >> 11) & 1
        row_phase<true, false>(F, F.gw, F.NGW, SEQ, FB, SS, HB, 0.5f, args.in[25], out + OFF_Y, nullptr, nullptr);
#endif
#ifdef PROBE_BF16
    for (size_t i = (size_t)blockIdx.x * 512 + F.tid; i < (size_t)MT * DM; i += (size_t)F.G * 512) out[OFF_Y + i] = bf2f(((const bf16*)PROBE_BF16)[i]);
#elif !((PHM >> 11) & 1)
    for (size_t i = (size_t)blockIdx.x * 512 + F.tid; i < (size_t)MT * DM / 4; i += (size_t)F.G * 512) ((f32x4*)(out + OFF_Y))[i] = (f32x4){0.f, 0.f, 0.f, 0.f};
#endif
#if !((PHM >> 5) & 1)
    for (size_t i = (size_t)blockIdx.x * 512 + F.tid; i < (size_t)256 * DM / 4; i += (size_t)F.G * 512) ((f32x4*)(out + OFF_GS))[i] = (f32x4){0.f, 0.f, 0.f, 0.f};
#endif
}

extern "C" void kernel_launch(void* const* d_in, const int* in_sizes, int n_in, void* d_out, int out_size, void* d_ws, size_t ws_size, hipStream_t stream) {
    static int grid = 0;
    if (grid == 0) {
        if (n_in != 26 || ws_size < WS_END) { fprintf(stderr, "kernel_launch: unexpected n_in %d / ws %zu\n", n_in, ws_size); grid = -1; return; }
        int dev = 0, cus = 0, per_cu = 0;
        if (hipGetDevice(&dev) != hipSuccess || hipDeviceGetAttribute(&cus, hipDeviceAttributeMultiprocessorCount, dev) != hipSuccess) { grid = -1; return; }
        if (hipFuncSetAttribute((const void*)mk_fwd, hipFuncAttributeMaxDynamicSharedMemorySize, LDS_BYTES) != hipSuccess) { fprintf(stderr, "kernel_launch: hipFuncSetAttribute failed\n"); grid = -1; return; }
        if (hipOccupancyMaxActiveBlocksPerMultiprocessor(&per_cu, (const void*)mk_fwd, NWAVES * 64, LDS_BYTES) != hipSuccess || per_cu < 1) { fprintf(stderr, "kernel_launch: occupancy query says %d\n", per_cu); per_cu = 1; }
        (void)hipGetLastError();
        grid = cus;
    }
    if (grid < 0) return;
    (void)hipMemsetAsync((char*)d_ws + WS_CTL, 0, CTL_ZERO_BYTES, stream);
    KArgs a{};
    for (int i = 0; i < 26; ++i) a.in[i] = (const float*)d_in[i];
    a.out = (float*)d_out; a.ws = (unsigned char*)d_ws;
    void* kargs[] = {&a};
    hipError_t e = hipLaunchCooperativeKernel((const void*)mk_fwd, dim3(grid), dim3(NWAVES * 64), kargs, LDS_BYTES, stream);
    if (e != hipSuccess) fprintf(stderr, "kernel_launch: cooperative launch failed: %s (grid %d)\n", hipGetErrorString(e), grid);
}
```

```cpp
#include <hip/hip_runtime.h>
#include <hip/hip_cooperative_groups.h>
#include <cstdio>
#include <cstdint>
namespace cg = cooperative_groups;
#ifndef P5M
#define P5M 7
#endif
#ifndef PHM
#define PHM 0xFFF
#endif

namespace pg8 {
#define PG8_LAS __attribute__((address_space(3)))
typedef unsigned short bf16_t;
typedef short bf16x8 __attribute__((ext_vector_type(8)));
typedef float f32x4 __attribute__((ext_vector_type(4)));
typedef float f32x2 __attribute__((ext_vector_type(2)));
typedef unsigned u32x4 __attribute__((ext_vector_type(4)));
typedef unsigned u32x2 __attribute__((ext_vector_type(2)));
constexpr int BM = 256, BK = 64, HALF = 128, HTB = HALF * BK * 2, STAGE_BYTES = 8 * HTB, NXCD = 8, WGM = 4;

__host__ __device__ __forceinline__ int lds_byte(int r, int c) { const int st = (r >> 4) * 2 + (c >> 5), rr = r & 15, cc = c & 31, ob = rr * 64 + cc * 2; return st * 1024 + (ob ^ (((ob >> 9) & 1) << 5)); }
__host__ __device__ __forceinline__ void stage_rc(int b, int& R, int& C) { const int st = b / 1024, sb = b % 1024, swz = sb ^ (((sb >> 9) & 1) << 5); R = (st >> 1) * 16 + swz / 64; C = (st & 1) * 32 + (swz % 64) / 2; }
__host__ __device__ __forceinline__ int perm32(int rho) { const int n = rho >> 4, i = rho & 15; return 8 * (i >> 2) + 4 * n + (i & 3); }

struct Unit { int pm, pn, w; };
struct Gemm { const bf16_t* A; const bf16_t* Bt; int M, N, K; const bf16_t* A2 = nullptr; const bf16_t* Bt2 = nullptr; int ld = 0; };

struct StaticOrder {
    int nM, nN, nwg, G, c;
    __host__ __device__ void init(int M, int N, int G_, int c_) { nM = M / BM; nN = N / BM; nwg = nM * nN; G = G_; c = c_; }
    __host__ __device__ bool next(int i, Unit& u) const {
        const long L = (long)i * G + c; if (L >= nwg) return false;
        map((int)L, u); return true;
    }
    __host__ __device__ void map(int L, Unit& u) const {
        int wgid = L; { const int q = nwg / NXCD, r = nwg % NXCD, xcd = wgid % NXCD, off = wgid / NXCD; wgid = (xcd < r ? xcd * (q + 1) : r * (q + 1) + (xcd - r) * q) + off; }
        const int nig = WGM * nN, gid = wgid / nig, fm = gid * WGM, gsz = (nM - fm) < WGM ? (nM - fm) : WGM;
        u.pm = fm + ((wgid % nig) % gsz); u.pn = (wgid % nig) / gsz; u.w = 0;
    }
    __device__ __forceinline__ void a_ready(const Unit&) const {}
    __device__ __forceinline__ void done(const Unit&) const {}
};
struct HeadOrder {
    StaticOrder so; int lim;
    __device__ __forceinline__ void init(int M, int N, int G_, int c_) { so.init(M, N, G_, c_); lim = (so.nwg / G_) * G_; if (G_ != 256 || (so.nwg - lim) * 2 != G_) lim = so.nwg; }
    __device__ __forceinline__ bool next(int i, Unit& u) const { const long L = (long)i * so.G + so.c; if (L >= lim) return false; so.map((int)L, u); return true; }
    __device__ __forceinline__ void a_ready(const Unit&) const {}
    __device__ __forceinline__ void done(const Unit&) const {}
};
struct TailOrder {
    StaticOrder so; int lim;
    __device__ __forceinline__ void init(int M, int N, int G_, int c_) { so.init(M, N, G_, c_); lim = (so.nwg / G_) * G_; if (G_ != 256 || (so.nwg - lim) * 2 != G_) lim = so.nwg; }
    __device__ __forceinline__ bool next(int i, Unit& u) const { if (i > 0 || lim == so.nwg) return false;
        const int x = so.c & 7, j = so.c >> 3; so.map(lim + 8 * (j >> 1) + x, u); u.pm = 2 * u.pm + (j & 1); return true; }
    __device__ __forceinline__ void a_ready(const Unit&) const {}
    __device__ __forceinline__ void done(const Unit&) const {}
};
struct DualOrder {
    StaticOrder so;
    __host__ __device__ void init(int M, int N, int G_, int c_) { so.init(M, N, G_, c_); }
    __host__ __device__ bool next(int i, Unit& u) const { if (!so.next(i >> 1, u)) return false; u.w = i & 1; return true; }
    __device__ __forceinline__ void a_ready(const Unit&) const {}
    __device__ __forceinline__ void done(const Unit&) const {}
};

typedef float f32x2_cv __attribute__((ext_vector_type(2))); typedef __bf16 bf16x2_cv __attribute__((ext_vector_type(2)));
struct OneUnit {
    int pm, pn;
    __device__ __forceinline__ bool next(int i, Unit& u) const { if (i > 0) return false; u.pm = pm; u.pn = pn; u.w = 0; return true; }
    __device__ __forceinline__ void a_ready(const Unit&) const {}
    __device__ __forceinline__ void done(const Unit&) const {}
};
__device__ __forceinline__ unsigned cvt_pk_bf16(float lo, float hi) { f32x2_cv v = {lo, hi}; bf16x2_cv b = __builtin_convertvector(v, bf16x2_cv); return __builtin_bit_cast(unsigned, b); }

template <class Epi, class Sched, bool ALIGN_EPI = false, bool SP2 = false, bool HALFM = false>
__device__ __forceinline__ void gemm_phase(PG8_LAS unsigned char* lds, const Gemm g, const Sched& S, const Epi& E) {
    int tid = threadIdx.x; asm volatile("" : "+v"(tid));
    const int wid = __builtin_amdgcn_readfirstlane(tid >> 6), lane = tid & 63, wr = wid >> 2, wc = wid & 3, fr = lane & 15, fq = lane >> 4;
    const int K = g.K, nt = K / BK, LD = g.ld ? g.ld : g.K;
    unsigned voffA[2], voffB[2];
#pragma unroll
    for (int i = 0; i < 2; ++i) { int R, C; stage_rc(tid * 16 + i * 8192, R, C); const int Rb = Epi::PERM ? ((R & ~31) + perm32(R & 31)) : R;
        voffA[i] = (unsigned)(R * LD + C) * 2u; voffB[i] = (unsigned)(Rb * LD + C) * 2u; }
    const size_t kstep = (size_t)(BK * 2);
    const size_t hstep = (size_t)HALF * LD * 2;
    const size_t tstep = 2 * hstep;
    const unsigned ldsw = (unsigned)wid * 1024u;
    const int aoff = lds_byte(wr * 64 + fr, fq * 8), boff = lds_byte(wc * 32 + fr, fq * 8);
#define PG8_SA(b, h) (((b) * 2 + (h)) * HTB)
#define PG8_SB(b, h) ((4 + (b) * 2 + (h)) * HTB)
#define PG8_STAGE(bufoff, gbase, voff) do { _Pragma("unroll") for (int _i = 0; _i < 2; ++_i) \
        __builtin_amdgcn_global_load_lds((const unsigned*)((const char*)(gbase) + (voff)[_i]), (PG8_LAS unsigned*)(lds + (bufoff) + ldsw + _i * 8192), 16, 0, 0); } while (0)
#define PG8_LDA(dst, b, h) do { _Pragma("unroll") for (int m = 0; m < 4; ++m) _Pragma("unroll") for (int k = 0; k < 2; ++k) dst[m][k] = *(const PG8_LAS bf16x8*)(lds + PG8_SA(b, h) + aoff + m * 2048 + k * 1024); } while (0)
#define PG8_LDB(dst, b, h) do { _Pragma("unroll") for (int n = 0; n < 2; ++n) _Pragma("unroll") for (int k = 0; k < 2; ++k) dst[n][k] = *(const PG8_LAS bf16x8*)(lds + PG8_SB(b, h) + boff + n * 2048 + k * 1024); } while (0)
#define PG8_MMA(ai, bj, At, Bt) do { __builtin_amdgcn_s_setprio(1); _Pragma("unroll") for (int m = 0; m < 4; ++m) _Pragma("unroll") for (int n = 0; n < 2; ++n) _Pragma("unroll") for (int k = 0; k < 2; ++k) \
        acc[ai][bj][m][n] = __builtin_amdgcn_mfma_f32_16x16x32_bf16(Bt[n][k], At[m][k], acc[ai][bj][m][n], 0, 0, 0); __builtin_amdgcn_s_setprio(0); } while (0)
#define PG8_WAIT_V(n) asm volatile("s_waitcnt vmcnt(" #n ")" ::: "memory")
#define PG8_WAIT_L(n) asm volatile("s_waitcnt lgkmcnt(" #n ")" ::: "memory")
#define PG8_BAR __builtin_amdgcn_s_barrier()
#define PG8_SCHED __builtin_amdgcn_sched_barrier(0)
    Unit cur, nxt; int ui = 0;
    if (!S.next(0, cur)) return;
    f32x4 acc[2][2][4][2];
#pragma unroll
    for (int a = 0; a < 2; ++a)
#pragma unroll
        for (int b = 0; b < 2; ++b)
#pragma unroll
            for (int m = 0; m < 4; ++m)
#pragma unroll
                for (int n = 0; n < 2; ++n) acc[a][b][m][n] = (f32x4){0.f, 0.f, 0.f, 0.f};
    bf16x8 At[4][2], B0[2][2], B1[2][2];
    const size_t astep = HALFM ? hstep : tstep;
    const char* cA = (const char*)(cur.w ? g.A2 : g.A) + (size_t)cur.pm * astep; const char* cB = (const char*)(cur.w ? g.Bt2 : g.Bt) + (size_t)cur.pn * tstep;
    S.a_ready(cur);
    if constexpr (SP2) {
        PG8_STAGE(PG8_SB(0, 0), cB, voffB); PG8_STAGE(PG8_SB(0, 1), cB + hstep, voffB); PG8_STAGE(PG8_SA(0, 0), cA, voffA); PG8_STAGE(PG8_SA(0, 1), cA + hstep, voffA);
        if (wr == 1) PG8_BAR;
        PG8_WAIT_V(2); PG8_BAR;
        PG8_STAGE(PG8_SB(1, 0), cB + kstep, voffB); PG8_STAGE(PG8_SA(1, 0), cA + kstep, voffA); PG8_STAGE(PG8_SB(1, 1), cB + hstep + kstep, voffB);
        PG8_WAIT_V(6); PG8_BAR;
    } else {
        PG8_STAGE(PG8_SB(0, 0), cB, voffB); PG8_STAGE(PG8_SA(0, 0), cA, voffA); PG8_STAGE(PG8_SB(0, 1), cB + hstep, voffB); PG8_STAGE(PG8_SA(0, 1), cA + hstep, voffA);
        if (wr == 1) PG8_BAR;
        PG8_WAIT_V(4); PG8_BAR;
        PG8_STAGE(PG8_SB(1, 0), cB + kstep, voffB); PG8_STAGE(PG8_SA(1, 0), cA + kstep, voffA); PG8_STAGE(PG8_SB(1, 1), cB + hstep + kstep, voffB);
        PG8_WAIT_V(6); PG8_BAR;
    }
    for (;;) {
        const bool has_next = S.next(ui + 1, nxt);
        const char* nA = has_next ? (const char*)(nxt.w ? g.A2 : g.A) + (size_t)nxt.pm * astep : cA; const char* nB = has_next ? (const char*)(nxt.w ? g.Bt2 : g.Bt) + (size_t)nxt.pn * tstep : cB;
        for (int t = 0; t < nt; t += 2) {
            const bool last = (t == nt - 2);
            const char* a1 = cA + (size_t)(t + 1) * kstep;
            const char* a2 = last ? nA : cA + (size_t)(t + 2) * kstep; const char* b2 = last ? nB : cB + (size_t)(t + 2) * kstep;
            const char* a3 = a2 + kstep; const char* b3 = b2 + kstep;
            if (last && has_next) S.a_ready(nxt);
            if constexpr (SP2) {
            PG8_LDB(B0, 0, 0); PG8_LDB(B1, 0, 1); PG8_SCHED; PG8_LDA(At, 0, 0); PG8_STAGE(PG8_SA(1, 1), a1 + hstep, voffA);
            PG8_WAIT_V(8); PG8_WAIT_L(0); PG8_BAR; PG8_MMA(0, 0, At, B0); PG8_MMA(0, 1, At, B1); PG8_BAR; PG8_SCHED;
            if constexpr (!HALFM) PG8_LDA(At, 0, 1); PG8_STAGE(PG8_SB(0, 0), b2, voffB); PG8_STAGE(PG8_SB(0, 1), b2 + hstep, voffB); PG8_STAGE(PG8_SA(0, 0), a2, voffA);
            PG8_WAIT_V(8); PG8_WAIT_L(0); PG8_BAR; if constexpr (!HALFM) { PG8_MMA(1, 0, At, B0); PG8_MMA(1, 1, At, B1); } PG8_BAR; PG8_SCHED;
            PG8_LDB(B0, 1, 0); PG8_LDB(B1, 1, 1); PG8_SCHED; PG8_LDA(At, 1, 0); PG8_STAGE(PG8_SA(0, 1), a2 + hstep, voffA);
            PG8_WAIT_V(8); PG8_WAIT_L(0); PG8_BAR; PG8_MMA(0, 0, At, B0); PG8_MMA(0, 1, At, B1); PG8_BAR; PG8_SCHED;
            if constexpr (!HALFM) PG8_LDA(At, 1, 1); PG8_STAGE(PG8_SB(1, 0), b3, voffB); PG8_STAGE(PG8_SB(1, 1), b3 + hstep, voffB); PG8_STAGE(PG8_SA(1, 0), a3, voffA);
            PG8_WAIT_V(8); PG8_WAIT_L(0); PG8_BAR; if constexpr (!HALFM) { PG8_MMA(1, 0, At, B0); PG8_MMA(1, 1, At, B1); } PG8_BAR; PG8_SCHED;
            } else {
            PG8_LDB(B0, 0, 0); PG8_SCHED; PG8_LDA(At, 0, 0); PG8_STAGE(PG8_SA(1, 1), a1 + hstep, voffA);
            PG8_WAIT_L(8); PG8_BAR; PG8_WAIT_L(0); PG8_MMA(0, 0, At, B0); PG8_BAR; PG8_SCHED;
            PG8_LDB(B1, 0, 1); PG8_STAGE(PG8_SB(0, 0), b2, voffB);
            PG8_BAR; PG8_WAIT_L(0); PG8_MMA(0, 1, At, B1); PG8_BAR;
            PG8_LDA(At, 0, 1); PG8_STAGE(PG8_SA(0, 0), a2, voffA);
            PG8_BAR; PG8_WAIT_L(0); PG8_MMA(1, 0, At, B0); PG8_BAR; PG8_SCHED;
            PG8_STAGE(PG8_SB(0, 1), b2 + hstep, voffB);
            PG8_WAIT_V(6); PG8_BAR; PG8_MMA(1, 1, At, B1); PG8_BAR;
            PG8_LDB(B0, 1, 0); PG8_SCHED; PG8_LDA(At, 1, 0); PG8_STAGE(PG8_SA(0, 1), a2 + hstep, voffA);
            PG8_WAIT_L(8); PG8_BAR; PG8_WAIT_L(0); PG8_MMA(0, 0, At, B0); PG8_BAR; PG8_SCHED;
            PG8_LDB(B1, 1, 1); PG8_STAGE(PG8_SB(1, 0), b3, voffB);
            PG8_BAR; PG8_WAIT_L(0); PG8_MMA(0, 1, At, B1); PG8_BAR;
            PG8_LDA(At, 1, 1); PG8_STAGE(PG8_SA(1, 0), a3, voffA);
            PG8_BAR; PG8_WAIT_L(0); PG8_MMA(1, 0, At, B0); PG8_BAR; PG8_SCHED;
            PG8_STAGE(PG8_SB(1, 1), b3 + hstep, voffB);
            PG8_WAIT_V(6); PG8_BAR; PG8_MMA(1, 1, At, B1); PG8_BAR;
            }
        }
        if constexpr (ALIGN_EPI) { if (wr == 0) PG8_BAR; }
        E(acc, cur, wr, wc, fr, fq); S.done(cur);
        if (!has_next) break;
        if (!(Epi::DUAL && cur.w == 0)) {
#pragma unroll
        for (int a = 0; a < 2; ++a)
#pragma unroll
            for (int b = 0; b < 2; ++b)
#pragma unroll
                for (int m = 0; m < 4; ++m)
#pragma unroll
                    for (int n = 0; n < 2; ++n) acc[a][b][m][n] = (f32x4){0.f, 0.f, 0.f, 0.f};
        }
        cur = nxt; cA = nA; cB = nB; ++ui;
        if constexpr (ALIGN_EPI) { if (wr == 1) PG8_BAR; }
    }
    PG8_WAIT_V(0);
    if constexpr (!ALIGN_EPI) { if (wr == 0) PG8_BAR; }
    PG8_BAR;
#undef PG8_SA
#undef PG8_SB
#undef PG8_STAGE
#undef PG8_LDA
#undef PG8_LDB
#undef PG8_MMA
#undef PG8_WAIT_V
#undef PG8_WAIT_L
#undef PG8_BAR
#undef PG8_SCHED
}
}

constexpr int DM = 1024, SEQ = 16384, DECB = 16, DECS = 16, PAST = 2048, NH = 8, DFF = 2816, INC = 7168;
constexpr int MT = SEQ + DECB * DECS;
constexpr int LDF = 2880;
constexpr float EPS = 1e-6f;
constexpr float C2 = 0.18033688011112042f;
constexpr float LAM_INIT = 0.2f;

constexpr size_t OFF_Y = 0, OFF_KP = (size_t)MT * DM, OFF_VP = OFF_KP + (size_t)SEQ * DM, OFF_KS = OFF_VP + (size_t)SEQ * DM,
                 OFF_VS = OFF_KS + (size_t)256 * DM, OFF_GS = OFF_VS + (size_t)256 * DM;

constexpr size_t MiB = 1u << 20;
constexpr size_t WS_CTL = 0, CTL_ZERO_BYTES = 64 * 1024;
constexpr size_t WS_ROPE = 1 * MiB;
constexpr size_t WS_SS = 2 * MiB;
constexpr size_t WS_W1IN = 4 * MiB;
constexpr size_t WS_W1OUT = 15 * MiB;
constexpr size_t WS_WIN = 21 * MiB;
constexpr size_t WS_WA = 35 * MiB, WS_WB = 37 * MiB, WS_WO = 39 * MiB;
constexpr size_t WS_W2IN = 41 * MiB, WS_W2OUT = 52 * MiB;
constexpr size_t WS_XN = 58 * MiB;
constexpr size_t WS_ACT = 91 * MiB;
constexpr size_t WS_UB = WS_ACT, WS_GVB = WS_ACT + 33 * MiB;
constexpr size_t WS_F = 184 * MiB;
constexpr size_t WS_ATT = WS_F, WS_SGU = WS_F + 33 * MiB;
constexpr size_t WS_H = 250 * MiB;
constexpr size_t WS_QB = 316 * MiB, WS_KPB = 349 * MiB, WS_VPB = 382 * MiB;
constexpr size_t WS_T1 = WS_QB;
constexpr size_t WS_SGA = 415 * MiB, WS_SGB = 448 * MiB;
constexpr size_t WS_SA = 481 * MiB;
constexpr size_t SA_XN = WS_SA, SA_ACT = WS_SA + 1 * MiB, SA_F = WS_SA + 3 * MiB, SA_H = WS_SA + 4 * MiB, SA_T1 = WS_SA + 5 * MiB, SA_Q = WS_SA + 6 * MiB,
                 SA_U = SA_Q + 512 * 1024, SA_GV = SA_U + 512 * 1024, SA_SGA = SA_GV + 512 * 1024, SA_SGB = SA_SGA + 512 * 1024, SA_ATT = SA_SGB + 512 * 1024,
                 SA_SGU = SA_ATT + 512 * 1024, SA_SS = SA_SGU + 512 * 1024;
constexpr size_t WS_END = 493 * MiB;
static_assert(WS_SS + (size_t)MT * 16 * 4 <= WS_W1IN && WS_XN + (size_t)MT * DM * 2 <= WS_ACT && WS_ACT + (size_t)MT * LDF * 2 <= WS_F &&
              WS_F + (size_t)MT * DM * 4 <= WS_H && WS_H + (size_t)MT * DM * 4 <= WS_QB &&
              WS_GVB + (size_t)MT * DM * 2 <= WS_F && WS_SGU + (size_t)MT * DM * 2 <= WS_H && true &&
              WS_W2OUT + (size_t)DM * LDF * 2 <= WS_XN && WS_W1IN + (size_t)2 * DFF * DM * 2 <= WS_W1OUT && WS_W1OUT + (size_t)DM * LDF * 2 <= WS_WIN &&
              WS_WIN + (size_t)INC * DM * 2 <= WS_WA && WS_W2IN + (size_t)2 * DFF * DM * 2 <= WS_W2OUT, "d_ws map");
constexpr int CW_BAR = 4096;
constexpr int CW_CH = 2048;
constexpr int CW_Q = 1024;

constexpr int RING_BYTES = 131072, MISC_OFF = RING_BYTES + 320, LDS_BYTES = 147456;
constexpr int NWAVES = 8;

#define GAS __attribute__((address_space(1)))
#define LAS __attribute__((address_space(3)))
typedef unsigned short bf16;
typedef unsigned v4u __attribute__((ext_vector_type(4)));
typedef unsigned v2u __attribute__((ext_vector_type(2)));
typedef float f32x4 __attribute__((ext_vector_type(4)));
#define LDS_WAIT() asm volatile("s_waitcnt lgkmcnt(0)" ::: "memory")
__device__ __forceinline__ unsigned f2bf(float f) { unsigned u = __builtin_bit_cast(unsigned, f); return (u + 0x7fffu + ((u >> 16) & 1u)) >> 16; }
__device__ __forceinline__ unsigned pk2(float lo, float hi) { return f2bf(lo) | (f2bf(hi) << 16); }
__device__ __forceinline__ float bf2f(unsigned short b) { return __builtin_bit_cast(float, (unsigned)b << 16); }
__device__ __forceinline__ float bflo(unsigned w) { return __builtin_bit_cast(float, w << 16); }
__device__ __forceinline__ float bfhi(unsigned w) { return __builtin_bit_cast(float, w & 0xffff0000u); }
template <int CTRL> __device__ __forceinline__ float dppf_(float x) { return __uint_as_float((unsigned)__builtin_amdgcn_update_dpp(0, (int)__float_as_uint(x), CTRL, 0xf, 0xf, false)); }
__device__ __forceinline__ float rowsum16_(float x) { x += dppf_<0x128>(x); x += dppf_<0x124>(x); x += dppf_<0x122>(x); x += dppf_<0x121>(x); return x; }
__device__ __forceinline__ float xsum16_(float x) { const auto r = __builtin_amdgcn_permlane16_swap(__float_as_uint(x), __float_as_uint(x), false, false); return __uint_as_float(r[0]) + __uint_as_float(r[1]); }
__device__ __forceinline__ float xsum32_(float x) { const auto r = __builtin_amdgcn_permlane32_swap(__float_as_uint(x), __float_as_uint(x), false, false); return __uint_as_float(r[0]) + __uint_as_float(r[1]); }
__device__ __forceinline__ float wave_sum(float v) { return xsum32_(xsum16_(rowsum16_(v))); }
__device__ __forceinline__ float fast_rcp(float x) { return __builtin_amdgcn_rcpf(x); }
__device__ __forceinline__ float sigmoidf_(float x) { return fast_rcp(1.0f + __builtin_amdgcn_exp2f(-1.4426950408889634f * x)); }
__device__ __forceinline__ float siluf_(float x) { return x * sigmoidf_(x); }
__device__ __forceinline__ float geluf_(float x) { const float z = 1.5957691216057308f * (x + 0.044715f * x * x * x); return x * sigmoidf_(z); }

typedef float f32x4_pk __attribute__((ext_vector_type(4)));
__device__ __forceinline__ f32x4_pk sigden4_(f32x4_pk q) {
    f32x4_pk e; e[0] = __builtin_amdgcn_exp2f(q[0]); e[1] = __builtin_amdgcn_exp2f(q[1]); e[2] = __builtin_amdgcn_exp2f(q[2]); e[3] = __builtin_amdgcn_exp2f(q[3]);
    const f32x4_pk d = e + 1.0f;
    f32x4_pk r; r[0] = __builtin_amdgcn_rcpf(d[0]); r[1] = __builtin_amdgcn_rcpf(d[1]); r[2] = __builtin_amdgcn_rcpf(d[2]); r[3] = __builtin_amdgcn_rcpf(d[3]);
    return r;
}
__device__ __forceinline__ f32x4_pk sigmoid4_(f32x4_pk x) { return sigden4_(x * -1.4426950408889634f); }
__device__ __forceinline__ f32x4_pk silu4_(f32x4_pk x) { return x * sigmoid4_(x); }
__device__ __forceinline__ f32x4_pk gelu4_(f32x4_pk x) {
    constexpr float GA_ = -1.5957691216057308f * 1.4426950408889634f, GB_ = GA_ * 0.044715f;
    const f32x4_pk t = x * x, w = t * GB_ + GA_;
    return x * sigden4_(x * w);
}

namespace pg8 {
struct EpiSwiglu {
    static constexpr bool PERM = true, DUAL = false;
    bf16_t* O;
    __device__ __forceinline__ void operator()(const f32x4 (&acc)[2][2][4][2], const Unit& u, int wr, int wc, int fr, int fq) const {
        const int row0 = u.pm * BM + wr * 64 + fr, col0 = u.pn * 128 + wc * 32 + 8 * fq;
#pragma unroll
        for (int ai = 0; ai < 2; ++ai)
#pragma unroll
            for (int m = 0; m < 4; ++m) {
                const f32x4 a0 = acc[ai][0][m][0], a1 = acc[ai][0][m][1], b0 = acc[ai][1][m][0], b1 = acc[ai][1][m][1];
                u32x4 w;
                const f32x4 y0 = silu4_(a0) * b0, y1 = silu4_(a1) * b1;
                w.x = cvt_pk_bf16(y0[0], y0[1]); w.y = cvt_pk_bf16(y0[2], y0[3]); w.z = cvt_pk_bf16(y1[0], y1[1]); w.w = cvt_pk_bf16(y1[2], y1[3]);
                *(u32x4*)(O + (size_t)(row0 + ai * HALF + m * 16) * LDF + col0) = w;
            }
    }
};
struct EpiSwigluHalfM {
    static constexpr bool PERM = true, DUAL = false;
    bf16_t* O;
    __device__ __forceinline__ void operator()(const f32x4 (&acc)[2][2][4][2], const Unit& u, int wr, int wc, int fr, int fq) const {
        const int row0 = u.pm * HALF + wr * 64 + fr, col0 = u.pn * 128 + wc * 32 + 8 * fq;
#pragma unroll
        for (int m = 0; m < 4; ++m) {
            const f32x4 a0 = acc[0][0][m][0], a1 = acc[0][0][m][1], b0 = acc[0][1][m][0], b1 = acc[0][1][m][1];
            u32x4 w;
            const f32x4 y0 = silu4_(a0) * b0, y1 = silu4_(a1) * b1;
            w.x = cvt_pk_bf16(y0[0], y0[1]); w.y = cvt_pk_bf16(y0[2], y0[3]); w.z = cvt_pk_bf16(y1[0], y1[1]); w.w = cvt_pk_bf16(y1[2], y1[3]);
            *(u32x4*)(O + (size_t)(row0 + m * 16) * LDF + col0) = w;
        }
    }
};
struct EpiF32Stats {
    static constexpr bool PERM = true, DUAL = false;
    bf16_t* O; float* SS;
    __device__ __forceinline__ void operator()(const f32x4 (&acc)[2][2][4][2], const Unit& u, int wr, int wc, int fr, int fq) const {
        const int row0 = u.pm * BM + wr * 64 + fr, col0 = u.pn * BM + wc * 32 + 8 * fq;
#pragma unroll
        for (int ai = 0; ai < 2; ++ai)
#pragma unroll
            for (int m = 0; m < 4; ++m) {
                const int row = row0 + ai * HALF + m * 16; float s = 0.f;
#pragma unroll
                for (int bj = 0; bj < 2; ++bj) { const f32x4 v0 = acc[ai][bj][m][0], v1 = acc[ai][bj][m][1];
                    u32x4 w; w.x = cvt_pk_bf16(v0[0], v0[1]); w.y = cvt_pk_bf16(v0[2], v0[3]); w.z = cvt_pk_bf16(v1[0], v1[1]); w.w = cvt_pk_bf16(v1[2], v1[3]);
                    *(u32x4*)(O + (size_t)row * DM + col0 + bj * HALF) = w;
                    s += (v0[0] * v0[0] + v0[1] * v0[1]) + (v0[2] * v0[2] + v0[3] * v0[3]) + (v1[0] * v1[0] + v1[1] * v1[1]) + (v1[2] * v1[2] + v1[3] * v1[3]); }
                s = xsum32_(xsum16_(s));
                if (fq == 0) SS[(size_t)row * 16 + u.pn * 4 + wc] = s;
            }
    }
};
struct EpiProj {
    static constexpr bool PERM = true, DUAL = false;
    bf16_t *Qb, *Kp, *Vp, *Ub, *GVb, *SGA, *SGB; float* kout; float* vout; float* SS; const float* rope; bool samp;
    __device__ __forceinline__ void operator()(const f32x4 (&acc)[2][2][4][2], const Unit& u, int wr, int wc, int fr, int fq) const {
        const int type = u.pn >> 2, cb = (u.pn & 3) * 256;
        const int row0 = u.pm * BM + wr * 64 + fr, col0 = cb + wc * 32 + 8 * fq;
        if (type <= 1) {
            const bool ropew = ((wc & 1) == 0);
            auto& A = const_cast<f32x4 (&)[2][2][4][2]>(acc);
            if (ropew) {
                f32x4 nx0, nx1, nx2, nx3;
                { const int pos = samp ? (PAST + (row0 & 15)) : row0; const f32x4* cp = (const f32x4*)(rope + (size_t)pos * 16); nx0 = cp[0]; nx1 = cp[1]; nx2 = cp[2]; nx3 = cp[3]; }
#pragma unroll
                for (int ai = 0; ai < 2; ++ai)
#pragma unroll
                    for (int m = 0; m < 4; ++m) {
                        const f32x4 cs[2] = {nx0, nx1}, sn[2] = {nx2, nx3};
                        if (ai * 4 + m < 7) { const int it1 = ai * 4 + m + 1, rown = row0 + (it1 >> 2) * HALF + (it1 & 3) * 16; const int pos = samp ? (PAST + (rown & 15)) : rown;
                            const f32x4* cp = (const f32x4*)(rope + (size_t)pos * 16); nx0 = cp[0]; nx1 = cp[1]; nx2 = cp[2]; nx3 = cp[3]; }
#pragma unroll
                        for (int bj = 0; bj < 2; ++bj)
#pragma unroll
                            for (int n = 0; n < 2; ++n)
#pragma unroll
                                for (int e = 0; e < 4; ++e) {
                                    const float x = A[ai][bj][m][n][e];
                                    const auto rr_ = __builtin_amdgcn_permlane16_swap(__float_as_uint(x), __float_as_uint(x), false, false);
                                    const float p = __uint_as_float((fq & 1) ? rr_[0] : rr_[1]);
                                    const float sgn = (fq == 0) ? -sn[n][e] : sn[n][e];
                                    const float rot = x * cs[n][e] + p * sgn;
                                    A[ai][bj][m][n][e] = (fq < 2) ? rot : x;
                                }
                    }
            }
#pragma unroll
            for (int ai = 0; ai < 2; ++ai)
#pragma unroll
                for (int m = 0; m < 4; ++m) {
                    const int row = row0 + ai * HALF + m * 16;
                    f32x4 v[2][2];
#pragma unroll
                    for (int bj = 0; bj < 2; ++bj)
#pragma unroll
                        for (int n = 0; n < 2; ++n) v[bj][n] = A[ai][bj][m][n];
                    if (type == 0) {
#pragma unroll
                        for (int bj = 0; bj < 2; ++bj) {
                            u32x4 w; w.x = cvt_pk_bf16(v[bj][0][0] * C2, v[bj][0][1] * C2); w.y = cvt_pk_bf16(v[bj][0][2] * C2, v[bj][0][3] * C2);
                            w.z = cvt_pk_bf16(v[bj][1][0] * C2, v[bj][1][1] * C2); w.w = cvt_pk_bf16(v[bj][1][2] * C2, v[bj][1][3] * C2);
                            *(u32x4*)(Qb + (size_t)row * DM + col0 + bj * HALF) = w;
                        }
                    } else {
                        float* kp = kout + (size_t)row * DM;
#pragma unroll
                        for (int bj = 0; bj < 2; ++bj) {
                            if (samp) { *(f32x4*)(kp + col0 + bj * HALF) = v[bj][0]; *(f32x4*)(kp + col0 + bj * HALF + 4) = v[bj][1]; }
                            if (!samp) {
                                u32x4 w; w.x = cvt_pk_bf16(v[bj][0][0], v[bj][0][1]); w.y = cvt_pk_bf16(v[bj][0][2], v[bj][0][3]);
                                w.z = cvt_pk_bf16(v[bj][1][0], v[bj][1][1]); w.w = cvt_pk_bf16(v[bj][1][2], v[bj][1][3]);
                                *(u32x4*)(Kp + (size_t)row * DM + col0 + bj * HALF) = w;
                            }
                        }
                    }
                }
        } else if (type == 2) {
#pragma unroll
            for (int ai = 0; ai < 2; ++ai)
#pragma unroll
                for (int m = 0; m < 4; ++m) {
                    const int row = row0 + ai * HALF + m * 16;
                    float* vp = vout + (size_t)row * DM;
#pragma unroll
                    for (int bj = 0; bj < 2; ++bj) {
                        const f32x4 v0 = acc[ai][bj][m][0], v1 = acc[ai][bj][m][1];
                        if (samp) { *(f32x4*)(vp + col0 + bj * HALF) = v0; *(f32x4*)(vp + col0 + bj * HALF + 4) = v1; }
                        if (!samp) {
                            const int c8 = col0 + bj * HALF, hh = c8 >> 7, cc = c8 & 127;
                            bf16_t* vt = Vp + (((size_t)(hh * (SEQ / 64) + (row >> 6)) * 128 + cc) << 6) + (row & 63);
                            vt[0 * 64] = (bf16_t)(cvt_pk_bf16(v0[0], 0.f) & 0xffffu); vt[1 * 64] = (bf16_t)(cvt_pk_bf16(v0[1], 0.f) & 0xffffu);
                            vt[2 * 64] = (bf16_t)(cvt_pk_bf16(v0[2], 0.f) & 0xffffu); vt[3 * 64] = (bf16_t)(cvt_pk_bf16(v0[3], 0.f) & 0xffffu);
                            vt[4 * 64] = (bf16_t)(cvt_pk_bf16(v1[0], 0.f) & 0xffffu); vt[5 * 64] = (bf16_t)(cvt_pk_bf16(v1[1], 0.f) & 0xffffu);
                            vt[6 * 64] = (bf16_t)(cvt_pk_bf16(v1[2], 0.f) & 0xffffu); vt[7 * 64] = (bf16_t)(cvt_pk_bf16(v1[3], 0.f) & 0xffffu);
                        }
                    }
                }
        } else if (type <= 4) {
            bf16_t* O = (type == 3) ? Ub : GVb;
#pragma unroll
            for (int ai = 0; ai < 2; ++ai)
#pragma unroll
                for (int m = 0; m < 4; ++m) {
                    const int row = row0 + ai * HALF + m * 16; float s = 0.f;
#pragma unroll
                    for (int bj = 0; bj < 2; ++bj) {
                        const f32x4 v0 = gelu4_(acc[ai][bj][m][0]), v1 = gelu4_(acc[ai][bj][m][1]);
                        { const f32x4 sq = v0 * v0 + v1 * v1; s += (sq[0] + sq[1]) + (sq[2] + sq[3]); }
                        u32x4 w; w.x = cvt_pk_bf16(v0[0], v0[1]); w.y = cvt_pk_bf16(v0[2], v0[3]); w.z = cvt_pk_bf16(v1[0], v1[1]); w.w = cvt_pk_bf16(v1[2], v1[3]);
                        *(u32x4*)(O + (size_t)row * DM + col0 + bj * HALF) = w;
                    }
                    if (type == 4) { s = xsum32_(xsum16_(s)); if (fq == 0) SS[(size_t)row * 16 + (u.pn & 3) * 4 + wc] = s; }
                }
        } else {
            bf16_t* O = (type == 5) ? SGA : SGB;
#pragma unroll
            for (int ai = 0; ai < 2; ++ai)
#pragma unroll
                for (int m = 0; m < 4; ++m) {
                    const int row = row0 + ai * HALF + m * 16;
#pragma unroll
                    for (int bj = 0; bj < 2; ++bj) {
                        const f32x4 v0 = acc[ai][bj][m][0], v1 = acc[ai][bj][m][1];
#ifdef EXP_CONST
                        u32x4 w; w.x = 0x3f803f80u; w.y = 0x3f803f80u; w.z = 0x3f803f80u; w.w = 0x3f803f80u; (void)v0; (void)v1;
#else
                        const f32x4 g0 = sigmoid4_(v0), g1 = sigmoid4_(v1);
                        u32x4 w; w.x = cvt_pk_bf16(g0[0], g0[1]); w.y = cvt_pk_bf16(g0[2], g0[3]); w.z = cvt_pk_bf16(g1[0], g1[1]); w.w = cvt_pk_bf16(g1[2], g1[3]);
#endif
                        *(u32x4*)(O + (size_t)row * DM + col0 + bj * HALF) = w;
                    }
                }
        }
    }
};
struct EpiGateA {
    static constexpr bool PERM = false, DUAL = false;
    float* T1; const bf16_t* SG;
    __device__ __forceinline__ void operator()(const f32x4 (&acc)[2][2][4][2], const Unit& u, int wr, int wc, int fr, int fq) const {
        const int row0 = u.pm * BM + wr * 64 + fr, col0 = u.pn * BM + wc * 32 + 4 * fq;
#pragma unroll
        for (int ai = 0; ai < 2; ++ai)
#pragma unroll
            for (int m = 0; m < 4; ++m) {
                const size_t ro = (size_t)(row0 + ai * HALF + m * 16) * DM + col0;
#pragma unroll
                for (int bj = 0; bj < 2; ++bj)
#pragma unroll
                    for (int n = 0; n < 2; ++n) {
                        const u32x2 g = *(const u32x2*)(SG + ro + bj * HALF + n * 16); const f32x4 v = acc[ai][bj][m][n];
                        f32x4 o; o[0] = v[0] * bflo(g.x); o[1] = v[1] * bfhi(g.x); o[2] = v[2] * bflo(g.y); o[3] = v[3] * bfhi(g.y);
                        *(f32x4*)(T1 + ro + bj * HALF + n * 16) = o;
                    }
            }
    }
};
struct EpiGateB {
    static constexpr bool PERM = true, DUAL = false;
    const float* T1; const bf16_t* SG; bf16_t* O;
    __device__ __forceinline__ void operator()(const f32x4 (&acc)[2][2][4][2], const Unit& u, int wr, int wc, int fr, int fq) const {
        const int row0 = u.pm * BM + wr * 64 + fr, col0 = u.pn * BM + wc * 32 + 8 * fq;
#pragma unroll
        for (int ai = 0; ai < 2; ++ai)
#pragma unroll
            for (int m = 0; m < 4; ++m) {
                const size_t ro = (size_t)(row0 + ai * HALF + m * 16) * DM + col0;
#pragma unroll
                for (int bj = 0; bj < 2; ++bj) {
                    const u32x4 g = *(const u32x4*)(SG + ro + bj * HALF);
                    const f32x4 t0 = *(const f32x4*)(T1 + ro + bj * HALF), t1 = *(const f32x4*)(T1 + ro + bj * HALF + 4);
                    const f32x4 v0 = acc[ai][bj][m][0], v1 = acc[ai][bj][m][1];
                    u32x4 w;
#ifndef GATEB_MODE
#define GATEB_MODE 0
#endif
                    const float ka = (GATEB_MODE == 2) ? 0.f : 1.f, kb = (GATEB_MODE == 1) ? 0.f : 1.f;
                    w.x = cvt_pk_bf16(ka * t0[0] + kb * v0[0] * bflo(g.x), ka * t0[1] + kb * v0[1] * bfhi(g.x)); w.y = cvt_pk_bf16(ka * t0[2] + kb * v0[2] * bflo(g.y), ka * t0[3] + kb * v0[3] * bfhi(g.y));
                    w.z = cvt_pk_bf16(ka * t1[0] + kb * v1[0] * bflo(g.z), ka * t1[1] + kb * v1[1] * bfhi(g.z)); w.w = cvt_pk_bf16(ka * t1[2] + kb * v1[2] * bflo(g.w), ka * t1[3] + kb * v1[3] * bfhi(g.w));
                    *(u32x4*)(O + ro + bj * HALF) = w;
                }
            }
    }
};
struct EpiGateAB {
    static constexpr bool PERM = true, DUAL = true;
    const bf16_t* SGa; const bf16_t* SGb; bf16_t* O;
    __device__ __forceinline__ void operator()(f32x4 (&acc)[2][2][4][2], const Unit& u, int wr, int wc, int fr, int fq) const {
        const int row0 = u.pm * BM + wr * 64 + fr, col0 = u.pn * BM + wc * 32 + 8 * fq;
#pragma unroll
        for (int ai = 0; ai < 2; ++ai)
#pragma unroll
            for (int m = 0; m < 4; ++m) {
                const size_t ro = (size_t)(row0 + ai * HALF + m * 16) * DM + col0;
                const u32x4 gbr[2] = {*(const u32x4*)(SGb + ro), *(const u32x4*)(SGb + ro + HALF)};
                const u32x4 gar[2] = {*(const u32x4*)(SGa + ro), *(const u32x4*)(SGa + ro + HALF)};
#pragma unroll
                for (int bj = 0; bj < 2; ++bj) {
                    const u32x4 gb = gbr[bj];
                    f32x4& v0 = acc[ai][bj][m][0]; f32x4& v1 = acc[ai][bj][m][1];
                    if (u.w == 0) {
                        const u32x4 ga = gar[bj];
                        v0[0] *= bflo(ga.x) * __builtin_amdgcn_rcpf(bflo(gb.x)); v0[1] *= bfhi(ga.x) * __builtin_amdgcn_rcpf(bfhi(gb.x));
                        v0[2] *= bflo(ga.y) * __builtin_amdgcn_rcpf(bflo(gb.y)); v0[3] *= bfhi(ga.y) * __builtin_amdgcn_rcpf(bfhi(gb.y));
                        v1[0] *= bflo(ga.z) * __builtin_amdgcn_rcpf(bflo(gb.z)); v1[1] *= bfhi(ga.z) * __builtin_amdgcn_rcpf(bfhi(gb.z));
                        v1[2] *= bflo(ga.w) * __builtin_amdgcn_rcpf(bflo(gb.w)); v1[3] *= bfhi(ga.w) * __builtin_amdgcn_rcpf(bfhi(gb.w));
                    } else {
                        v0[0] *= bflo(gb.x); v0[1] *= bfhi(gb.x); v0[2] *= bflo(gb.y); v0[3] *= bfhi(gb.y);
                        v1[0] *= bflo(gb.z); v1[1] *= bfhi(gb.z); v1[2] *= bflo(gb.w); v1[3] *= bfhi(gb.w);
                    }
                }
            }
        if (u.w != 0) {
#pragma unroll
            for (int ai = 0; ai < 2; ++ai)
#pragma unroll
                for (int m = 0; m < 4; ++m) {
                    const size_t ro = (size_t)(row0 + ai * HALF + m * 16) * DM + col0;
#pragma unroll
                    for (int bj = 0; bj < 2; ++bj) {
                        const f32x4 v0 = acc[ai][bj][m][0], v1 = acc[ai][bj][m][1];
                        u32x4 w; w.x = cvt_pk_bf16(v0[0], v0[1]); w.y = cvt_pk_bf16(v0[2], v0[3]); w.z = cvt_pk_bf16(v1[0], v1[1]); w.w = cvt_pk_bf16(v1[2], v1[3]);
                        *(u32x4*)(O + ro + bj * HALF) = w;
                    }
                }
        }
    }
};
}

namespace att {
using bf16x8 = __attribute__((ext_vector_type(8))) short;
using s16x4 = __attribute__((ext_vector_type(4))) short;
using f32x16 = __attribute__((ext_vector_type(16))) float;
using f32x8 = __attribute__((ext_vector_type(8))) float;
using u32x4 = __attribute__((ext_vector_type(4))) unsigned;
constexpr int KVBLK = 64, LDR = 1024;
constexpr int SHM_V = KVBLK * 128 * 2, SHM_K = KVBLK * 128 * 2, SHM_ATTN = 3 * SHM_V + 3 * SHM_K + 8 * 64 * 4;
constexpr float THRL = 8.f;
#define KSWZ(row, colB) ((row) * 256 + ((colB) ^ (((row) & 15) << 4)))
#define SBAR() __builtin_amdgcn_sched_barrier(0)
__device__ __forceinline__ int crow(int r, int hi) { return (r & 3) + 8 * (r >> 2) + 4 * hi; }
__device__ __forceinline__ unsigned cvtpk(float lo, float hi) { return pg8::cvt_pk_bf16(lo, hi); }
__device__ __forceinline__ bf16x8 tobf(f32x8 x) { u32x4 w = {cvtpk(x[0], x[1]), cvtpk(x[2], x[3]), cvtpk(x[4], x[5]), cvtpk(x[6], x[7])}; return *reinterpret_cast<bf16x8*>(&w); }

__device__ __forceinline__ void partialSM(f32x16& p0, f32x16& p1, float& m_reg, float& alpha) {
    float m0 = fmaxf(fmaxf(p0[0], p0[1]), p0[2]), m1 = fmaxf(fmaxf(p0[3], p0[4]), p0[5]), m2 = fmaxf(fmaxf(p1[0], p1[1]), p1[2]), m3 = fmaxf(fmaxf(p1[3], p1[4]), p1[5]);
    m0 = fmaxf(fmaxf(m0, p0[6]), p0[7]); m1 = fmaxf(fmaxf(m1, p0[8]), p0[9]); m2 = fmaxf(fmaxf(m2, p1[6]), p1[7]); m3 = fmaxf(fmaxf(m3, p1[8]), p1[9]);
    m0 = fmaxf(fmaxf(m0, p0[10]), p0[11]); m1 = fmaxf(fmaxf(m1, p0[12]), p0[13]); m2 = fmaxf(fmaxf(m2, p1[10]), p1[11]); m3 = fmaxf(fmaxf(m3, p1[12]), p1[13]);
    m0 = fmaxf(fmaxf(m0, p0[14]), p0[15]); m2 = fmaxf(fmaxf(m2, p1[14]), p1[15]);
    float pmax = fmaxf(fmaxf(m0, m1), fmaxf(m2, m3));
    { auto rr = __builtin_amdgcn_permlane32_swap(__float_as_uint(pmax), __float_as_uint(pmax), false, false);
      pmax = fmaxf(__uint_as_float(rr[0]), __uint_as_float(rr[1])); }
    float mn;
    if (__builtin_expect(__all(pmax - m_reg <= THRL), 1)) { mn = m_reg; alpha = 1.f; }
    else { mn = fmaxf(m_reg, pmax); alpha = __builtin_amdgcn_exp2f(m_reg - mn); m_reg = mn; }
#pragma unroll
    for (int r = 0; r < 16; ++r) p0[r] = p0[r] - mn;
#pragma unroll
    for (int r = 0; r < 16; ++r) p1[r] = p1[r] - mn;
#pragma unroll
    for (int r = 0; r < 16; ++r) p0[r] = __builtin_amdgcn_exp2f(p0[r]);
}
__device__ __forceinline__ void finishSM(f32x16& p0, f32x16& p1, float alpha, float& l_reg, bf16x8& pa0, bf16x8& pa1, bf16x8& pa2, bf16x8& pa3) {
#pragma unroll
    for (int r = 0; r < 16; ++r) p1[r] = __builtin_amdgcn_exp2f(p1[r]);
    float s0 = p0[0] + p0[1], s1 = p0[2] + p0[3], s2 = p1[0] + p1[1], s3 = p1[2] + p1[3];
#pragma unroll
    for (int r = 4; r < 16; r += 2) { if (r & 2) { s1 += p0[r] + p0[r + 1]; s3 += p1[r] + p1[r + 1]; } else { s0 += p0[r] + p0[r + 1]; s2 += p1[r] + p1[r + 1]; } }
    float ps = (s0 + s1) + (s2 + s3);
    { auto rr = __builtin_amdgcn_permlane32_swap(__float_as_uint(ps), __float_as_uint(ps), false, false);
      ps = __uint_as_float(rr[0]) + __uint_as_float(rr[1]); }
    l_reg = l_reg * alpha + ps;
#define PK4(P, BASE, OUT) do { unsigned a0 = cvtpk(P[BASE + 0], P[BASE + 1]), a1 = cvtpk(P[BASE + 2], P[BASE + 3]);   \
    unsigned b0 = cvtpk(P[BASE + 4], P[BASE + 5]), b1 = cvtpk(P[BASE + 6], P[BASE + 7]);                              \
    auto r0 = __builtin_amdgcn_permlane32_swap(a0, b0, false, false); auto r1 = __builtin_amdgcn_permlane32_swap(a1, b1, false, false); \
    u32x4 w = {r0[0], r1[0], r0[1], r1[1]}; OUT = *reinterpret_cast<bf16x8*>(&w); } while (0)
    PK4(p0, 0, pa0); PK4(p0, 8, pa1); PK4(p1, 0, pa2); PK4(p1, 8, pa3);
#undef PK4
}
__device__ __forceinline__ void qkt(f32x16& p0, f32x16& p1, const char* Ks, const bf16x8* qr, int r32, int hi, int sub) {
    p0 = f32x16{}; p1 = f32x16{};
#pragma unroll
    for (int d0 = 0; d0 < 4; ++d0) { const int cb = (sub * 64 + d0 * 16 + hi * 8) * 2;
        const bf16x8 b0 = *reinterpret_cast<const bf16x8*>(Ks + KSWZ(r32, cb));
        const bf16x8 b1 = *reinterpret_cast<const bf16x8*>(Ks + KSWZ(32 + r32, cb));
        p0 = __builtin_amdgcn_mfma_f32_32x32x16_bf16(b0, qr[d0], p0, 0, 0, 0);
        p1 = __builtin_amdgcn_mfma_f32_32x32x16_bf16(b1, qr[d0], p1, 0, 0, 0); }
}
__device__ __forceinline__ int v_st(int k, int c) { const int kk = (k & ~0xC) | ((k & 4) << 1) | ((k & 8) >> 1); return ((kk >> 3) * 4 + (c >> 5)) * 512 + ((kk & 7) * 32 + (c & 31)) * 2; }
__device__ __forceinline__ int v_rd_base(int lane) { return ((lane & 3) << 3) | (((lane >> 2) & 3) << 6) | (((lane >> 4) & 1) << 5) | (((lane >> 5) & 1) << 8); }
constexpr int v_rd_off(int d0, int ks, int half) { return d0 * 512 + ks * 4096 + half * 2048; }
typedef short v4i16_t __attribute__((ext_vector_type(4)));
typedef __attribute__((address_space(3))) const char* lds_cptr;
template <int OFF> __device__ __forceinline__ s16x4 tr_read(lds_cptr vp) {
    return __builtin_bit_cast(s16x4, __builtin_amdgcn_ds_read_tr16_b64_v4i16((__attribute__((address_space(3))) v4i16_t*)(vp + OFF)));
}
template <int D0> __device__ __forceinline__ void pv_one(f32x16& od, lds_cptr vb, bf16x8 pa0, bf16x8 pa1, bf16x8 pa2, bf16x8 pa3) {
    const s16x4 l0 = tr_read<v_rd_off(D0, 0, 0)>(vb), h0 = tr_read<v_rd_off(D0, 0, 1)>(vb), l1 = tr_read<v_rd_off(D0, 1, 0)>(vb), h1 = tr_read<v_rd_off(D0, 1, 1)>(vb);
    const s16x4 l2 = tr_read<v_rd_off(D0, 2, 0)>(vb), h2 = tr_read<v_rd_off(D0, 2, 1)>(vb), l3 = tr_read<v_rd_off(D0, 3, 0)>(vb), h3 = tr_read<v_rd_off(D0, 3, 1)>(vb);
#define PK(L, H) (bf16x8){L[0], L[1], L[2], L[3], H[0], H[1], H[2], H[3]}
    od = __builtin_amdgcn_mfma_f32_32x32x16_bf16(pa0, PK(l0, h0), od, 0, 0, 0);
    od = __builtin_amdgcn_mfma_f32_32x32x16_bf16(pa1, PK(l1, h1), od, 0, 0, 0);
    od = __builtin_amdgcn_mfma_f32_32x32x16_bf16(pa2, PK(l2, h2), od, 0, 0, 0);
    od = __builtin_amdgcn_mfma_f32_32x32x16_bf16(pa3, PK(l3, h3), od, 0, 0, 0);
#undef PK
}
__device__ __forceinline__ void pv_t(f32x16* o, const char* vt, const int* ko, bf16x8 pa0, bf16x8 pa1, bf16x8 pa2, bf16x8 pa3) {
#pragma unroll
    for (int d0 = 0; d0 < 4; ++d0) {
        const bf16x8 b0 = *reinterpret_cast<const bf16x8*>(vt + d0 * 4096 + ko[0]), b1 = *reinterpret_cast<const bf16x8*>(vt + d0 * 4096 + ko[1]);
        const bf16x8 b2 = *reinterpret_cast<const bf16x8*>(vt + d0 * 4096 + ko[2]), b3 = *reinterpret_cast<const bf16x8*>(vt + d0 * 4096 + ko[3]);
        o[d0] = __builtin_amdgcn_mfma_f32_32x32x16_bf16(pa0, b0, o[d0], 0, 0, 0);
        o[d0] = __builtin_amdgcn_mfma_f32_32x32x16_bf16(pa1, b1, o[d0], 0, 0, 0);
        o[d0] = __builtin_amdgcn_mfma_f32_32x32x16_bf16(pa2, b2, o[d0], 0, 0, 0);
        o[d0] = __builtin_amdgcn_mfma_f32_32x32x16_bf16(pa3, b3, o[d0], 0, 0, 0);
    }
}
__device__ __forceinline__ void pv_d0(f32x16* o, lds_cptr vb, bf16x8 pa0, bf16x8 pa1, bf16x8 pa2, bf16x8 pa3) {
    pv_one<0>(o[0], vb, pa0, pa1, pa2, pa3); pv_one<1>(o[1], vb, pa0, pa1, pa2, pa3); pv_one<2>(o[2], vb, pa0, pa1, pa2, pa3); pv_one<3>(o[3], vb, pa0, pa1, pa2, pa3);
}

struct Args {
    const unsigned short* Qb; const unsigned short* Kp; const unsigned short* Vp;
    const float* cK; const float* cV;
    const float* nK; const float* nV;
    unsigned short* ATT; const float* gsub;
    const unsigned short* Qs; unsigned short* ATTs;
    float* kpo; float* vpo;
};

template <bool SAMPLE>
__device__ __forceinline__ void attn_unit(const Args& A, int h, int qi, char* lds, float lam) {
    asm volatile("" : "+s"(h), "+s"(qi));
    int tid = threadIdx.x; asm volatile("" : "+v"(tid));
    const int lane = tid & 63, r32 = lane & 31, hi = lane >> 5;
    const int wid = __builtin_amdgcn_readfirstlane(tid >> 6), sub = wid >> 2, rg = wid & 3;
    char* V_lds = lds; char* K_lds = lds + 2 * SHM_V;
    float* ws = (float*)(lds + 3 * SHM_V + 3 * SHM_K) + wid * 64; float* li_l = ws; float* al_l = ws + 32;
    const int NT = SAMPLE ? 33 : 2 * qi + 2;
    float m_reg = -1e30f, l_reg = 0; f32x16 o[4] = {}; bf16x8 qr[4];
    {
        const int qrow = SAMPLE ? (qi * 16 + (r32 & 15)) : (qi * 128 + rg * 32 + r32);
        const unsigned short* Qw = (SAMPLE ? A.Qs : A.Qb) + (size_t)qrow * LDR + h * 128 + sub * 64 + hi * 8;
#pragma unroll
        for (int d0 = 0; d0 < 4; ++d0) qr[d0] = *reinterpret_cast<const bf16x8*>(Qw + d0 * 16);
    }
    const int sr = tid >> 4, sc = (tid & 15) * 8;
    const int vcol0 = tid >> 3, vcol1 = 64 + (tid >> 3), vch = tid & 7;
    const int vst0 = SAMPLE ? v_st(sr, sc) : vcol0 * 128 + ((vch ^ ((vcol0 >> 1) & 7)) << 4), vst1 = SAMPLE ? v_st(32 + sr, sc) : vcol1 * 128 + ((vch ^ ((vcol1 >> 1) & 7)) << 4);
    const lds_cptr vb0 = (lds_cptr)V_lds + v_rd_base(lane);
    const char* vtb = V_lds + r32 * 128; int vko[4];
#pragma unroll
    for (int ks = 0; ks < 4; ++ks) vko[ks] = ((2 * ks + hi) ^ ((r32 >> 1) & 7)) << 4;
    constexpr int SDEPTH = SAMPLE ? 2 : 1;
    using ST = typename std::conditional<SAMPLE, f32x8, bf16x8>::type;
    struct { ST vs0, vs1, ks0, ks1; } sr_[SDEPTH];
    constexpr unsigned ESZ = SAMPLE ? 4u : 2u;
    const unsigned lo0 = (unsigned)(sr * LDR + sc) * ESZ, lo1 = lo0 + 32u * LDR * ESZ, lon = (unsigned)((sr & 15) * LDR + sc) * 4u;
    const __amdgpu_buffer_rsrc_t rK = __builtin_amdgcn_make_buffer_rsrc((void*)(SAMPLE ? (const void*)A.cK : (const void*)A.Kp), 0, SAMPLE ? 16 * PAST * LDR * 4 : SEQ * LDR * 2, 0x00020000);
    const __amdgpu_buffer_rsrc_t rV = __builtin_amdgcn_make_buffer_rsrc((void*)(SAMPLE ? (const void*)A.cV : (const void*)A.Vp), 0, SAMPLE ? 16 * PAST * LDR * 4 : SEQ * LDR * 2, 0x00020000);
    const __amdgpu_buffer_rsrc_t rKn = __builtin_amdgcn_make_buffer_rsrc((void*)A.nK, 0, 256 * LDR * 4, 0x00020000);
    const __amdgpu_buffer_rsrc_t rVn = __builtin_amdgcn_make_buffer_rsrc((void*)A.nV, 0, 256 * LDR * 4, 0x00020000);
    const unsigned sbase = SAMPLE ? (unsigned)((qi * PAST * LDR + h * 128) * 4) : (unsigned)(h * 256), sbn = (unsigned)((qi * 16 * LDR + h * 128) * 4);
    const unsigned vl0 = (unsigned)tid * 16u, vl1 = vl0 + 8192u, vsb = (unsigned)h * (unsigned)(SEQ / 64) * 16384u;
    auto cv = [](ST x) -> bf16x8 { if constexpr (SAMPLE) return tobf(x); else return x; };
    auto bld = [](__amdgpu_buffer_rsrc_t r, unsigned vo, unsigned so) -> ST {
        if constexpr (SAMPLE) { const u32x4 a = __builtin_amdgcn_raw_buffer_load_b128(r, vo, so, 0), b = __builtin_amdgcn_raw_buffer_load_b128(r, vo + 16u, so, 0);
            f32x8 o; o[0] = __uint_as_float(a[0]); o[1] = __uint_as_float(a[1]); o[2] = __uint_as_float(a[2]); o[3] = __uint_as_float(a[3]);
            o[4] = __uint_as_float(b[0]); o[5] = __uint_as_float(b[1]); o[6] = __uint_as_float(b[2]); o[7] = __uint_as_float(b[3]); return o; }
        else { const u32x4 a = __builtin_amdgcn_raw_buffer_load_b128(r, vo, so, 0); return __builtin_bit_cast(bf16x8, a); }
    };
#define SLOAD(i, t) do { if (SAMPLE && (t) >= 32) { \
        sr_[i].vs0 = bld(rVn, lon, sbn); sr_[i].vs1 = sr_[i].vs0; sr_[i].ks0 = bld(rKn, lon, sbn); sr_[i].ks1 = sr_[i].ks0; \
    } else { const unsigned so_ = sbase + (unsigned)(t) * (64u * LDR * ESZ); \
        if constexpr (SAMPLE) { sr_[i].vs0 = bld(rV, lo0, so_); sr_[i].vs1 = bld(rV, lo1, so_); } else { const unsigned sv_ = vsb + (unsigned)(t) * 16384u; sr_[i].vs0 = bld(rV, vl0, sv_); sr_[i].vs1 = bld(rV, vl1, sv_); } \
        sr_[i].ks0 = bld(rK, lo0, so_); sr_[i].ks1 = bld(rK, lo1, so_); } } while (0)
#define SWRITE(b, i) do { *(bf16x8*)(V_lds + (b) * SHM_V + vst0) = cv(sr_[i].vs0);          \
    *(bf16x8*)(V_lds + (b) * SHM_V + vst1) = cv(sr_[i].vs1); const int kc = sc * 2;               \
    *(bf16x8*)(K_lds + (b) * SHM_K + KSWZ(sr, kc)) = cv(sr_[i].ks0);                       \
    *(bf16x8*)(K_lds + (b) * SHM_K + KSWZ(32 + sr, kc)) = cv(sr_[i].ks1); } while (0)
#define SWAIT() do { if constexpr (SDEPTH == 2) asm volatile("s_waitcnt vmcnt(4)" ::: "memory"); else asm volatile("s_waitcnt vmcnt(0)" ::: "memory"); } while (0)
#define RESC(a) do { if (__any((a) < 1.f)) { if (hi == 0) al_l[r32] = (a); asm volatile("s_waitcnt lgkmcnt(0)" ::: "memory"); \
    _Pragma("unroll") for (int d = 0; d < 4; ++d) _Pragma("unroll") for (int r = 0; r < 16; ++r) o[d][r] *= al_l[crow(r, hi)]; } } while (0)
#define MASK(P0, P1, t) do { if constexpr (SAMPLE) { if ((t) >= 32) { _Pragma("unroll") for (int r = 0; r < 16; ++r) { if (crow(r, hi) >= 16) P0[r] = -INFINITY; P1[r] = -INFINITY; } } } \
    else { if ((t) == NT - 1 && rg < 2) { _Pragma("unroll") for (int r = 0; r < 16; ++r) { P0[r] = -INFINITY; P1[r] = -INFINITY; } } } } while (0)
    bf16x8 pa0, pa1, pa2, pa3;
    if constexpr (SAMPLE) {
        f32x16 pA0, pA1; float alA = 1.f;
        SLOAD(0, 0); SLOAD(1, 1);
#define STILE(t, SL) do { SWRITE(SL, SL); if ((t) + 2 < NT) SLOAD(SL, (t) + 2); __syncthreads(); \
            if (rg == 0) { SBAR(); qkt(pA0, pA1, K_lds + (SL) * SHM_K, qr, r32, hi, sub); MASK(pA0, pA1, t); partialSM(pA0, pA1, m_reg, alA); RESC(alA); \
                finishSM(pA0, pA1, alA, l_reg, pa0, pa1, pa2, pa3); SBAR(); pv_d0(o, vb0 + (SL) * SHM_V, pa0, pa1, pa2, pa3); } } while (0)
        for (int t = 0; t + 1 < NT; t += 2) { STILE(t, 0); STILE(t + 1, 1); }
        STILE(NT - 1, 0);
#undef STILE
        __syncthreads();
    } else {
    f32x16 S0, S1; float alpha = 1.f; bf16x8 kf[4], vf[8], pl, ph_, pbl, pbh;
    const int grp = sub;
    typedef __attribute__((address_space(3))) unsigned lds_u;
    char* Kr = lds + 3 * SHM_V;
    int so_p = 2 * SHM_K, so_c = 0, so_n = SHM_K;
    const int krow0 = 8 * wid + (lane >> 4), krow1 = krow0 + 4, vcl0 = 16 * wid + (lane >> 3), vcl1 = vcl0 + 8;
    const unsigned kdo0 = (unsigned)krow0 * (LDR * 2u) + (unsigned)(((lane & 15) ^ (krow0 & 15)) << 4), kdo1 = (unsigned)krow1 * (LDR * 2u) + (unsigned)(((lane & 15) ^ (krow1 & 15)) << 4);
    const unsigned vdo0 = (unsigned)vcl0 * 128u + (unsigned)(((lane & 7) ^ ((vcl0 >> 1) & 7)) << 4), vdo1 = (unsigned)vcl1 * 128u + (unsigned)(((lane & 7) ^ ((vcl1 >> 1) & 7)) << 4);
#define KDMA_(t, so) do { const unsigned s_ = sbase + (unsigned)(t) * (64u * LDR * 2u); \
        __builtin_amdgcn_raw_ptr_buffer_load_lds(rK, (lds_u*)(Kr + (so) + wid * 2048), 16, kdo0, s_, 0, 0); \
        __builtin_amdgcn_raw_ptr_buffer_load_lds(rK, (lds_u*)(Kr + (so) + wid * 2048 + 1024), 16, kdo1, s_, 0, 0); } while (0)
#define VDMA_(t, so) do { const unsigned s_ = vsb + (unsigned)(t) * 16384u; \
        __builtin_amdgcn_raw_ptr_buffer_load_lds(rV, (lds_u*)(V_lds + (so) + wid * 2048), 16, vdo0, s_, 0, 0); \
        __builtin_amdgcn_raw_ptr_buffer_load_lds(rV, (lds_u*)(V_lds + (so) + wid * 2048 + 1024), 16, vdo1, s_, 0, 0); } while (0)
#define DST_(t) do { if ((t) + 3 < NT) KDMA_((t) + 3, so_c); if ((t) + 2 < NT) VDMA_((t) + 2, so_p); } while (0)
#define WAITV_(t) do { if ((t) + 2 < NT) asm volatile("s_waitcnt vmcnt(4)" ::: "memory"); else asm volatile("s_waitcnt vmcnt(0)" ::: "memory"); } while (0)
#define ROT_() do { const int t_ = so_p; so_p = so_c; so_c = so_n; so_n = t_; } while (0)
#define MEET_() do { asm volatile("s_waitcnt lgkmcnt(0)" ::: "memory"); __builtin_amdgcn_s_barrier(); asm volatile("" ::: "memory"); } while (0)
#define LSEG(HAVE_K, KSO, KH, HAVE_V, VSO, VH, STG, WT) do { \
        if (HAVE_K) { const char* kb_ = Kr + (KSO); \
            _Pragma("unroll") for (int d0 = 0; d0 < 4; ++d0) kf[d0] = *reinterpret_cast<const bf16x8*>(kb_ + KSWZ(32 * (KH) + r32, (sub * 64 + d0 * 16 + hi * 8) * 2)); } \
        if (HAVE_V) { const char* vb_ = vtb + (VSO); \
            _Pragma("unroll") for (int d0 = 0; d0 < 4; ++d0) { vf[2 * d0] = *reinterpret_cast<const bf16x8*>(vb_ + d0 * 4096 + vko[2 * (VH)]); vf[2 * d0 + 1] = *reinterpret_cast<const bf16x8*>(vb_ + d0 * 4096 + vko[2 * (VH) + 1]); } } \
        STG; \
        if ((WT) >= 0 && grp == 1) WAITV_(WT); \
        MEET_(); } while (0)
#define MF_(acc, A_, B_) acc = __builtin_amdgcn_mfma_f32_32x32x16_bf16(A_, B_, acc, 0, 0, 0)
#define EX_(SC, i) SC[i] = __builtin_amdgcn_exp2f(SC[i])
#define PKH_(SC, B0, OUT) do { const unsigned a0_ = cvtpk(SC[B0 + 0], SC[B0 + 1]), a1_ = cvtpk(SC[B0 + 2], SC[B0 + 3]), b0_ = cvtpk(SC[B0 + 4], SC[B0 + 5]), b1_ = cvtpk(SC[B0 + 6], SC[B0 + 7]); \
        auto r0_ = __builtin_amdgcn_permlane32_swap(a0_, b0_, false, false); auto r1_ = __builtin_amdgcn_permlane32_swap(a1_, b1_, false, false); \
        u32x4 w_ = {r0_[0], r1_[0], r0_[1], r1_[1]}; OUT = *reinterpret_cast<bf16x8*>(&w_); } while (0)
#define GQ_(HAVE_QK, X) do { SBAR(); if (HAVE_QK) { X; } SBAR(); } while (0)
#define CSEG(HAVE_QK, HAVE_PV, HAVE_SM, FIRST, SC, SN, PRL, PRH, PWL, PWH, WT) do { \
        float s0_ = 0.f, s1_ = 0.f, s2_ = 0.f, s3_ = 0.f, pmax_ = pmx, dlt_ = 0.f, n0_ = 0.f, n1_ = 0.f, n2_ = 0.f, n3_ = 0.f; bool ok_ = true; \
        unsigned c0_ = 0, c1_ = 0, c2_ = 0, c3_ = 0, c4_ = 0, c5_ = 0, c6_ = 0, c7_ = 0; \
        __builtin_amdgcn_s_setprio(2); \
        GQ_(HAVE_QK, SN = __builtin_amdgcn_mfma_f32_32x32x16_bf16(kf[0], qr[0], negm, 0, 0, 0)); \
        if (HAVE_SM) { ok_ = (FIRST) ? false : (bool)__all(pmax_ <= THRL);        \
            if (__builtin_expect(!ok_, 0)) { { auto rr_ = __builtin_amdgcn_permlane32_swap(__float_as_uint(pmax_), __float_as_uint(pmax_), false, false); pmax_ = fmaxf(__uint_as_float(rr_[0]), __uint_as_float(rr_[1])); } \
                dlt_ = (FIRST) ? pmax_ : fmaxf(pmax_, 0.f); m_reg += dlt_; alpha = (FIRST) ? 1.f : __builtin_amdgcn_exp2f(-dlt_); l_reg *= alpha; \
                _Pragma("unroll") for (int r = 0; r < 16; ++r) SC[r] -= dlt_; } \
            EX_(SC, 0); EX_(SC, 1); } \
        GQ_(HAVE_QK, MF_(SN, kf[1], qr[1])); if (HAVE_SM) { EX_(SC, 2); EX_(SC, 3); EX_(SC, 4); } \
        GQ_(HAVE_QK, MF_(SN, kf[2], qr[2])); if (HAVE_SM) { EX_(SC, 5); EX_(SC, 6); EX_(SC, 7); } \
        GQ_(HAVE_QK, MF_(SN, kf[3], qr[3])); if (HAVE_SM) { EX_(SC, 8); EX_(SC, 9); EX_(SC, 10); } \
        GQ_(HAVE_PV, MF_(o[0], PRL, vf[0])); if (HAVE_SM) { EX_(SC, 11); EX_(SC, 12); EX_(SC, 13); } \
        GQ_(HAVE_PV, MF_(o[0], PRH, vf[1])); if (HAVE_SM) { EX_(SC, 14); EX_(SC, 15); c0_ = cvtpk(SC[0], SC[1]); c1_ = cvtpk(SC[2], SC[3]); } \
        GQ_(HAVE_PV, MF_(o[1], PRL, vf[2])); if (HAVE_SM) { c2_ = cvtpk(SC[4], SC[5]); c3_ = cvtpk(SC[6], SC[7]); \
            auto r0_ = __builtin_amdgcn_permlane32_swap(c0_, c2_, false, false); auto r1_ = __builtin_amdgcn_permlane32_swap(c1_, c3_, false, false); \
            u32x4 w_ = {r0_[0], r1_[0], r0_[1], r1_[1]}; PWL = *reinterpret_cast<bf16x8*>(&w_); } \
        if (HAVE_QK) { n0_ = fmaxf(fmaxf(SN[0], SN[1]), SN[2]); n1_ = fmaxf(fmaxf(SN[3], SN[4]), SN[5]); }        \
        GQ_(HAVE_PV, MF_(o[1], PRH, vf[3])); if (HAVE_SM) { c4_ = cvtpk(SC[8], SC[9]); c5_ = cvtpk(SC[10], SC[11]); c6_ = cvtpk(SC[12], SC[13]); c7_ = cvtpk(SC[14], SC[15]); } \
        if (HAVE_QK) { n2_ = fmaxf(fmaxf(SN[6], SN[7]), SN[8]); n3_ = fmaxf(fmaxf(SN[9], SN[10]), SN[11]); } \
        GQ_(HAVE_PV, MF_(o[2], PRL, vf[4])); if (HAVE_SM) { auto r0_ = __builtin_amdgcn_permlane32_swap(c4_, c6_, false, false); auto r1_ = __builtin_amdgcn_permlane32_swap(c5_, c7_, false, false); \
            u32x4 w_ = {r0_[0], r1_[0], r0_[1], r1_[1]}; PWH = *reinterpret_cast<bf16x8*>(&w_); } \
        if (HAVE_QK) { const float n4_ = fmaxf(fmaxf(SN[12], SN[13]), SN[14]); n0_ = fmaxf(fmaxf(n0_, n1_), n2_); n3_ = fmaxf(fmaxf(n3_, n4_), SN[15]); } \
        GQ_(HAVE_PV, MF_(o[2], PRH, vf[5])); if (HAVE_QK) pmx = fmaxf(n0_, n3_); \
        if (HAVE_SM) { s0_ = SC[0] + SC[1]; s1_ = SC[2] + SC[3]; s2_ = SC[4] + SC[5]; s3_ = SC[6] + SC[7]; s0_ += SC[8]; s1_ += SC[9]; s2_ += SC[10]; s3_ += SC[11]; \
            s0_ += SC[12]; s1_ += SC[13]; s2_ += SC[14]; s3_ += SC[15]; s0_ += s1_; s2_ += s3_; s0_ += s2_; l_reg += s0_; }    \
        GQ_(HAVE_PV, MF_(o[3], PRL, vf[6])); \
        GQ_(HAVE_PV, MF_(o[3], PRH, vf[7])); \
        SBAR(); \
        if (HAVE_SM) { if (__builtin_expect(!ok_, 0)) { if (!(FIRST)) RESC(alpha); \
            if (HAVE_QK) { _Pragma("unroll") for (int r = 0; r < 16; ++r) SN[r] -= dlt_; pmx -= dlt_; } \
            _Pragma("unroll") for (int r = 0; r < 16; ++r) negm[r] = -m_reg; } } \
        __builtin_amdgcn_s_setprio(0); if ((WT) >= 0 && grp == 0) WAITV_(WT); MEET_(); } while (0)
    float pmx = 0.f;
    f32x16 negm = {}; m_reg = 0.f;
    KDMA_(0, 0); VDMA_(0, 0); KDMA_(1, SHM_K); VDMA_(1, SHM_V); if (2 < NT) KDMA_(2, 2 * SHM_K);
    asm volatile("s_waitcnt vmcnt(0)" ::: "memory");
    MEET_();
    if (grp == 1) MEET_();
    LSEG(true, 0, 0, false, 0, 0, (void)0, -1);             CSEG(true, false, false, false, S1, S0, pbl, pbh, pl, ph_, -1);
    LSEG(true, so_c, 1, false, 0, 0, (void)0, 0);           CSEG(true, false, true, true, S0, S1, pbl, pbh, pl, ph_, 0);
    LSEG(true, so_n, 0, true, so_c, 0, DST_(0), -1);        CSEG(true, true, true, false, S1, S0, pl, ph_, pbl, pbh, -1);
    ROT_();
#pragma clang loop unroll(disable)
    for (int t = 1; t < NT - 1; ++t) {
        LSEG(true, so_c, 1, true, so_p, 1, (void)0, t);     CSEG(true, true, true, false, S0, S1, pbl, pbh, pl, ph_, t);
        LSEG(true, so_n, 0, true, so_c, 0, DST_(t), -1);    CSEG(true, true, true, false, S1, S0, pl, ph_, pbl, pbh, -1);
        ROT_();
    }
    if (rg < 2) {
        LSEG(false, 0, 0, true, so_p, 1, (void)0, NT - 1);  CSEG(false, true, false, false, S0, S1, pbl, pbh, pl, ph_, NT - 1);
        LSEG(false, 0, 0, false, 0, 0, (void)0, -1);        CSEG(false, false, false, false, S0, S1, pbl, pbh, pl, ph_, -1);
        LSEG(false, 0, 0, false, 0, 0, (void)0, -1);        CSEG(false, false, false, false, S0, S1, pbl, pbh, pl, ph_, -1);
    } else {
        LSEG(true, so_c, 1, true, so_p, 1, (void)0, NT - 1); CSEG(true, true, true, false, S0, S1, pbl, pbh, pl, ph_, NT - 1);
        LSEG(false, 0, 0, true, so_c, 0, (void)0, -1);       CSEG(false, true, true, false, S1, S0, pl, ph_, pbl, pbh, -1);
        LSEG(false, 0, 0, true, so_c, 1, (void)0, -1);       CSEG(false, true, false, false, S0, S1, pbl, pbh, pl, ph_, -1);
    }
    if (grp == 0) MEET_();
    { auto rr_ = __builtin_amdgcn_permlane32_swap(__float_as_uint(l_reg), __float_as_uint(l_reg), false, false); l_reg = __uint_as_float(rr_[0]) + __uint_as_float(rr_[1]); }
#undef KDMA_
#undef VDMA_
#undef DST_
#undef WAITV_
#undef ROT_
#undef MEET_
#undef GQ_
#undef MF_
#undef EX_
#undef PKH_
#undef LSEG
#undef CSEG
    }
#undef SLOAD
#undef SWRITE
#undef SWAIT
#undef RESC
#undef MASK
    if (hi == 0) li_l[r32] = l_reg;
    asm volatile("s_waitcnt lgkmcnt(0)" ::: "memory");
    __syncthreads();
    float* X = (float*)lds;
    if (sub == 1 && (!SAMPLE || rg == 0)) {
#pragma unroll
        for (int r = 0; r < 16; ++r) { const float rl = __builtin_amdgcn_rcpf(li_l[crow(r, hi)]);
#pragma unroll
            for (int d0 = 0; d0 < 4; ++d0) X[((rg * 4 + d0) * 16 + r) * 64 + lane] = o[d0][r] * rl; }
    }
    __syncthreads();
    if (sub == 0 && (!SAMPLE || rg == 0)) {
        float gs[4];
#pragma unroll
        for (int d0 = 0; d0 < 4; ++d0) gs[d0] = A.gsub[d0 * 32 + r32];
#pragma unroll
        for (int r = 0; r < 16; ++r) {
            const int cr = crow(r, hi);
            const float rl = __builtin_amdgcn_rcpf(li_l[cr]);
            float d[4]; float v = 0.f;
#pragma unroll
            for (int d0 = 0; d0 < 4; ++d0) { d[d0] = o[d0][r] * rl - lam * X[((rg * 4 + d0) * 16 + r) * 64 + lane]; v += d[d0] * d[d0]; }
            v = xsum16_(rowsum16_(v));
            const float sc_ = (1.0f - LAM_INIT) / sqrtf(v * (1.0f / 128.0f) + EPS);
            const bool ok = SAMPLE ? (cr < 16) : true;
            const int orow = SAMPLE ? (qi * 16 + cr) : (qi * 128 + rg * 32 + cr);
            if (ok) {
                unsigned short* op = (SAMPLE ? A.ATTs : A.ATT) + (size_t)orow * LDR + h * 128 + r32;
#pragma unroll
                for (int d0 = 0; d0 < 4; ++d0) op[d0 * 32] = (unsigned short)f2bf(d[d0] * sc_ * gs[d0]);
            }
        }
    }
    if constexpr (!SAMPLE) {
    {
        const int kr_ = tid >> 2, kc_ = (tid & 3) * 32;
        const unsigned short* ks_ = A.Kp + (size_t)(qi * 128 + kr_) * LDR + h * 128 + kc_;
        float* kd_ = A.kpo + (size_t)(qi * 128 + kr_) * LDR + h * 128 + kc_;
#pragma unroll
        for (int i = 0; i < 4; ++i) { const u32x4 w = *(const u32x4*)(ks_ + 8 * i);
            f32x4 a, b; a[0] = __uint_as_float(w[0] << 16); a[1] = __uint_as_float(w[0] & 0xffff0000u); a[2] = __uint_as_float(w[1] << 16); a[3] = __uint_as_float(w[1] & 0xffff0000u);
            b[0] = __uint_as_float(w[2] << 16); b[1] = __uint_as_float(w[2] & 0xffff0000u); b[2] = __uint_as_float(w[3] << 16); b[3] = __uint_as_float(w[3] & 0xffff0000u);
            *(f32x4*)(kd_ + 8 * i) = a; *(f32x4*)(kd_ + 8 * i + 4) = b; }
        const int vt_ = 2 * qi + (wid >> 2);
        const unsigned short* vs_ = A.Vp + ((size_t)(h * (SEQ / 64) + vt_) * 128) * 64;
        float* vd_ = A.vpo + (size_t)(vt_ * 64) * LDR + h * 128;
#pragma unroll
        for (int cc = 0; cc < 2; ++cc) {
            const int col = lane + 64 * cc;
#pragma unroll
            for (int ch = 0; ch < 2; ++ch) { const int k0 = (2 * (wid & 3) + ch) * 8;
                const u32x4 w = *(const u32x4*)(vs_ + (size_t)col * 64 + k0);
#pragma unroll
                for (int e = 0; e < 4; ++e) { vd_[(size_t)(k0 + 2 * e) * LDR + col] = __uint_as_float(w[e] << 16); vd_[(size_t)(k0 + 2 * e + 1) * LDR + col] = __uint_as_float(w[e] & 0xffff0000u); } }
        }
    }
    }
    __syncthreads();
}
#undef KSWZ

struct SpArgs { const unsigned short* Ub; const unsigned short* GVb; const float* SS; const float* gsgu; const float* wsp; const float* bsp; unsigned short* SGU; float* gsout;
                const unsigned short* Us; const unsigned short* GVs; const float* SSs; unsigned short* SGUs; };
__device__ __forceinline__ void spatial_unit(const SpArgs& A, bool sample, int c, int g, char* lds) {
    asm volatile("" : "+s"(c), "+s"(g));
    int tid = threadIdx.x; asm volatile("" : "+v"(tid));
    const int lane = tid & 63, r32 = lane & 31, hi = lane >> 5;
    const int wid = __builtin_amdgcn_readfirstlane(tid >> 6);
    const int R0 = sample ? (16 * c) : (128 * c), nrows = sample ? 16 : 128;
    const unsigned short* Ubp = sample ? A.Us : A.Ub; const unsigned short* GVp = sample ? A.GVs : A.GVb; const float* SSp = sample ? A.SSs : A.SS; unsigned short* SGUp = sample ? A.SGUs : A.SGU;
    float* rs_l = (float*)lds;
    if (tid < nrows) {
        const f32x4* sp = (const f32x4*)(SSp + (size_t)(R0 + tid) * 16);
        const f32x4 a = sp[0], b = sp[1], cc = sp[2], d = sp[3];
        const float s = ((a[0] + a[1]) + (a[2] + a[3])) + ((b[0] + b[1]) + (b[2] + b[3])) + ((cc[0] + cc[1]) + (cc[2] + cc[3])) + ((d[0] + d[1]) + (d[2] + d[3]));
        rs_l[tid] = 1.0f / sqrtf(s * (1.0f / 1024.0f) + EPS);
    }
    __syncthreads();
    const int ch = g * 256 + wid * 32 + r32;
    const float gch = A.gsgu[ch];
    const int nks = sample ? 1 : 8, nrb = sample ? 1 : 4;
    bf16x8 bfr[8];
#pragma unroll
    for (int ks = 0; ks < 8; ++ks) {
        if (ks < nks) {
            float vv[8];
#pragma unroll
            for (int jj = 0; jj < 8; ++jj) {
                const int j = 16 * ks + 8 * hi + jj;
                vv[jj] = bf2f(GVp[(size_t)(R0 + j) * LDR + ch]) * rs_l[j] * gch;
                if (sample) A.gsout[(size_t)(16 * c + j) * LDR + ch] = vv[jj];
            }
            u32x4 w = {cvtpk(vv[0], vv[1]), cvtpk(vv[2], vv[3]), cvtpk(vv[4], vv[5]), cvtpk(vv[6], vv[7])};
            bfr[ks] = *reinterpret_cast<bf16x8*>(&w);
        } else bfr[ks] = bf16x8{};
    }
    const float* Wg = A.wsp + (size_t)g * 128 * 128;
#pragma unroll 1
    for (int rb = 0; rb < nrb; ++rb) {
        {
            f32x16 acc = {};
            const int i = 32 * rb + r32;
#pragma unroll
            for (int ks = 0; ks < 8; ++ks) {
                if (ks < nks && 16 * ks <= 32 * rb + 31) {
                    const int j0 = 16 * ks + 8 * hi;
                    const f32x4 w0 = *(const f32x4*)(Wg + (size_t)i * 128 + j0), w1 = *(const f32x4*)(Wg + (size_t)i * 128 + j0 + 4);
                    float wv[8] = {w0[0], w0[1], w0[2], w0[3], w1[0], w1[1], w1[2], w1[3]};
#pragma unroll
                    for (int jj = 0; jj < 8; ++jj) if (j0 + jj > i) wv[jj] = 0.f;
                    u32x4 w = {cvtpk(wv[0], wv[1]), cvtpk(wv[2], wv[3]), cvtpk(wv[4], wv[5]), cvtpk(wv[6], wv[7])};
                    acc = __builtin_amdgcn_mfma_f32_32x32x16_bf16(*reinterpret_cast<bf16x8*>(&w), bfr[ks], acc, 0, 0, 0);
                }
            }
#pragma unroll
            for (int r = 0; r < 16; ++r) {
                const int io = 32 * rb + crow(r, hi);
                if (io < nrows) {
                    const float uv = bf2f(Ubp[(size_t)(R0 + io) * LDR + ch]);
                    SGUp[(size_t)(R0 + io) * LDR + ch] = (unsigned short)f2bf(uv * (acc[r] + A.bsp[g * 128 + io]));
                }
            }
        }
    }
    __syncthreads();
}
__device__ __forceinline__ void spatial_unit_prompt(const SpArgs& A, int c, int g, char* lds) {
    asm volatile("" : "+s"(c), "+s"(g));
    int tid = threadIdx.x; asm volatile("" : "+v"(tid));
    const int lane = tid & 63, r32 = lane & 31, hi = lane >> 5;
    const int wid = __builtin_amdgcn_readfirstlane(tid >> 6);
    constexpr int GST = 528, WST = 272;
    char* Gt = lds; char* Wt = lds + 128 * GST; float* rs_l = (float*)(lds + 128 * GST + 128 * WST);
    const int R0 = 128 * c;
    u32x4 gv[8];
#pragma unroll
    for (int i = 0; i < 8; ++i) { const int q = tid + 512 * i, row = q >> 5, cc = q & 31;
        gv[i] = *(const u32x4*)(A.GVb + (size_t)(R0 + row) * LDR + g * 256 + cc * 8); }
    const int wi = tid >> 2, wj = (tid & 3) * 32;
    f32x4 wv[8];
#pragma unroll
    for (int i = 0; i < 8; ++i) wv[i] = *(const f32x4*)(A.wsp + (size_t)g * 128 * 128 + (size_t)wi * 128 + wj + 4 * i);
    if (tid < 128) {
        const f32x4* sp = (const f32x4*)(A.SS + (size_t)(R0 + tid) * 16);
        const f32x4 a = sp[0], b = sp[1], cc = sp[2], d = sp[3];
        const float s = ((a[0] + a[1]) + (a[2] + a[3])) + ((b[0] + b[1]) + (b[2] + b[3])) + ((cc[0] + cc[1]) + (cc[2] + cc[3])) + ((d[0] + d[1]) + (d[2] + d[3]));
        rs_l[tid] = 1.0f / sqrtf(s * (1.0f / 1024.0f) + EPS);
    }
#pragma unroll
    for (int i = 0; i < 8; ++i) { const int q = tid + 512 * i, row = q >> 5, cc = q & 31; *(u32x4*)(Gt + row * GST + cc * 16) = gv[i]; }
    __syncthreads();
#pragma unroll
    for (int i = 0; i < 4; ++i) {
        const f32x4 r0 = *(const f32x4*)(rs_l + wj + 8 * i), r1 = *(const f32x4*)(rs_l + wj + 8 * i + 4);
        float t[8];
#pragma unroll
        for (int e = 0; e < 4; ++e) { t[e] = (wj + 8 * i + e <= wi) ? wv[2 * i][e] * r0[e] : 0.f; t[4 + e] = (wj + 8 * i + 4 + e <= wi) ? wv[2 * i + 1][e] * r1[e] : 0.f; }
        u32x4 w = {cvtpk(t[0], t[1]), cvtpk(t[2], t[3]), cvtpk(t[4], t[5]), cvtpk(t[6], t[7])};
        *(u32x4*)(Wt + wi * WST + (wj + 8 * i) * 2) = w;
    }
    __syncthreads();
    u32x4 uu[8];
#pragma unroll
    for (int i = 0; i < 8; ++i) { const int q = tid + 512 * i, row = q >> 5, cc = q & 31;
        uu[i] = *(const u32x4*)(A.Ub + (size_t)(R0 + row) * LDR + g * 256 + cc * 8); }
    const int ccol = wid * 32 + r32, ch = g * 256 + ccol;
    const float gch = A.gsgu[ch];
    bf16x8 bfr[8];
#pragma unroll
    for (int ks = 0; ks < 8; ++ks) {
        unsigned p[4];
#pragma unroll
        for (int e = 0; e < 4; ++e) { const int j = 16 * ks + 8 * hi + 2 * e;
            const unsigned lo = *(const unsigned short*)(Gt + j * GST + ccol * 2), hi16 = *(const unsigned short*)(Gt + (j + 1) * GST + ccol * 2);
            p[e] = lo | (hi16 << 16); }
        u32x4 w = {p[0], p[1], p[2], p[3]};
        bfr[ks] = *reinterpret_cast<bf16x8*>(&w);
    }
    asm volatile("s_waitcnt lgkmcnt(0)" ::: "memory");
#pragma unroll
    for (int rb = 0; rb < 4; ++rb) {
        f32x16 acc = {};
#pragma unroll
        for (int ks = 0; ks < 8; ++ks) {
            if (ks <= 2 * rb + 1) {
                const bf16x8 af = *(const bf16x8*)(Wt + (32 * rb + r32) * WST + (16 * ks + 8 * hi) * 2);
                acc = __builtin_amdgcn_mfma_f32_32x32x16_bf16(af, bfr[ks], acc, 0, 0, 0);
            }
        }
#pragma unroll
        for (int r = 0; r < 16; ++r) { const int io = 32 * rb + crow(r, hi);
            *(unsigned short*)(Gt + io * GST + ccol * 2) = (unsigned short)f2bf(acc[r] * gch + A.bsp[g * 128 + io]); }
    }
    __syncthreads();
#pragma unroll
    for (int i = 0; i < 8; ++i) { const int q = tid + 512 * i, row = q >> 5, cc = q & 31;
        const u32x4 rv = *(const u32x4*)(Gt + row * GST + cc * 16);
        u32x4 ov;
#pragma unroll
        for (int e = 0; e < 4; ++e) { const float a0 = __builtin_bit_cast(float, rv[e] << 16) * __builtin_bit_cast(float, uu[i][e] << 16), a1 = __builtin_bit_cast(float, rv[e] & 0xffff0000u) * __builtin_bit_cast(float, uu[i][e] & 0xffff0000u);
            ov[e] = cvtpk(a0, a1); }
        *(u32x4*)(A.SGU + (size_t)(R0 + row) * LDR + g * 256 + cc * 8) = ov; }
    __syncthreads();
}
#undef SBAR
}

struct KArgs {
    const float* in[26]; float* out; unsigned char* ws;
};

struct Frame {
    LAS unsigned char* lds; int tid, lane, wave, G, gw, NGW;
};

__device__ __forceinline__ void p0_transpose_item(const float* W, int K, int N, bf16* WT, int mode, LAS float* scr, int item, int lane, int ldw = 0) {
    if (ldw == 0) ldw = K;
    const int nblk = N / 32, kb = item / nblk, nb = item % nblk, k0 = 64 * kb, n0 = 32 * nb;
    int d0 = n0;
    if (mode == 1) { const int half = N / 2; const int nn = (n0 < half) ? n0 : n0 - half; d0 = (nn >> 7) * 256 + (nn & 127) + ((n0 < half) ? 0 : 128); }
#pragma unroll
    for (int i = 0; i < 32; ++i) { const int kk = 2 * i + (lane >> 5); scr[kk * 33 + (lane & 31)] = W[(size_t)(k0 + kk) * N + n0 + (lane & 31)]; }
    LDS_WAIT(); asm volatile("" ::: "memory");
    const int c = lane & 7;
#pragma unroll
    for (int j = 0; j < 4; ++j) { const int n = (lane >> 3) + 8 * j; const LAS float* s = scr + (8 * c) * 33 + n;
        v4u o; o.x = pk2(s[0 * 33], s[1 * 33]); o.y = pk2(s[2 * 33], s[3 * 33]); o.z = pk2(s[4 * 33], s[5 * 33]); o.w = pk2(s[6 * 33], s[7 * 33]);
        *(v4u*)(WT + (size_t)(d0 + n) * ldw + k0 + 8 * c) = o; }
    LDS_WAIT(); asm volatile("" ::: "memory");
}

__device__ __forceinline__ const float* xrow_ptr(const float* xp, const float* xs, int m) { return (m < SEQ) ? xp + (size_t)m * DM : xs + (size_t)(m - SEQ) * DM; }

template <bool BIN, bool BOUT>
__device__ __forceinline__ void row_phase(const Frame& F, int m0, int mstep, int mend, const bf16* Fb, const float* SS, const void* base0, float scale,
                                          const float* gpost, void* Hout, const float* gnext, bf16* XN) {
    for (int m = m0; m < mend; m += 2 * mstep) {
        const bool two = (m + mstep < mend); const int mb = two ? m + mstep : m;
        const v2u* fa_ = (const v2u*)(Fb + (size_t)m * DM) + F.lane; const v2u* fb_ = (const v2u*)(Fb + (size_t)mb * DM) + F.lane;
        const f32x4* gp = (const f32x4*)gpost + F.lane;
        v2u fwa[4], fwb[4]; f32x4 bva[4], bvb[4], g[4];
        float ssa = SS[(size_t)m * 16 + (F.lane & 15)], ssb = SS[(size_t)mb * 16 + (F.lane & 15)];
#pragma unroll
        for (int j = 0; j < 4; ++j) { fwa[j] = fa_[64 * j]; fwb[j] = fb_[64 * j]; g[j] = gp[64 * j];
            if constexpr (BIN) { const v2u wa = ((const v2u*)((const bf16*)base0 + (size_t)m * DM) + F.lane)[64 * j], wb = ((const v2u*)((const bf16*)base0 + (size_t)mb * DM) + F.lane)[64 * j];
                bva[j] = (f32x4){bflo(wa.x), bfhi(wa.x), bflo(wa.y), bfhi(wa.y)}; bvb[j] = (f32x4){bflo(wb.x), bfhi(wb.x), bflo(wb.y), bfhi(wb.y)}; }
            else { bva[j] = ((const f32x4*)((const float*)base0 + (size_t)m * DM) + F.lane)[64 * j]; bvb[j] = ((const f32x4*)((const float*)base0 + (size_t)mb * DM) + F.lane)[64 * j]; } }
#pragma unroll
        for (int half = 0; half < 2; ++half) {
            if (half == 1 && !two) break;
            const int mm = half ? mb : m;
            float ss = half ? ssb : ssa;
            ss = rowsum16_(ss);
            const float rs = 1.0f / sqrtf(ss * (1.0f / DM) + EPS);
            f32x4 hv[4]; float s2 = 0.f;
#pragma unroll
            for (int j = 0; j < 4; ++j) { const v2u fw = half ? fwb[j] : fwa[j]; const f32x4 f = {bflo(fw.x), bfhi(fw.x), bflo(fw.y), bfhi(fw.y)}; const f32x4 b = half ? bvb[j] : bva[j];
                hv[j] = b + (f * g[j]) * (rs * scale);
                s2 += (hv[j][0] * hv[j][0] + hv[j][1] * hv[j][1]) + (hv[j][2] * hv[j][2] + hv[j][3] * hv[j][3]); }
            if (Hout) {
                if constexpr (BOUT) { v2u* ho = (v2u*)((bf16*)Hout + (size_t)mm * DM) + F.lane;
#pragma unroll
                    for (int j = 0; j < 4; ++j) ho[64 * j] = (v2u){pk2(hv[j][0], hv[j][1]), pk2(hv[j][2], hv[j][3])}; }
                else { f32x4* ho = (f32x4*)((float*)Hout + (size_t)mm * DM) + F.lane;
#pragma unroll
                    for (int j = 0; j < 4; ++j) { if (gnext) ho[64 * j] = hv[j]; else __builtin_nontemporal_store(hv[j], &ho[64 * j]); } }
            }
            if (gnext) {
                const float rs2 = 1.0f / sqrtf(wave_sum(s2) * (1.0f / DM) + EPS);
                const f32x4* gn = (const f32x4*)gnext + F.lane;
                unsigned long long* o8 = (unsigned long long*)(XN + (size_t)mm * DM) + F.lane;
#pragma unroll
                for (int j = 0; j < 4; ++j) { const f32x4 gq = gn[64 * j]; const f32x4 v = hv[j] * gq * rs2;
                    o8[64 * j] = (unsigned long long)pk2(v[0], v[1]) | ((unsigned long long)pk2(v[2], v[3]) << 32); }
            }
        }
    }
}


#define XB_TMO      128
#define XB_XCNT(j)  (256  + 64 * (j))
#define XB_XSUB(j)  (1280 + 64 * (j))
#define XB_XGEN(j)  (2304 + 64 * (j))
#define XB_TOP      3328
#define XB_TOPGEN   3392
#define XCD_BAR_WORDS 3456
#define XB_SPIN_CAP (1u << 20)
__device__ __forceinline__ unsigned xb_ld(unsigned* p)              { return __hip_atomic_load(p, __ATOMIC_RELAXED, __HIP_MEMORY_SCOPE_AGENT); }
__device__ __forceinline__ unsigned xb_add(unsigned* p, unsigned v) { return __hip_atomic_fetch_add(p, v, __ATOMIC_RELAXED, __HIP_MEMORY_SCOPE_AGENT); }
__device__ __forceinline__ unsigned xb_xcc_id() { return (unsigned)__builtin_amdgcn_s_getreg((3 << 11) | 20) & 0xFu; }
#define XB_SPIN(cond, bar) do { unsigned _sp = 0; while (cond) { __builtin_amdgcn_s_sleep(1); \
    if ((++_sp & 255u) == 0u) { if (xb_ld(&(bar)[XB_TMO])) break; if (_sp > XB_SPIN_CAP) { atomicAdd(&(bar)[XB_TMO], 1u); break; } } } } while (0)
struct XcdBarrier { unsigned* bar; unsigned x; volatile LAS unsigned* st; };
__device__ __forceinline__ XcdBarrier xcd_barrier_post(unsigned* bar, volatile LAS unsigned* st) {
    XcdBarrier b; b.bar = bar; b.x = xb_xcc_id(); b.st = st;
    if (threadIdx.x == 0) (void)xb_add(&bar[XB_XCNT(b.x)], 1u);
    return b;
}
__device__ __forceinline__ void xcd_barrier_complete(unsigned* bar, unsigned x, unsigned& nloc, unsigned& nx) {
    const unsigned G = gridDim.x * gridDim.y * gridDim.z;
    unsigned sum, cnt, mine, sp = 0u;
    for (;;) {
        sum = 0u; cnt = 0u; mine = 0u;
#pragma unroll
        for (unsigned j = 0; j < 16; ++j) { const unsigned c = xb_ld(&bar[XB_XCNT(j)]); sum += c; cnt += (c > 0u) ? 1u : 0u; mine = (j == x) ? c : mine; }
        if (sum == G) break;
        __builtin_amdgcn_s_sleep(1);
        if ((++sp & 255u) == 0u) { if (xb_ld(&bar[XB_TMO])) break; if (sp > XB_SPIN_CAP) { atomicAdd(&bar[XB_TMO], 1u); break; } }
    }
    nloc = mine > 0u ? mine : 1u; nx = cnt > 0u ? cnt : 1u;
}
__device__ __forceinline__ void xcd_barrier(const XcdBarrier& b) {
    asm volatile("s_waitcnt vmcnt(0)" ::: "memory");
    __syncthreads();
    if (threadIdx.x == 0) {
        unsigned* bar = b.bar;
        __builtin_amdgcn_s_waitcnt(0);
        unsigned nloc = b.st[0], nx = b.st[1];
        if (nloc == 0u) { xcd_barrier_complete(bar, b.x, nloc, nx); b.st[0] = nloc; b.st[1] = nx; }
        const unsigned old = xb_add(&bar[XB_XSUB(b.x)], 1u);
        const unsigned gen = old / nloc;
        if (old + 1u == (gen + 1u) * nloc) {
            __builtin_amdgcn_fence(__ATOMIC_RELEASE, "agent");
            asm volatile("s_waitcnt vmcnt(0)" ::: "memory");
            const unsigned og = xb_add(&bar[XB_TOP], 1u);
            const unsigned tg = og / nx;
            if (og + 1u == (tg + 1u) * nx) xb_add(&bar[XB_TOPGEN], 1u);
            else XB_SPIN(xb_ld(&bar[XB_TOPGEN]) == tg, bar);
            __builtin_amdgcn_fence(__ATOMIC_ACQUIRE, "agent");
            xb_add(&bar[XB_XGEN(b.x)], 1u);
            asm volatile("s_waitcnt vmcnt(0)" ::: "memory");
        } else {
            XB_SPIN(xb_ld(&bar[XB_XGEN(b.x)]) == gen, bar);
            __builtin_amdgcn_fence(__ATOMIC_ACQUIRE, "agent");
            asm volatile("s_waitcnt vmcnt(0)" ::: "memory");
        }
    }
    __syncthreads();
}

__device__ __forceinline__ int queue_pop(unsigned* ctr, volatile LAS unsigned* slot) {
    if (threadIdx.x == 0) *slot = __hip_atomic_fetch_add(ctr, 1u, __ATOMIC_RELAXED, __HIP_MEMORY_SCOPE_AGENT);
    __syncthreads();
    const int v = __builtin_amdgcn_readfirstlane((int)*slot);
    __syncthreads();
    return v;
}

__global__ void __launch_bounds__(NWAVES * 64, 2) mk_fwd(KArgs args) {
    extern __shared__ __attribute__((aligned(16))) unsigned char lds[];
    cg::grid_group grid = cg::this_grid();
    Frame F;
    F.lds = (LAS unsigned char*)lds;
    F.tid = threadIdx.x; F.lane = F.tid & 63; F.wave = __builtin_amdgcn_readfirstlane(F.tid >> 6);
    F.G = gridDim.x; F.gw = blockIdx.x * NWAVES + F.wave; F.NGW = F.G * NWAVES;
    unsigned char* ws = args.ws;
    unsigned* ctl = (unsigned*)(ws + WS_CTL);
    const float* xp = args.in[0]; const float* xs = args.in[1];
    float* rope = (float*)(ws + WS_ROPE); float* SS = (float*)(ws + WS_SS);
    bf16 *W1IN = (bf16*)(ws + WS_W1IN), *W1OUT = (bf16*)(ws + WS_W1OUT), *WIN = (bf16*)(ws + WS_WIN), *WA = (bf16*)(ws + WS_WA), *WB = (bf16*)(ws + WS_WB), *WO = (bf16*)(ws + WS_WO),
         *W2IN = (bf16*)(ws + WS_W2IN), *W2OUT = (bf16*)(ws + WS_W2OUT);
    bf16 *XN = (bf16*)(ws + WS_XN), *ACT = (bf16*)(ws + WS_ACT), *UB = (bf16*)(ws + WS_UB), *GVB = (bf16*)(ws + WS_GVB), *ATT = (bf16*)(ws + WS_ATT), *SGU = (bf16*)(ws + WS_SGU),
         *QB = (bf16*)(ws + WS_QB), *KPB = (bf16*)(ws + WS_KPB), *VPB = (bf16*)(ws + WS_VPB), *SGA = (bf16*)(ws + WS_SGA), *SGB = (bf16*)(ws + WS_SGB);
    bf16* FB = (bf16*)(ws + WS_F); bf16* HB = (bf16*)(ws + WS_H); float* T1 = (float*)(ws + WS_T1);
    bf16 *XNs = (bf16*)(ws + SA_XN), *ACTs = (bf16*)(ws + SA_ACT), *Qs = (bf16*)(ws + SA_Q), *Us = (bf16*)(ws + SA_U), *GVs = (bf16*)(ws + SA_GV), *SGAs = (bf16*)(ws + SA_SGA),
         *SGBs = (bf16*)(ws + SA_SGB), *ATTs = (bf16*)(ws + SA_ATT), *SGUs = (bf16*)(ws + SA_SGU);
    bf16* Fs = (bf16*)(ws + SA_F); float *Hs = (float*)(ws + SA_H), *T1s = (float*)(ws + SA_T1), *SSs = (float*)(ws + SA_SS);
    float* out = args.out;
    volatile LAS unsigned* MISC = (volatile LAS unsigned*)(F.lds + MISC_OFF);
    if (F.tid < 32) MISC[F.tid] = 0u;
    __syncthreads();
    XcdBarrier bar = xcd_barrier_post(ctl + CW_BAR, MISC + 8);
#define GRID_BAR() xcd_barrier(bar)

#if (PHM >> 0) & 1
    {
        LAS float* scr = (LAS float*)(F.lds + F.wave * 16384);
        constexpr int I_FIN = (DM / 64) * (2 * DFF / 32), I_FOUT = (DFF / 64) * (DM / 32), I_IN = (DM / 64) * (INC / 32), I_SQ = (DM / 64) * (DM / 32);
        constexpr int NITEMS = 2 * I_FIN + 2 * I_FOUT + I_IN + 3 * I_SQ;
        for (int it = F.gw; it < NITEMS; it += F.NGW) {
            int r = it;
            if (r < I_FIN) { p0_transpose_item(args.in[5], DM, 2 * DFF, W1IN, 1, scr, r, F.lane); continue; } r -= I_FIN;
            if (r < I_FOUT) { p0_transpose_item(args.in[6], DFF, DM, W1OUT, 0, scr, r, F.lane, LDF); continue; } r -= I_FOUT;
            if (r < I_IN) { p0_transpose_item(args.in[9], DM, INC, WIN, 0, scr, r, F.lane); continue; } r -= I_IN;
            if (r < I_SQ) { p0_transpose_item(args.in[18], DM, DM, WA, 0, scr, r, F.lane); continue; } r -= I_SQ;
            if (r < I_SQ) { p0_transpose_item(args.in[19], DM, DM, WB, 0, scr, r, F.lane); continue; } r -= I_SQ;
            if (r < I_SQ) { p0_transpose_item(args.in[20], DM, DM, WO, 0, scr, r, F.lane); continue; } r -= I_SQ;
            if (r < I_FIN) { p0_transpose_item(args.in[23], DM, 2 * DFF, W2IN, 1, scr, r, F.lane); continue; } r -= I_FIN;
            p0_transpose_item(args.in[24], DFF, DM, W2OUT, 0, scr, r, F.lane, LDF);
        }
        for (int i = blockIdx.x * (NWAVES * 64) + F.tid; i < SEQ * 8; i += F.G * NWAVES * 64) {
            const int pos = i >> 3, d = i & 7;
            const double cf = (d == 0) ? 0.15915494309189535 : (d == 1) ? 0.03086376340470123 : (d == 2) ? 0.005985185712713705 : (d == 3) ? 0.001160663641240061 :
                              (d == 4) ? 0.00022507907903927653 : (d == 5) ? 4.364795279280289e-05 : (d == 6) ? 8.464330808241401e-06 : 1.6414262627950345e-06;
            const double rev = (double)pos * cf; double t = rev - __builtin_floor(rev);
            t = t - __builtin_rint(t);
            const double q = __builtin_rint(4.0 * t); const double a = (t - 0.25 * q) * 6.283185307179586476925;
            const double a2 = a * a;
            const double sn = a * (1.0 + a2 * (-1.0 / 6 + a2 * (1.0 / 120 + a2 * (-1.0 / 5040 + a2 * (1.0 / 362880 + a2 * (-1.0 / 39916800 + a2 * (1.0 / 6227020800.0)))))));
            const double cs = 1.0 + a2 * (-0.5 + a2 * (1.0 / 24 + a2 * (-1.0 / 720 + a2 * (1.0 / 40320 + a2 * (-1.0 / 3628800 + a2 * (1.0 / 479001600 + a2 * (-1.0 / 87178291200.0)))))));
            const int qi = ((int)q) & 3;
            const double s_ = (qi == 0) ? sn : (qi == 1) ? cs : (qi == 2) ? -sn : -cs;
            const double c_ = (qi == 0) ? cs : (qi == 1) ? -sn : (qi == 2) ? -cs : sn;
            rope[(size_t)pos * 16 + d] = (float)c_; rope[(size_t)pos * 16 + 8 + d] = (float)s_;
        }
        const float* g1 = args.in[4];
        for (int m = F.gw; m < MT; m += 2 * F.NGW) {
            const bool two = (m + F.NGW < MT); const int mb = two ? m + F.NGW : m;
            const f32x4* xa = (const f32x4*)xrow_ptr(xp, xs, m) + F.lane; const f32x4* xb = (const f32x4*)xrow_ptr(xp, xs, mb) + F.lane; const f32x4* gp = (const f32x4*)g1 + F.lane;
            f32x4 va[4], vb[4], g[4]; float sa = 0.f, sb = 0.f;
#pragma unroll
            for (int j = 0; j < 4; ++j) { va[j] = xa[64 * j]; vb[j] = xb[64 * j]; g[j] = gp[64 * j]; }
#pragma unroll
            for (int j = 0; j < 4; ++j) { sa += (va[j][0] * va[j][0] + va[j][1] * va[j][1]) + (va[j][2] * va[j][2] + va[j][3] * va[j][3]);
                                          sb += (vb[j][0] * vb[j][0] + vb[j][1] * vb[j][1]) + (vb[j][2] * vb[j][2] + vb[j][3] * vb[j][3]); }
            const float rsa = 1.0f / sqrtf(wave_sum(sa) * (1.0f / DM) + EPS), rsb = 1.0f / sqrtf(wave_sum(sb) * (1.0f / DM) + EPS);
            unsigned long long* oa = (unsigned long long*)(m < SEQ ? XN + (size_t)m * DM : XNs + (size_t)(m - SEQ) * DM) + F.lane;
            unsigned long long* ob = (unsigned long long*)(mb < SEQ ? XN + (size_t)mb * DM : XNs + (size_t)(mb - SEQ) * DM) + F.lane;
#pragma unroll
            for (int j = 0; j < 4; ++j) { const f32x4 w = va[j] * g[j] * rsa; oa[64 * j] = (unsigned long long)pk2(w[0], w[1]) | ((unsigned long long)pk2(w[2], w[3]) << 32); }
            if (two) {
#pragma unroll
                for (int j = 0; j < 4; ++j) { const f32x4 w = vb[j] * g[j] * rsb; ob[64 * j] = (unsigned long long)pk2(w[0], w[1]) | ((unsigned long long)pk2(w[2], w[3]) << 32); }
            }
        }
    }
    GRID_BAR();
    if (args.ws == nullptr) grid.sync();

#endif
#if (PHM >> 1) & 1
    { pg8::Gemm g{XN, W1IN, SEQ, 2 * DFF, DM}; pg8::HeadOrder S; S.init(SEQ, 2 * DFF, F.G, (int)blockIdx.x);
      pg8::EpiSwiglu E{ACT}; pg8::gemm_phase<pg8::EpiSwiglu, pg8::HeadOrder, true, true>(F.lds, g, S, E);
      pg8::TailOrder S2; S2.init(SEQ, 2 * DFF, F.G, (int)blockIdx.x);
      pg8::EpiSwigluHalfM E2{ACT}; pg8::gemm_phase<pg8::EpiSwigluHalfM, pg8::TailOrder, true, true, true>(F.lds, g, S2, E2); }
    GRID_BAR();
#endif
#if (PHM >> 2) & 1
    { pg8::Gemm g{ACT, W1OUT, SEQ, DM, DFF, nullptr, nullptr, LDF}; pg8::StaticOrder S; S.init(SEQ, DM, F.G, (int)blockIdx.x);
      pg8::EpiF32Stats E{FB, SS}; pg8::gemm_phase<pg8::EpiF32Stats, pg8::StaticOrder, false, true>(F.lds, g, S, E); }
    GRID_BAR();
#endif
#if (PHM >> 3) & 1
    row_phase<false, true>(F, F.gw, F.NGW, SEQ, FB, SS, xp, 0.5f, args.in[7], HB, args.in[8], XN);
    GRID_BAR();
#endif
#if (PHM >> 4) & 1
    { pg8::Gemm g{XN, WIN, SEQ, INC, DM}; pg8::StaticOrder S; S.init(SEQ, INC, F.G, (int)blockIdx.x);
      pg8::EpiProj E{QB, KPB, VPB, UB, GVB, SGA, SGB, out + OFF_KP, out + OFF_VP, SS, rope, false}; pg8::gemm_phase<pg8::EpiProj, pg8::StaticOrder, true, true>(F.lds, g, S, E); }
    GRID_BAR();
#endif
#if (PHM >> 5) & 1
    {
        float lam;
        { const float a = args.in[10][F.lane] * args.in[11][F.lane], b = args.in[12][F.lane] * args.in[13][F.lane];
          lam = expf(wave_sum(a)) - expf(wave_sum(b)) + LAM_INIT;
          lam = __builtin_bit_cast(float, __builtin_amdgcn_readfirstlane(__builtin_bit_cast(int, lam))); }
        unsigned* ch = ctl + CW_CH;
        int ch_ready = 0;
#define CH_N(s) ((s) == 1 || (s) == 10 ? 22 : (s) == 4 ? 28 : (s) == 5 ? 192 : ((s) == 3 || (s) == 9 || (s) == 12) ? 16 : 4)
#define CH_DONE_NOW(s, RES) do { if ((s) <= ch_ready) RES = true; else { \
            if (F.tid == 0) MISC[1] = (__hip_atomic_load(ch + 128 * (s) + 64, __ATOMIC_RELAXED, __HIP_MEMORY_SCOPE_AGENT) >= (unsigned)CH_N(s)) ? 1u : 0u; \
            __syncthreads(); RES = __builtin_amdgcn_readfirstlane((int)MISC[1]) != 0; __syncthreads(); } } while (0)
#define CH_WAIT(s) do { if ((s) > ch_ready) { \
            if (F.tid == 0) { unsigned sp_ = 0; while (__hip_atomic_load(ch + 128 * (s) + 64, __ATOMIC_RELAXED, __HIP_MEMORY_SCOPE_AGENT) < (unsigned)CH_N(s)) { __builtin_amdgcn_s_sleep(8); if (++sp_ > (1u << 22)) break; } \
                if (!((s) == 4 && !starter)) { __builtin_amdgcn_fence(__ATOMIC_ACQUIRE, "agent"); asm volatile("s_waitcnt vmcnt(0)" ::: "memory"); } } \
            __syncthreads(); ch_ready = (s); } } while (0)
#define CH_SIGNAL(s) do { asm volatile("s_waitcnt vmcnt(0)" ::: "memory"); __syncthreads(); \
            if (F.tid == 0) { __builtin_amdgcn_fence(__ATOMIC_RELEASE, "agent"); asm volatile("s_waitcnt vmcnt(0)" ::: "memory"); \
                __hip_atomic_fetch_add(ch + 128 * (s) + 64, 1u, __ATOMIC_RELAXED, __HIP_MEMORY_SCOPE_AGENT); } } while (0)
#define WP(T, off) ((T*)(w_ + (off)))
#define CH_UNIT(s, u) do { \
            if ((s) == 1 || (s) == 10) { pg8::Gemm g{WP(bf16, SA_XN), (s) == 1 ? WP(bf16, WS_W1IN) : WP(bf16, WS_W2IN), 256, 2 * DFF, DM}; pg8::OneUnit S{0, (u)}; pg8::EpiSwiglu E{WP(bf16, SA_ACT)}; pg8::gemm_phase<pg8::EpiSwiglu, pg8::OneUnit, false, true>(F.lds, g, S, E); } \
            else if ((s) == 2 || (s) == 11) { pg8::Gemm g{WP(bf16, SA_ACT), (s) == 2 ? WP(bf16, WS_W1OUT) : WP(bf16, WS_W2OUT), 256, DM, DFF, nullptr, nullptr, LDF}; pg8::OneUnit S{0, (u)}; pg8::EpiF32Stats E{WP(bf16, SA_F), WP(float, SA_SS)}; pg8::gemm_phase<pg8::EpiF32Stats, pg8::OneUnit, false, true>(F.lds, g, S, E); } \
            else if ((s) == 8) { pg8::Gemm g{WP(bf16, SA_XN), WP(bf16, WS_WO), 256, DM, DM}; pg8::OneUnit S{0, (u)}; pg8::EpiF32Stats E{WP(bf16, SA_F), WP(float, SA_SS)}; pg8::gemm_phase<pg8::EpiF32Stats, pg8::OneUnit, false, true>(F.lds, g, S, E); } \
            else if ((s) == 4) { pg8::Gemm g{WP(bf16, SA_XN), WP(bf16, WS_WIN), 256, INC, DM}; pg8::OneUnit S{0, (u)}; \
                               pg8::EpiProj E{WP(bf16, SA_Q), nullptr, nullptr, WP(bf16, SA_U), WP(bf16, SA_GV), WP(bf16, SA_SGA), WP(bf16, SA_SGB), o_ + OFF_KS, o_ + OFF_VS, WP(float, SA_SS), WP(float, WS_ROPE), true}; \
                               pg8::gemm_phase<pg8::EpiProj, pg8::OneUnit, false, true>(F.lds, g, S, E); } \
            else if ((s) == 6) { pg8::Gemm g{WP(bf16, SA_ATT), WP(bf16, WS_WA), 256, DM, DM}; pg8::OneUnit S{0, (u)}; pg8::EpiGateA E{WP(float, SA_T1), WP(bf16, SA_SGA)}; pg8::gemm_phase<pg8::EpiGateA, pg8::OneUnit, false, true>(F.lds, g, S, E); } \
            else if ((s) == 7) { pg8::Gemm g{WP(bf16, SA_SGU), WP(bf16, WS_WB), 256, DM, DM}; pg8::OneUnit S{0, (u)}; pg8::EpiGateB E{WP(float, SA_T1), WP(bf16, SA_SGB), WP(bf16, SA_XN)}; pg8::gemm_phase<pg8::EpiGateB, pg8::OneUnit, false, true>(F.lds, g, S, E); } \
            else if ((s) == 3) row_phase<false, false>(F, 16 * (u) + F.wave, NWAVES, 16 * (u) + 16, WP(bf16, SA_F), WP(float, SA_SS), KIN(1), 0.5f, KIN(7), WP(float, SA_H), KIN(8), WP(bf16, SA_XN)); \
            else if ((s) == 9) row_phase<false, false>(F, 16 * (u) + F.wave, NWAVES, 16 * (u) + 16, WP(bf16, SA_F), WP(float, SA_SS), WP(float, SA_H), 1.0f, KIN(21), WP(float, SA_H), KIN(22), WP(bf16, SA_XN)); \
            else if ((s) == 12) row_phase<false, false>(F, 16 * (u) + F.wave, NWAVES, 16 * (u) + 16, WP(bf16, SA_F), WP(float, SA_SS), WP(float, SA_H), 0.5f, KIN(25), o_ + OFF_Y + (size_t)SEQ * DM, nullptr, nullptr); \
            else {} } while (0)
#ifndef P5_REPS
#define P5_REPS 1
#endif
#ifndef NDED
#define NDED 12
#endif
        const int h8 = blockIdx.x & 7;
#pragma unroll 1
        for (int rep = 0; rep < P5_REPS; ++rep) {
        unsigned* qb_ = ctl + CW_Q + rep * 1024;
        const bool starter = (int)blockIdx.x >= (int)F.G - NDED;
        int st = starter ? 0 : 1, cs = starter ? 1 : 5, hh = 0; bool s5_open = true, try5 = false;
        for (;;) {
            int kind = 0, a0 = 0, a1 = 0, dep = 0, sig = 0;
            if (st == 0 || st == 3) {
                while (cs <= 12) { const int u = queue_pop(ch + 128 * cs, MISC); if (u < CH_N(cs)) { kind = 3; a0 = cs; a1 = u; dep = cs - 1; sig = cs; break; } ++cs; }
                if (kind == 0) { if (st == 0) { st = 1; cs = 5; continue; } break; }
            } else if (st == 1) {
                if (try5) { try5 = false; bool rdy_; CH_DONE_NOW(4, rdy_);
                    if (rdy_) { const int u = queue_pop(ch + 128 * 5, MISC); if (u < CH_N(5)) { kind = 3; a0 = 5; a1 = u; dep = 4; sig = 5; } else s5_open = false; } }
                if (kind == 0) {
                    while (hh < 8) { const int hq = (h8 + hh) & 7; const int idx = queue_pop(qb_ + 64 * hq, MISC); if (idx < 128) { kind = 1; a0 = hq; a1 = 127 - idx; try5 = s5_open; break; }
                        if (F.tid < 8) MISC[32 + F.tid] = __hip_atomic_load(qb_ + 64 * F.tid, __ATOMIC_RELAXED, __HIP_MEMORY_SCOPE_AGENT);
                        __syncthreads();
                        ++hh; while (hh < 8 && MISC[32 + ((h8 + hh) & 7)] >= 128u) ++hh;
                        __syncthreads(); }
                    if (kind == 0) { st = 2; continue; }
                }
            } else {
                const int idx = queue_pop(qb_ + 64 * 8, MISC);
                if (idx < 512) { kind = 2; a0 = idx >> 2; a1 = idx & 3; } else { bool fin_; CH_DONE_NOW(12, fin_); if (fin_) break; st = 3; cs = 5; continue; }
            }
            if (dep) CH_WAIT(dep);
            typedef __attribute__((address_space(4))) const unsigned long long* kptr_t;
            kptr_t kq_ = (kptr_t)__builtin_amdgcn_kernarg_segment_ptr(); asm volatile("" : "+s"(kq_));
#define KIN(k) ((const float*)(const GAS float*)kq_[k])
            unsigned char* w_ = (unsigned char*)(GAS unsigned char*)kq_[27]; float* o_ = (float*)(GAS float*)kq_[26];
            if (kind == 1 || (kind == 3 && a0 == 5 && a1 < 128)) {
                att::Args AA{WP(bf16, WS_QB), WP(bf16, WS_KPB), WP(bf16, WS_VPB), KIN(2), KIN(3), o_ + OFF_KS, o_ + OFF_VS, WP(bf16, WS_ATT), KIN(14), WP(bf16, SA_Q), WP(bf16, SA_ATT), o_ + OFF_KP, o_ + OFF_VP};
                if (kind == 1) att::attn_unit<false>(AA, a0, a1, (char*)lds, lam); else att::attn_unit<true>(AA, a1 & 7, a1 >> 3, (char*)lds, lam);
            } else if (kind == 2 || (kind == 3 && a0 == 5)) { const bool smp = (kind == 3);
                att::SpArgs SA{WP(bf16, WS_UB), WP(bf16, WS_GVB), WP(float, WS_SS), KIN(15), KIN(16), KIN(17), WP(bf16, WS_SGU), o_ + OFF_GS, WP(bf16, SA_U), WP(bf16, SA_GV), WP(float, SA_SS), WP(bf16, SA_SGU)};
                if (smp) att::spatial_unit(SA, true, (a1 - 128) >> 2, (a1 - 128) & 3, (char*)lds); else att::spatial_unit_prompt(SA, a0, a1, (char*)lds); }
            else CH_UNIT(a0, a1);
            if (sig) CH_SIGNAL(sig);
        }
        if (rep + 1 < P5_REPS) GRID_BAR();
        }
    }
    GRID_BAR();
#endif
#if (PHM >> 6) & 1
    { pg8::Gemm g{ATT, WA, SEQ, DM, DM, SGU, WB}; pg8::DualOrder S; S.init(SEQ, DM, F.G, (int)blockIdx.x);
      pg8::EpiGateAB E{SGA, SGB, XN}; pg8::gemm_phase<pg8::EpiGateAB, pg8::DualOrder, true, true>(F.lds, g, S, E); }
    GRID_BAR();
#endif
#if (PHM >> 8) & 1
    { pg8::Gemm g{XN, WO, SEQ, DM, DM}; pg8::StaticOrder S; S.init(SEQ, DM, F.G, (int)blockIdx.x);
      pg8::EpiF32Stats E{FB, SS}; pg8::gemm_phase<pg8::EpiF32Stats, pg8::StaticOrder, false, true>(F.lds, g, S, E); }
    GRID_BAR();
#endif
#if (PHM >> 9) & 1
    row_phase<true, true>(F, F.gw, F.NGW, SEQ, FB, SS, HB, 1.0f, args.in[21], HB, args.in[22], XN);
    GRID_BAR();
#endif
#if (PHM >> 10) & 1
    { pg8::Gemm g{XN, W2IN, SEQ, 2 * DFF, DM}; pg8::HeadOrder S; S.init(SEQ, 2 * DFF, F.G, (int)blockIdx.x);
      pg8::EpiSwiglu E{ACT}; pg8::gemm_phase<pg8::EpiSwiglu, pg8::HeadOrder, true, true>(F.lds, g, S, E);
      pg8::TailOrder S2; S2.init(SEQ, 2 * DFF, F.G, (int)blockIdx.x);
      pg8::EpiSwigluHalfM E2{ACT}; pg8::gemm_phase<pg8::EpiSwigluHalfM, pg8::TailOrder, true, true, true>(F.lds, g, S2, E2); }
    GRID_BAR();
    { pg8::Gemm g{ACT, W2OUT, SEQ, DM, DFF, nullptr, nullptr, LDF}; pg8::StaticOrder S; S.init(SEQ, DM, F.G, (int)blockIdx.x);
      pg8::EpiF32Stats E{FB, SS}; pg8::gemm_phase<pg8::EpiF32Stats, pg8::StaticOrder, false, true>(F.lds, g, S, E); }
    GRID_BAR();
#endif
#if (PHM >> 11) & 1
        row_phase<true, false>(F, F.gw, F.NGW, SEQ, FB, SS, HB, 0.5f, args.in[25], out + OFF_Y, nullptr, nullptr);
#endif
#ifdef PROBE_BF16
    for (size_t i = (size_t)blockIdx.x * 512 + F.tid; i < (size_t)MT * DM; i += (size_t)F.G * 512) out[OFF_Y + i] = bf2f(((const bf16*)PROBE_BF16)[i]);
#elif !((PHM >> 11) & 1)
    for (size_t i = (size_t)blockIdx.x * 512 + F.tid; i < (size_t)MT * DM / 4; i += (size_t)F.G * 512) ((f32x4*)(out + OFF_Y))[i] = (f32x4){0.f, 0.f, 0.f, 0.f};
#endif
#if !((PHM >> 5) & 1)
    for (size_t i = (size_t)blockIdx.x * 512 + F.tid; i < (size_t)256 * DM / 4; i += (size_t)F.G * 512) ((f32x4*)(out + OFF_GS))[i] = (f32x4){0.f, 0.f, 0.f, 0.f};
#endif
}

extern "C" void kernel_launch(void* const* d_in, const int* in_sizes, int n_in, void* d_out, int out_size, void* d_ws, size_t ws_size, hipStream_t stream) {
    static int grid = 0;
    if (grid == 0) {
        if (n_in != 26 || ws_size < WS_END) { fprintf(stderr, "kernel_launch: unexpected n_in %d / ws %zu\n", n_in, ws_size); grid = -1; return; }
        int dev = 0, cus = 0, per_cu = 0;
        if (hipGetDevice(&dev) != hipSuccess || hipDeviceGetAttribute(&cus, hipDeviceAttributeMultiprocessorCount, dev) != hipSuccess) { grid = -1; return; }
        if (hipFuncSetAttribute((const void*)mk_fwd, hipFuncAttributeMaxDynamicSharedMemorySize, LDS_BYTES) != hipSuccess) { fprintf(stderr, "kernel_launch: hipFuncSetAttribute failed\n"); grid = -1; return; }
        if (hipOccupancyMaxActiveBlocksPerMultiprocessor(&per_cu, (const void*)mk_fwd, NWAVES * 64, LDS_BYTES) != hipSuccess || per_cu < 1) { fprintf(stderr, "kernel_launch: occupancy query says %d\n", per_cu); per_cu = 1; }
        (void)hipGetLastError();
        grid = cus;
    }
    if (grid < 0) return;
    (void)hipMemsetAsync((char*)d_ws + WS_CTL, 0, CTL_ZERO_BYTES, stream);
    KArgs a{};
    for (int i = 0; i < 26; ++i) a.in[i] = (const float*)d_in[i];
    a.out = (float*)d_out; a.ws = (unsigned char*)d_ws;
    void* kargs[] = {&a};
    hipError_t e = hipLaunchCooperativeKernel((const void*)mk_fwd, dim3(grid), dim3(NWAVES * 64), kargs, LDS_BYTES, stream);
    if (e != hipSuccess) fprintf(stderr, "kernel_launch: cooperative launch failed: %s (grid %d)\n", hipGetErrorString(e), grid);
}
```
